# Optimizing an MI355X kernel written in HIP

```python
import jax, jax.numpy as jnp
from jax import lax
import numpy as np

D_MODEL = 2048
BATCH = 8
SEQ = 2048
DEPTH = 2

HEAD_DIM = 128
A_GROUPS = 4
A_WIDTH = A_GROUPS * HEAD_DIM
A_CHUNK = 128
B_HEADS = 6
B_WIDTH = B_HEADS * HEAD_DIM
B_CONV = 4
B_CHUNK = 64
C_HEADS = 6
C_WIDTH = C_HEADS * HEAD_DIM
C_BRANCHES = ((128, 1), (512, 4), (2048, 16))
C_BLOCK = 128
MIX_WIDTH = A_WIDTH + B_WIDTH + C_WIDTH
FFN_HIDDEN = -(-8 * D_MODEL // (3 * 256)) * 256
IN_SIZES = (A_WIDTH, A_WIDTH,
            B_WIDTH, B_WIDTH, B_WIDTH, B_WIDTH, B_HEADS, B_HEADS,
            C_WIDTH, C_WIDTH, C_WIDTH)
IN_TOTAL = sum(IN_SIZES)
EPS = 1e-6

kernel_name = "hybrid_sgu_deltanet_dilated_attn"


def rms_norm(x, g):
    xf = x.astype(jnp.float32)
    y = xf * lax.rsqrt(jnp.mean(xf * xf, axis=-1, keepdims=True) + EPS)
    return (y * g.astype(jnp.float32)).astype(x.dtype)


def l2_norm(x):
    return x * lax.rsqrt(jnp.sum(x * x, axis=-1, keepdims=True) + EPS)


def chunked_spatial_gating(u, v, sgu_g, w_s, b_s):
    bsz, s, _ = u.shape
    nc = s // A_CHUNK
    u = jax.nn.gelu(u)
    v = rms_norm(jax.nn.gelu(v).reshape(bsz, s, A_GROUPS, HEAD_DIM), sgu_g)
    v = v.reshape(bsz, nc, A_CHUNK, A_GROUPS, HEAD_DIM)
    causal = jnp.tril(jnp.ones((A_CHUNK, A_CHUNK), dtype=bool))
    w = jnp.where(causal[None], w_s, jnp.zeros_like(w_s)).astype(v.dtype)
    z = jnp.einsum('gij,bcjgd->bcigd', w, v) + b_s.T.astype(v.dtype)[None, None, :, :, None]
    return u * z.reshape(bsz, s, A_WIDTH)


def causal_depthwise_conv(x, w):
    k = w.shape[0]
    s = x.shape[1]
    xp = jnp.pad(x, ((0, 0), (k - 1, 0), (0, 0)))
    return sum(xp[:, j:j + s] * w[j].astype(x.dtype) for j in range(k))


def gated_delta_net(q, k, v, gate, beta_logit, a, conv_w, a_log, dt_bias, o_norm_g):
    bsz, s, _ = q.shape
    f32 = jnp.float32
    qkv = jax.nn.silu(causal_depthwise_conv(jnp.concatenate([q, k, v], axis=-1), conv_w))
    q, k, v = jnp.split(qkv, 3, axis=-1)
    to_heads = lambda t: t.reshape(bsz, s, B_HEADS, HEAD_DIM).transpose(0, 2, 1, 3).astype(f32)
    q = l2_norm(to_heads(q)) * (HEAD_DIM ** -0.5)
    k = l2_norm(to_heads(k))
    v = to_heads(v)
    beta = jax.nn.sigmoid(beta_logit.astype(f32)).transpose(0, 2, 1)
    g = (-jnp.exp(a_log.astype(f32))[None, None, :]
         * jax.nn.softplus(a.astype(f32) + dt_bias.astype(f32)[None, None, :])).transpose(0, 2, 1)
    nc = s // B_CHUNK
    chunk = lambda t: t.reshape(t.shape[:2] + (nc, B_CHUNK) + t.shape[3:])
    q, k, v, beta, g = map(chunk, (q, k, v, beta, g))
    g = jnp.cumsum(g, axis=-1)
    causal = jnp.tril(jnp.ones((B_CHUNK, B_CHUNK), dtype=bool))
    strict = jnp.tril(jnp.ones((B_CHUNK, B_CHUNK), dtype=bool), -1)
    gdiff = g[..., :, None] - g[..., None, :]
    decay_mat = jnp.exp(jnp.where(causal, gdiff, -jnp.inf))
    k_beta = k * beta[..., None]
    a_mat = jnp.einsum('bhnid,bhnjd->bhnij', k_beta, k) * jnp.where(strict, decay_mat, 0.0)
    m = a_mat + jnp.eye(B_CHUNK, dtype=f32)
    rhs = jnp.concatenate([v * beta[..., None], k_beta * jnp.exp(g)[..., None]], axis=-1)
    sol = lax.linalg.triangular_solve(m, rhs, left_side=True, lower=True, unit_diagonal=True)
    u_vals, w_keys = jnp.split(sol, 2, axis=-1)
    attn_intra = jnp.einsum('bhnid,bhnjd->bhnij', q, k) * decay_mat

    def step(state, xs):
        q_c, k_c, u_c, w_c, g_c, attn_c = xs
        v_new = u_c - jnp.einsum('bhik,bhkv->bhiv', w_c, state)
        o_c = (jnp.einsum('bhik,bhkv->bhiv', q_c * jnp.exp(g_c)[..., None], state)
               + jnp.einsum('bhij,bhjv->bhiv', attn_c, v_new))
        g_last = g_c[..., -1:]
        state = (state * jnp.exp(g_last)[..., None]
                 + jnp.einsum('bhik,bhiv->bhkv', k_c * jnp.exp(g_last - g_c)[..., None], v_new))
        return state, o_c

    xs = tuple(jnp.moveaxis(t, 2, 0) for t in (q, k, u_vals, w_keys, g, attn_intra))
    state0 = jnp.zeros((bsz, B_HEADS, HEAD_DIM, HEAD_DIM), f32)
    _, o = lax.scan(step, state0, xs)
    o = jnp.moveaxis(o, 0, 2).reshape(bsz, B_HEADS, s, HEAD_DIM).transpose(0, 2, 1, 3)
    gate = gate.reshape(bsz, s, B_HEADS, HEAD_DIM)
    y = rms_norm(o, o_norm_g) * jax.nn.silu(gate.astype(f32))
    return y.astype(gate.dtype).reshape(bsz, s, B_WIDTH)


def dilated_branch(q, k, v, slopes, window, dilation):
    bsz, s, h, hd = q.shape
    span = window // dilation
    seg = s // dilation
    nb = -(-seg // C_BLOCK)
    lp = nb * C_BLOCK

    def to_blocks(t):
        t = t.reshape(bsz, seg, dilation, h, hd)
        t = jnp.pad(t, ((0, 0), (0, lp - seg), (0, 0), (0, 0), (0, 0)))
        return t.reshape(bsz, nb, C_BLOCK, dilation, h, hd)

    qb, kb, vb = map(to_blocks, (q, k, v))
    prev = lambda t: jnp.pad(t, ((0, 0), (1, 0), (0, 0), (0, 0), (0, 0), (0, 0)))[:, :-1]
    kb = jnp.concatenate([prev(kb), kb], axis=2)
    vb = jnp.concatenate([prev(vb), vb], axis=2)
    scores = jnp.einsum('bnqrhd,bnkrhd->bnrhqk', qb, kb).astype(jnp.float32) * (hd ** -0.5)
    qi = jnp.arange(C_BLOCK)[:, None]
    kj = jnp.arange(2 * C_BLOCK)[None, :]
    delta = C_BLOCK + qi - kj
    in_band = (delta >= 0) & (delta <= span)
    key_exists = (jnp.arange(nb)[:, None, None] > 0) | (kj >= C_BLOCK)[None]
    mask = in_band[None] & key_exists
    bias = -slopes[:, None, None] * (delta * dilation).astype(jnp.float32)[None]
    sc = jnp.where(mask[None, :, None, None], scores + bias[None, None, None], -jnp.inf)
    mx = jnp.max(sc, axis=-1, keepdims=True)
    p = jnp.exp(sc - mx)
    den = jnp.sum(p, axis=-1, keepdims=True)
    out = jnp.einsum('bnrhqk,bnkrhd->bnqrhd', (p / den).astype(v.dtype), vb)
    lse = (mx + jnp.log(den))[..., 0]
    out = out.reshape(bsz, lp, dilation, h, hd)[:, :seg].reshape(bsz, s, h, hd)
    lse = lse.transpose(0, 1, 4, 2, 3).reshape(bsz, lp, dilation, h)[:, :seg].reshape(bsz, s, h)
    return out, lse


def dilated_attention(q, k, v, q_g, k_g, slopes):
    bsz, s, _ = q.shape
    to_heads = lambda t: t.reshape(bsz, s, C_HEADS, HEAD_DIM)
    q = rms_norm(to_heads(q), q_g)
    k = rms_norm(to_heads(k), k_g)
    v = to_heads(v)
    outs, lses = zip(*(dilated_branch(q, k, v, slopes, w, r) for (w, r) in C_BRANCHES))
    wts = jax.nn.softmax(jnp.stack(lses, axis=0), axis=0)
    out = jnp.sum(wts[..., None] * jnp.stack(outs, axis=0).astype(jnp.float32), axis=0)
    return out.astype(v.dtype).reshape(bsz, s, C_WIDTH)


def setup_inputs(seed: int = 0) -> dict:
    key = jax.random.key(seed)
    ks = jax.random.split(key, 16)
    f32 = jnp.float32
    nrm = lambda k, shape, scale: jax.random.normal(k, shape, f32) * scale
    gain = lambda k, shape: 1.0 + 0.02 * jax.random.normal(k, shape, f32)
    dt = jnp.exp(jax.random.uniform(ks[7], (DEPTH, B_HEADS), f32, np.log(1e-3), np.log(1e-1)))
    return {
        "x": jax.random.normal(ks[0], (BATCH, SEQ, D_MODEL), f32),
        "norm1_g": gain(ks[1], (DEPTH, D_MODEL)),
        "w_in": nrm(ks[2], (DEPTH, D_MODEL, IN_TOTAL), D_MODEL ** -0.5),
        "sgu_norm_g": gain(ks[3], (DEPTH, A_GROUPS, HEAD_DIM)),
        "w_spatial": nrm(ks[4], (DEPTH, A_GROUPS, A_CHUNK, A_CHUNK), A_CHUNK ** -0.5),
        "b_spatial": gain(ks[5], (DEPTH, A_GROUPS, A_CHUNK)),
        "conv_w": nrm(ks[6], (DEPTH, B_CONV, 3 * B_WIDTH), B_CONV ** -0.5),
        "a_log": jnp.log(jax.random.uniform(ks[8], (DEPTH, B_HEADS), f32, 1.0, 16.0)),
        "dt_bias": dt + jnp.log(-jnp.expm1(-dt)),
        "o_norm_g": gain(ks[9], (DEPTH, HEAD_DIM)),
        "q_norm_g": gain(ks[10], (DEPTH, HEAD_DIM)),
        "k_norm_g": gain(ks[11], (DEPTH, HEAD_DIM)),
        "w_out": nrm(ks[12], (DEPTH, MIX_WIDTH, D_MODEL), MIX_WIDTH ** -0.5),
        "norm2_g": gain(ks[13], (DEPTH, D_MODEL)),
        "w_gate_up": nrm(ks[14], (DEPTH, D_MODEL, 2 * FFN_HIDDEN), D_MODEL ** -0.5),
        "w_down": nrm(ks[15], (DEPTH, FFN_HIDDEN, D_MODEL), FFN_HIDDEN ** -0.5),
    }


def reference(x, norm1_g, w_in, sgu_norm_g, w_spatial, b_spatial, conv_w, a_log, dt_bias,
              o_norm_g, q_norm_g, k_norm_g, w_out, norm2_g, w_gate_up, w_down):
    slopes = jnp.exp2(-8.0 * (jnp.arange(C_HEADS, dtype=jnp.float32) + 1.0) / C_HEADS)
    offsets = np.cumsum(IN_SIZES)[:-1].tolist()
    for layer in range(DEPTH):
        h = rms_norm(x, norm1_g[layer])
        proj = jnp.einsum('bsd,de->bse', h, w_in[layer])
        (a_u, a_v, b_q, b_k, b_v, b_gate, b_beta, b_a, c_q, c_k, c_v) = jnp.split(proj, offsets, axis=-1)
        y_a = chunked_spatial_gating(a_u, a_v, sgu_norm_g[layer], w_spatial[layer], b_spatial[layer])
        y_b = gated_delta_net(b_q, b_k, b_v, b_gate, b_beta, b_a, conv_w[layer], a_log[layer],
                              dt_bias[layer], o_norm_g[layer])
        y_c = dilated_attention(c_q, c_k, c_v, q_norm_g[layer], k_norm_g[layer], slopes)
        mix = jnp.concatenate([y_a, y_b, y_c], axis=-1)
        x = x + jnp.einsum('bse,ed->bsd', mix, w_out[layer])
        h = rms_norm(x, norm2_g[layer])
        gt, up = jnp.split(jnp.einsum('bsd,df->bsf', h, w_gate_up[layer]), 2, axis=-1)
        x = x + jnp.einsum('bsf,fd->bsd', jax.nn.silu(gt) * up, w_down[layer])
    return x
```

```cpp
#include <hip/hip_runtime.h>
#include <hip/hip_cooperative_groups.h>
#include <cstdio>
#include <cstdint>
namespace cg = cooperative_groups;
namespace pg8 {
#define PG8_LAS __attribute__((address_space(3)))
typedef unsigned short bf16_t;
typedef short bf16x8 __attribute__((ext_vector_type(8)));
typedef float f32x4 __attribute__((ext_vector_type(4)));
typedef unsigned u32x4 __attribute__((ext_vector_type(4)));
constexpr int BM = 256, BK = 64, HALF = 128, HTB = HALF * BK * 2  , STAGE_BYTES = 8 * HTB, NXCD = 8, WGM = 8;

__host__ __device__ __forceinline__ int lds_byte(int r, int c) { const int st = (r >> 4) * 2 + (c >> 5), rr = r & 15, cc = c & 31, ob = rr * 64 + cc * 2; return st * 1024 + (ob ^ (((ob >> 9) & 1) << 5)); }
__host__ __device__ __forceinline__ void stage_rc(int b, int& R, int& C) { const int st = b / 1024, sb = b % 1024, swz = sb ^ (((sb >> 9) & 1) << 5); R = (st >> 1) * 16 + swz / 64; C = (st & 1) * 32 + (swz % 64) / 2; }
__host__ __device__ __forceinline__ int perm32(int rho) { const int n = rho >> 4, i = rho & 15; return 8 * (i >> 2) + 4 * n + (i & 3); }

struct Unit { int pm, pn; };
struct Gemm { const bf16_t* A; const bf16_t* Bt; int M, N, K; };

struct StaticOrder {
    int nM, nN, nwg, G, c;
    __host__ __device__ void init(int M, int N, int G_, int c_) { nM = M / BM; nN = N / BM; nwg = nM * nN; G = G_; c = c_; }
    __host__ __device__ bool next(int i, Unit& u) const {
        const long L = (long)i * G + c; if (L >= nwg) return false;
        int wgid = (int)L; { const int q = nwg / NXCD, r = nwg % NXCD, xcd = wgid % NXCD, off = wgid / NXCD; wgid = (xcd < r ? xcd * (q + 1) : r * (q + 1) + (xcd - r) * q) + off; }
        const int nig = WGM * nN, gid = wgid / nig, fm = gid * WGM, gsz = (nM - fm) < WGM ? (nM - fm) : WGM;
        u.pm = fm + ((wgid % nig) % gsz); u.pn = (wgid % nig) / gsz; return true;
    }
    __device__ __forceinline__ void a_ready(const Unit&) const {}
    __device__ __forceinline__ void done(const Unit&) const {}
};

__device__ __forceinline__ unsigned cvt_pk_bf16(float lo, float hi) { unsigned r; asm volatile("v_cvt_pk_bf16_f32 %0, %1, %2" : "=v"(r) : "v"(lo), "v"(hi)); return r; }
typedef float f32x2 __attribute__((ext_vector_type(2)));
__device__ __forceinline__ f32x2 gelu_pk(f32x2 v) {
    const f32x2 av = __builtin_elementwise_abs(v), d = av * 0.2316418882f + 1.0f;
    f32x2 t; t.x = __builtin_amdgcn_rcpf(d.x); t.y = __builtin_amdgcn_rcpf(d.y);
    f32x2 q = t * 0.5307027145f + (-0.7265760135f); q = q * t + 0.7107068705f; q = q * t + (-0.142248368f); q = q * t + 0.127414796f; q = q * t;
    const f32x2 s = (v * v) * (-0.72134752044f);
    f32x2 e; e.x = __builtin_amdgcn_exp2f(s.x); e.y = __builtin_amdgcn_exp2f(s.y);
    const f32x2 m = v * (q * e), r = v - m;
    f32x2 o; o.x = v.x < 0.f ? m.x : r.x; o.y = v.y < 0.f ? m.y : r.y; return o;
}

template <int ACT  > struct EpiBf16 {
    static constexpr bool PERM = true, AFTER_DRAIN = false; static_assert(ACT == 0 || ACT == 1, "EpiBf16: ACT is 0 (none) or 1 (gelu_pk)");
    bf16_t* O; int ldc; const float* bias; int split_cols; size_t split_stride; float scale0;
    __device__ __forceinline__ void operator()(const f32x4 (&acc)[2][2][4][2], const Unit& u, int wr, int wc, int fr, int fq) const {
        const int row0 = u.pm * BM + wr * 64 + fr; int colt = u.pn * BM; bf16_t* base = O;
        float sc = 1.f; if (split_cols) { const int t = colt / split_cols; base += (size_t)t * split_stride; colt -= t * split_cols; if (t == 0) sc = scale0; }
        const int col0 = colt + wc * 32 + 8 * fq, bcol0 = u.pn * BM + wc * 32 + 8 * fq;
        f32x4 bv[2][2];
#pragma unroll
        for (int bj = 0; bj < 2; ++bj)
#pragma unroll
            for (int n = 0; n < 2; ++n) bv[bj][n] = bias ? *(const f32x4*)(bias + bcol0 + bj * HALF + 4 * n) : (f32x4){0.f, 0.f, 0.f, 0.f};
#pragma unroll
        for (int ai = 0; ai < 2; ++ai)
#pragma unroll
            for (int m = 0; m < 4; ++m) { bf16_t* rowp = base + (size_t)(row0 + ai * HALF + m * 16) * ldc + col0;
#pragma unroll
                for (int bj = 0; bj < 2; ++bj) { f32x4 v0 = acc[ai][bj][m][0] + bv[bj][0], v1 = acc[ai][bj][m][1] + bv[bj][1];
                    if (ACT == 1) { f32x2 a = gelu_pk((f32x2){v0[0], v0[1]}), b = gelu_pk((f32x2){v0[2], v0[3]}), c = gelu_pk((f32x2){v1[0], v1[1]}), d = gelu_pk((f32x2){v1[2], v1[3]});
                        v0 = (f32x4){a.x, a.y, b.x, b.y}; v1 = (f32x4){c.x, c.y, d.x, d.y}; }
                    v0 = v0 * sc; v1 = v1 * sc; u32x4 w; w.x = cvt_pk_bf16(v0[0], v0[1]); w.y = cvt_pk_bf16(v0[2], v0[3]); w.z = cvt_pk_bf16(v1[0], v1[1]); w.w = cvt_pk_bf16(v1[2], v1[3]);
                    *(u32x4*)(rowp + bj * HALF) = w; } }
    }
};
struct EpiResF32 {
    static constexpr bool PERM = false, AFTER_DRAIN = false;
    const float* base; float* out; int ldc;
    __device__ __forceinline__ void operator()(const f32x4 (&acc)[2][2][4][2], const Unit& u, int wr, int wc, int fr, int fq) const {
        const int row0 = u.pm * BM + wr * 64 + fr; const int col0 = u.pn * BM + wc * 32 + 4 * fq;
#pragma unroll
        for (int ai = 0; ai < 2; ++ai)
#pragma unroll
            for (int m = 0; m < 4; ++m) { const size_t off = (size_t)(row0 + ai * HALF + m * 16) * ldc + col0;
#pragma unroll
                for (int bj = 0; bj < 2; ++bj)
#pragma unroll
                    for (int n = 0; n < 2; ++n) { const f32x4 b = *(const f32x4*)(base + off + bj * HALF + n * 16); *(f32x4*)(out + off + bj * HALF + n * 16) = b + acc[ai][bj][m][n]; } }
    }
};
__device__ __forceinline__ float silu_f(float g) { return g * __builtin_amdgcn_rcpf(1.0f + __expf(-g)); }
struct EpiSwiGLU {
    static constexpr bool PERM = true, AFTER_DRAIN = false;
    bf16_t* O; int ldo;
    __device__ __forceinline__ void operator()(const f32x4 (&acc)[2][2][4][2], const Unit& u, int wr, int wc, int fr, int fq) const {
        const int row0 = u.pm * BM + wr * 64 + fr; const int col0 = u.pn * HALF + wc * 32 + 8 * fq;
#pragma unroll
        for (int ai = 0; ai < 2; ++ai)
#pragma unroll
            for (int m = 0; m < 4; ++m) { bf16_t* rowp = O + (size_t)(row0 + ai * HALF + m * 16) * ldo + col0;
                const f32x4 g0 = acc[ai][0][m][0], g1 = acc[ai][0][m][1], u0 = acc[ai][1][m][0], u1 = acc[ai][1][m][1];
                u32x4 w; w.x = cvt_pk_bf16(silu_f(g0[0]) * u0[0], silu_f(g0[1]) * u0[1]); w.y = cvt_pk_bf16(silu_f(g0[2]) * u0[2], silu_f(g0[3]) * u0[3]);
                w.z = cvt_pk_bf16(silu_f(g1[0]) * u1[0], silu_f(g1[1]) * u1[1]); w.w = cvt_pk_bf16(silu_f(g1[2]) * u1[2], silu_f(g1[3]) * u1[3]);
                *(u32x4*)rowp = w; }
    }
};
template <class Epi, class Sched, bool ALIGN_EPI = false, bool SP2 = false>
__device__ __forceinline__ void gemm_phase(PG8_LAS unsigned char* lds, const Gemm g, const Sched& S, const Epi& E) {
    int tid_ = threadIdx.x; asm volatile("" : "+v"(tid_)); const int tid = tid_, wid = __builtin_amdgcn_readfirstlane(tid >> 6), lane = tid & 63, wr = wid >> 2, wc = wid & 3, fr = lane & 15, fq = lane >> 4;
    const int K = g.K, nt = K / BK;
    unsigned voffA[2], voffB[2];
#pragma unroll
    for (int i = 0; i < 2; ++i) { int R, C; stage_rc(tid * 16 + i * 8192, R, C); const int Rb = Epi::PERM ? ((R & ~31) + perm32(R & 31)) : R;
        voffA[i] = (unsigned)(R * K + C) * 2u; voffB[i] = (unsigned)(Rb * K + C) * 2u; }
    const size_t kstep = (size_t)(BK * 2);
    const size_t hstep = (size_t)HALF * K * 2;
    const size_t tstep = 2 * hstep;
    const unsigned ldsw = (unsigned)wid * 1024u;
    const int aoff = lds_byte(wr * 64 + fr, fq * 8), boff = lds_byte(wc * 32 + fr, fq * 8);
#define PG8_SA(b, h) (((b) * 2 + (h)) * HTB)
#define PG8_SB(b, h) ((4 + (b) * 2 + (h)) * HTB)
#define PG8_STAGE(bufoff, gbase, voff) do { _Pragma("unroll") for (int _i = 0; _i < 2; ++_i) \
        __builtin_amdgcn_global_load_lds((const unsigned*)((const char*)(gbase) + (voff)[_i]), (PG8_LAS unsigned*)(lds + (bufoff) + ldsw + _i * 8192), 16, 0, 0); } while (0)
#define PG8_LDA(dst, b, h) do { _Pragma("unroll") for (int m = 0; m < 4; ++m) _Pragma("unroll") for (int k = 0; k < 2; ++k) dst[m][k] = *(const PG8_LAS bf16x8*)(lds + PG8_SA(b, h) + aoff + m * 2048 + k * 1024); } while (0)
#define PG8_LDB(dst, b, h) do { _Pragma("unroll") for (int n = 0; n < 2; ++n) _Pragma("unroll") for (int k = 0; k < 2; ++k) dst[n][k] = *(const PG8_LAS bf16x8*)(lds + PG8_SB(b, h) + boff + n * 2048 + k * 1024); } while (0)
#define PG8_MMA(ai, bj, At, Bt) do { __builtin_amdgcn_s_setprio(1); _Pragma("unroll") for (int m = 0; m < 4; ++m) _Pragma("unroll") for (int n = 0; n < 2; ++n) _Pragma("unroll") for (int k = 0; k < 2; ++k) \
        acc[ai][bj][m][n] = __builtin_amdgcn_mfma_f32_16x16x32_bf16(Bt[n][k], At[m][k], acc[ai][bj][m][n], 0, 0, 0); __builtin_amdgcn_s_setprio(0); } while (0)
#define PG8_WAIT_V(n) asm volatile("s_waitcnt vmcnt(" #n ")" ::: "memory")
#define PG8_WAIT_L(n) asm volatile("s_waitcnt lgkmcnt(" #n ")" ::: "memory")
#define PG8_BAR __builtin_amdgcn_s_barrier()
#define PG8_SCHED __builtin_amdgcn_sched_barrier(0)
    Unit cur, nxt; int ui = 0;
    if (!S.next(0, cur)) return;
    f32x4 acc[2][2][4][2];
#pragma unroll
    for (int a = 0; a < 2; ++a)
#pragma unroll
        for (int b = 0; b < 2; ++b)
#pragma unroll
            for (int m = 0; m < 4; ++m)
#pragma unroll
                for (int n = 0; n < 2; ++n) acc[a][b][m][n] = (f32x4){0.f, 0.f, 0.f, 0.f};
    bf16x8 At[4][2], B0[2][2], B1[2][2];
    const char* cA = (const char*)g.A + (size_t)cur.pm * tstep; const char* cB = (const char*)g.Bt + (size_t)cur.pn * tstep;
    S.a_ready(cur);
    if constexpr (SP2) {
        PG8_STAGE(PG8_SB(0, 0), cB, voffB); PG8_STAGE(PG8_SB(0, 1), cB + hstep, voffB); PG8_STAGE(PG8_SA(0, 0), cA, voffA); PG8_STAGE(PG8_SA(0, 1), cA + hstep, voffA);
        if (wr == 1) PG8_BAR;
        PG8_WAIT_V(2); PG8_BAR;
        PG8_STAGE(PG8_SB(1, 0), cB + kstep, voffB); PG8_STAGE(PG8_SA(1, 0), cA + kstep, voffA); PG8_STAGE(PG8_SB(1, 1), cB + hstep + kstep, voffB);
        PG8_WAIT_V(6); PG8_BAR;
    } else {
        PG8_STAGE(PG8_SB(0, 0), cB, voffB); PG8_STAGE(PG8_SA(0, 0), cA, voffA); PG8_STAGE(PG8_SB(0, 1), cB + hstep, voffB); PG8_STAGE(PG8_SA(0, 1), cA + hstep, voffA);
        if (wr == 1) PG8_BAR;
        PG8_WAIT_V(4); PG8_BAR;
        PG8_STAGE(PG8_SB(1, 0), cB + kstep, voffB); PG8_STAGE(PG8_SA(1, 0), cA + kstep, voffA); PG8_STAGE(PG8_SB(1, 1), cB + hstep + kstep, voffB);
        PG8_WAIT_V(6); PG8_BAR;
    }
    for (;;) {
        const bool has_next = S.next(ui + 1, nxt);
        const char* nA = has_next ? (const char*)g.A + (size_t)nxt.pm * tstep : cA; const char* nB = has_next ? (const char*)g.Bt + (size_t)nxt.pn * tstep : cB;
        for (int t = 0; t < nt; t += 2) {
            const bool last = (t == nt - 2);
            const char* a1 = cA + (size_t)(t + 1) * kstep;
            const char* a2 = last ? nA : cA + (size_t)(t + 2) * kstep; const char* b2 = last ? nB : cB + (size_t)(t + 2) * kstep;
            const char* a3 = a2 + kstep; const char* b3 = b2 + kstep;
            if (last && has_next) S.a_ready(nxt);
            if constexpr (SP2) {
            PG8_LDB(B0, 0, 0); PG8_LDB(B1, 0, 1); PG8_SCHED; PG8_LDA(At, 0, 0); PG8_STAGE(PG8_SA(1, 1), a1 + hstep, voffA);
            PG8_WAIT_V(8); PG8_WAIT_L(0); PG8_BAR; PG8_MMA(0, 0, At, B0); PG8_MMA(0, 1, At, B1); PG8_BAR; PG8_SCHED;
            PG8_LDA(At, 0, 1); PG8_STAGE(PG8_SB(0, 0), b2, voffB); PG8_STAGE(PG8_SB(0, 1), b2 + hstep, voffB); PG8_STAGE(PG8_SA(0, 0), a2, voffA);
            PG8_WAIT_V(8); PG8_WAIT_L(0); PG8_BAR; PG8_MMA(1, 0, At, B0); PG8_MMA(1, 1, At, B1); PG8_BAR; PG8_SCHED;
            PG8_LDB(B0, 1, 0); PG8_LDB(B1, 1, 1); PG8_SCHED; PG8_LDA(At, 1, 0); PG8_STAGE(PG8_SA(0, 1), a2 + hstep, voffA);
            PG8_WAIT_V(8); PG8_WAIT_L(0); PG8_BAR; PG8_MMA(0, 0, At, B0); PG8_MMA(0, 1, At, B1); PG8_BAR; PG8_SCHED;
            PG8_LDA(At, 1, 1); PG8_STAGE(PG8_SB(1, 0), b3, voffB); PG8_STAGE(PG8_SB(1, 1), b3 + hstep, voffB); PG8_STAGE(PG8_SA(1, 0), a3, voffA);
            PG8_WAIT_V(8); PG8_WAIT_L(0); PG8_BAR; PG8_MMA(1, 0, At, B0); PG8_MMA(1, 1, At, B1); PG8_BAR; PG8_SCHED;
            } else {
            PG8_LDB(B0, 0, 0); PG8_SCHED; PG8_LDA(At, 0, 0); PG8_STAGE(PG8_SA(1, 1), a1 + hstep, voffA);
            PG8_WAIT_L(8); PG8_BAR; PG8_WAIT_L(0); PG8_MMA(0, 0, At, B0); PG8_BAR; PG8_SCHED;
            PG8_LDB(B1, 0, 1); PG8_STAGE(PG8_SB(0, 0), b2, voffB);
            PG8_BAR; PG8_WAIT_L(0); PG8_MMA(0, 1, At, B1); PG8_BAR;
            PG8_LDA(At, 0, 1); PG8_STAGE(PG8_SA(0, 0), a2, voffA);
            PG8_BAR; PG8_WAIT_L(0); PG8_MMA(1, 0, At, B0); PG8_BAR; PG8_SCHED;
            PG8_STAGE(PG8_SB(0, 1), b2 + hstep, voffB);
            PG8_WAIT_V(6); PG8_BAR; PG8_MMA(1, 1, At, B1); PG8_BAR;
            PG8_LDB(B0, 1, 0); PG8_SCHED; PG8_LDA(At, 1, 0); PG8_STAGE(PG8_SA(0, 1), a2 + hstep, voffA);
            PG8_WAIT_L(8); PG8_BAR; PG8_WAIT_L(0); PG8_MMA(0, 0, At, B0); PG8_BAR; PG8_SCHED;
            PG8_LDB(B1, 1, 1); PG8_STAGE(PG8_SB(1, 0), b3, voffB);
            PG8_BAR; PG8_WAIT_L(0); PG8_MMA(0, 1, At, B1); PG8_BAR;
            PG8_LDA(At, 1, 1); PG8_STAGE(PG8_SA(1, 0), a3, voffA);
            PG8_BAR; PG8_WAIT_L(0); PG8_MMA(1, 0, At, B0); PG8_BAR; PG8_SCHED;
            PG8_STAGE(PG8_SB(1, 1), b3 + hstep, voffB);
            PG8_WAIT_V(6); PG8_BAR; PG8_MMA(1, 1, At, B1); PG8_BAR;
            }
        }
        if constexpr (ALIGN_EPI) { if (wr == 0) PG8_BAR; }
        if constexpr (!Epi::AFTER_DRAIN) { E(acc, cur, wr, wc, fr, fq); S.done(cur); }
        if (!has_next) break;
#pragma unroll
        for (int a = 0; a < 2; ++a)
#pragma unroll
            for (int b = 0; b < 2; ++b)
#pragma unroll
                for (int m = 0; m < 4; ++m)
#pragma unroll
                    for (int n = 0; n < 2; ++n) acc[a][b][m][n] = (f32x4){0.f, 0.f, 0.f, 0.f};
        cur = nxt; cA = nA; cB = nB; ++ui;
        if constexpr (ALIGN_EPI) { if (wr == 1) PG8_BAR; }
    }
    PG8_WAIT_V(0);
    if constexpr (!ALIGN_EPI) { if (wr == 0) PG8_BAR; }
    PG8_BAR;
    if constexpr (Epi::AFTER_DRAIN) { E.fused(acc, cur, wr, wc, fr, fq, lds, wid, lane); S.done(cur); }
#undef PG8_SA
#undef PG8_SB
#undef PG8_STAGE
#undef PG8_LDA
#undef PG8_LDB
#undef PG8_MMA
#undef PG8_WAIT_V
#undef PG8_WAIT_L
#undef PG8_BAR
#undef PG8_SCHED
}
}
#define DI __device__ __forceinline__
#define LAS __attribute__((address_space(3)))
typedef unsigned short bf16;
typedef short bf16x8 __attribute__((ext_vector_type(8)));
typedef short s16x4 __attribute__((ext_vector_type(4)));
typedef short v4i16_t __attribute__((ext_vector_type(4)));
typedef float f32x4 __attribute__((ext_vector_type(4)));
typedef float f32x2 __attribute__((ext_vector_type(2)));
typedef unsigned u32x4 __attribute__((ext_vector_type(4)));
typedef unsigned u32x2 __attribute__((ext_vector_type(2)));
typedef __bf16 bf16x2_t __attribute__((ext_vector_type(2)));

constexpr int NB = 8, SEQ = 2048, DM = 2048, M = NB * SEQ, DEPTH = 2, HD = 128, NH = 6;
constexpr int NPROJ = 6400, IN_TOTAL = 6412, FF = 5632;
constexpr int C_AU = 0, C_AV = 512, C_BQ = 1024, C_BK = 1792, C_BV = 2560, C_BG = 3328, C_CQ = 4096, C_CK = 4864, C_CV = 5632;
constexpr float EPS = 1e-6f, LOG2E = 1.4426950408889634f, LN2 = 0.6931471805599453f;
enum { I_X = 0, I_N1G, I_WIN, I_SGUG, I_WS, I_BS, I_CONVW, I_ALOG, I_DTB, I_ONG, I_QNG, I_KNG, I_WOUT, I_N2G, I_WGU, I_WDN };

constexpr size_t SZ_WIN = (size_t)NPROJ * DM * 2, SZ_WOUT = (size_t)DM * DM * 2, SZ_WGU = (size_t)2 * FF * DM * 2, SZ_WDN = (size_t)DM * FF * 2;
constexpr size_t SZ_WL = SZ_WIN + SZ_WOUT + SZ_WGU + SZ_WDN;
constexpr size_t WS_W = 0;
constexpr size_t WS_H = WS_W + DEPTH * SZ_WL;
constexpr size_t WS_PROJ = WS_H + (size_t)M * DM * 2;
constexpr size_t WS_BD = WS_PROJ + (size_t)M * NPROJ * 2;
constexpr size_t WS_DN = WS_BD + (size_t)M * 12 * 4;
constexpr int NCHUNK = NB * NH * 32;
constexpr size_t DN_WK = 0, DN_QG = 16384, DN_KDT = 32768, DN_UT = 49152, DN_ATT = 65536, DN_STRIDE = 73728;
constexpr size_t WS_GL = WS_DN + (size_t)NCHUNK * DN_STRIDE;
constexpr size_t WS_ODN = WS_GL + 8192;
constexpr size_t WS_OBR = WS_ODN + (size_t)M * 768 * 4;
constexpr size_t WS_LSE = WS_OBR + (size_t)3 * M * 768 * 2;
constexpr size_t WS_END = WS_LSE + (size_t)3 * M * 6 * 4;
constexpr int LDS_BYTES = 143360;
constexpr int NTHR = 512;
constexpr int NSCAN = 96;

DI unsigned pk2(float lo, float hi) { f32x2 v = {lo, hi}; bf16x2_t b = __builtin_convertvector(v, bf16x2_t); return __builtin_bit_cast(unsigned, b); }
DI float bflo(unsigned w) { return __uint_as_float(w << 16); }
DI float bfhi(unsigned w) { return __uint_as_float(w & 0xffff0000u); }
DI f32x4 mfma16(bf16x8 a, bf16x8 b, f32x4 c) { return __builtin_amdgcn_mfma_f32_16x16x32_bf16(a, b, c, 0, 0, 0); }
DI s16x4 tr4(const LAS unsigned char* p) { return __builtin_bit_cast(s16x4, __builtin_amdgcn_ds_read_tr16_b64_v4i16((LAS v4i16_t*)p)); }
DI bf16x8 tr_frag(const LAS unsigned char* p0, const LAS unsigned char* p1) { const s16x4 lo = tr4(p0), hi = tr4(p1); return __builtin_shufflevector(lo, hi, 0, 1, 2, 3, 4, 5, 6, 7); }
DI bf16x8 ld_frag(const LAS unsigned char* p) { return *(const LAS bf16x8*)p; }
DI int opaque(int x) { asm volatile("" : "+v"(x)); return x; }
DI float wave_sum(float v) {
#pragma unroll
    for (int o = 1; o < 64; o <<= 1) v += __shfl_xor(v, o);
    return v;
}
DI float sigmoid_f(float x) { return __builtin_amdgcn_rcpf(1.0f + __expf(-x)); }
DI float silu_f(float x) { return x * sigmoid_f(x); }
DI float gelu_tanh(float x) { const float u = 0.7978845608028654f * (x + 0.044715f * x * x * x); return x * sigmoid_f(2.0f * u); }
DI void unpack8(const u32x4 w, float* f) { f[0] = bflo(w.x); f[1] = bfhi(w.x); f[2] = bflo(w.y); f[3] = bfhi(w.y); f[4] = bflo(w.z); f[5] = bfhi(w.z); f[6] = bflo(w.w); f[7] = bfhi(w.w); }
DI u32x4 pack8(const float* f) { u32x4 w; w.x = pk2(f[0], f[1]); w.y = pk2(f[2], f[3]); w.z = pk2(f[4], f[5]); w.w = pk2(f[6], f[7]); return w; }
DI u32x2 pack4(const f32x4 v) { u32x2 w; w.x = pk2(v[0], v[1]); w.y = pk2(v[2], v[3]); return w; }

DI void transpose_item(const float* W, int K, int Nsrc, int src_col0, bf16* WT, int dst_row0, int k0, LAS float* scr, int lane) {
#pragma unroll 8
    for (int i = 0; i < 32; ++i) { const int kk = 2 * i + (lane >> 5); scr[kk * 33 + (lane & 31)] = W[(size_t)(k0 + kk) * Nsrc + src_col0 + (lane & 31)]; }
    asm volatile("s_waitcnt lgkmcnt(0)" ::: "memory");
    const int c = lane & 7;
#pragma unroll
    for (int j = 0; j < 4; ++j) { const int n = (lane >> 3) + 8 * j; const LAS float* s = scr + (8 * c) * 33 + n;
        u32x4 o; o.x = pk2(s[0 * 33], s[1 * 33]); o.y = pk2(s[2 * 33], s[3 * 33]); o.z = pk2(s[4 * 33], s[5 * 33]); o.w = pk2(s[6 * 33], s[7 * 33]);
        *(u32x4*)(WT + (size_t)(dst_row0 + n) * K + k0 + 8 * c) = o; }
    asm volatile("s_waitcnt lgkmcnt(0)" ::: "memory");
}
DI void weight_prep(const float* const* in, unsigned char* ws, LAS unsigned char* lds, int gw, int ngw, int wave, int lane) {
    LAS float* scr = (LAS float*)(lds + wave * 16384);
    constexpr int I_IN = (DM / 64) * (NPROJ / 32), I_OUT = (DM / 64) * (DM / 32), I_GU = (DM / 64) * (2 * FF / 32), I_DN = (FF / 64) * (DM / 32);
    constexpr int PER_L = I_IN + I_OUT + I_GU + I_DN;
    for (int it = gw; it < DEPTH * PER_L; it += ngw) {
        const int l = it / PER_L; int r = it % PER_L;
        unsigned char* wl = ws + WS_W + (size_t)l * SZ_WL;
        if (r < I_IN) { const int nblk = NPROJ / 32, kb = r / nblk, nb = r % nblk, n0 = nb * 32;
            transpose_item(in[I_WIN] + (size_t)l * DM * IN_TOTAL, DM, IN_TOTAL, n0 < 4096 ? n0 : n0 + 12, (bf16*)wl, n0, kb * 64, scr, lane); continue; }
        r -= I_IN;
        if (r < I_OUT) { const int nblk = DM / 32, kb = r / nblk, nb = r % nblk, n0 = nb * 32;
            transpose_item(in[I_WOUT] + (size_t)l * DM * DM, DM, DM, n0, (bf16*)(wl + SZ_WIN), n0, kb * 64, scr, lane); continue; }
        r -= I_OUT;
        if (r < I_GU) { const int nblk = 2 * FF / 32, kb = r / nblk, nb = r % nblk, n0 = nb * 32, pn = n0 >> 8, j = n0 & 255;
            transpose_item(in[I_WGU] + (size_t)l * DM * 2 * FF, DM, 2 * FF, j < 128 ? 128 * pn + j : FF + 128 * pn + (j - 128), (bf16*)(wl + SZ_WIN + SZ_WOUT), n0, kb * 64, scr, lane); continue; }
        r -= I_GU;
        { const int nblk = DM / 32, kb = r / nblk, nb = r % nblk, n0 = nb * 32;
            transpose_item(in[I_WDN] + (size_t)l * FF * DM, FF, DM, n0, (bf16*)(wl + SZ_WIN + SZ_WOUT + SZ_WGU), n0, kb * 64, scr, lane); }
    }
}

DI void norm_phase(const float* x, const float* g, bf16* h, const float* w_in_l, float* bd, LAS unsigned char* lds, int gw, int ngw, int tid0, int lane0) {
    const int tid = opaque(tid0), lane = tid & 63; (void)lane0;
    LAS f32x4* wl = (LAS f32x4*)lds;
    if (w_in_l) {
        for (int k = tid; k < DM; k += NTHR) {
            const f32x4* src = (const f32x4*)(w_in_l + (size_t)k * IN_TOTAL + 4096);
            const f32x4 a = src[0], b = src[1], c = src[2];
            const int j = k >> 8, l = (k >> 2) & 63, e = k & 3;
            LAS float* dst = (LAS float*)lds + ((size_t)(j * 12) * 64 + l) * 4 + e;
            dst[0 * 256] = a[0]; dst[1 * 256] = a[1]; dst[2 * 256] = a[2]; dst[3 * 256] = a[3];
            dst[4 * 256] = b[0]; dst[5 * 256] = b[1]; dst[6 * 256] = b[2]; dst[7 * 256] = b[3];
            dst[8 * 256] = c[0]; dst[9 * 256] = c[1]; dst[10 * 256] = c[2]; dst[11 * 256] = c[3];
        }
        __syncthreads();
    }
    f32x4 gv[8];
#pragma unroll
    for (int j = 0; j < 8; ++j) gv[j] = ((const f32x4*)g)[64 * j + lane];
    for (int row = gw; row < M; row += ngw) {
        const f32x4* xr = (const f32x4*)(x + (size_t)row * DM) + lane;
        f32x4 v[8]; float s = 0.f;
#pragma unroll
        for (int j = 0; j < 8; ++j) { v[j] = xr[64 * j]; s += (v[j][0] * v[j][0] + v[j][1] * v[j][1]) + (v[j][2] * v[j][2] + v[j][3] * v[j][3]); }
        const float rs = 1.0f / sqrtf(wave_sum(s) * (1.0f / DM) + EPS);
        u32x2* o8 = (u32x2*)(h + (size_t)row * DM) + lane;
#pragma unroll
        for (int j = 0; j < 8; ++j) { v[j] = v[j] * rs * gv[j]; u32x2 w; w.x = pk2(v[j][0], v[j][1]); w.y = pk2(v[j][2], v[j][3]); o8[64 * j] = w; }
        if (w_in_l) {
            float outv = 0.f;
            asm volatile("" ::: "memory");
#pragma unroll 1
            for (int c = 0; c < 12; ++c) {
                float acc = 0.f;
#pragma unroll
                for (int j = 0; j < 8; ++j) { const f32x4 w = wl[(j * 12 + c) * 64 + lane]; acc += (v[j][0] * w[0] + v[j][1] * w[1]) + (v[j][2] * w[2] + v[j][3] * w[3]); }
                acc = wave_sum(acc);
                if (lane == c) outv = acc;
            }
            if (lane < 12) bd[(size_t)row * 12 + lane] = outv;
        }
    }
    if (w_in_l) __syncthreads();
}
DI void sgu_item(int item, const bf16* proj, const float* sgu_g, const float* w_s, const float* b_s, bf16* mix, LAS unsigned char* lds, int tid0) {
    const int tid = opaque(tid0);
    const int g = item & 3, c = (item >> 2) & 15, b = item >> 6;
    const size_t row0 = (size_t)b * SEQ + c * 128;
    LAS unsigned char* Vimg = lds; LAS unsigned char* Wimg = lds + 128 * 272;
    {
        const int i = tid >> 2, p = tid & 3;
        const bf16* src = proj + (row0 + i) * NPROJ + C_AV + g * 128 + p * 32;
        float y[32]; float ss = 0.f;
#pragma unroll
        for (int e = 0; e < 4; ++e) { const u32x4 raw = *(const u32x4*)(src + 8 * e); unpack8(raw, y + 8 * e); }
#pragma unroll
        for (int e = 0; e < 32; ++e) { y[e] = gelu_tanh(y[e]); ss += y[e] * y[e]; }
        ss += __shfl_xor(ss, 1); ss += __shfl_xor(ss, 2);
        const float rs = 1.0f / sqrtf(ss * (1.0f / 128.0f) + EPS);
        const float* gg = sgu_g + g * 128 + p * 32;
#pragma unroll
        for (int e = 0; e < 4; ++e) { float t[8];
#pragma unroll
            for (int k = 0; k < 8; ++k) t[k] = y[8 * e + k] * rs * gg[8 * e + k];
            *(LAS u32x4*)(Vimg + i * 272 + p * 64 + e * 16) = pack8(t); }
        const float* wsrc = w_s + ((size_t)g * 128 + i) * 128 + p * 32;
#pragma unroll
        for (int e = 0; e < 4; ++e) { const f32x4 a = *(const f32x4*)(wsrc + 8 * e), bb = *(const f32x4*)(wsrc + 8 * e + 4); float t[8];
#pragma unroll
            for (int k = 0; k < 4; ++k) { t[k] = (p * 32 + 8 * e + k <= i) ? a[k] : 0.f; t[4 + k] = (p * 32 + 8 * e + 4 + k <= i) ? bb[k] : 0.f; }
            *(LAS u32x4*)(Wimg + i * 272 + p * 64 + e * 16) = pack8(t); }
    }
    __syncthreads();
    const int w = tid >> 6, lane = tid & 63, r = lane & 15, q = lane >> 4;
    f32x4 acc[8];
#pragma unroll
    for (int dt = 0; dt < 8; ++dt) acc[dt] = (f32x4){0.f, 0.f, 0.f, 0.f};
    const int nks = (16 * (w + 1) + 31) >> 5;
    for (int ks = 0; ks < nks; ++ks) {
        const bf16x8 bfr = ld_frag(Wimg + (16 * w + r) * 272 + (32 * ks + 8 * q) * 2);
#pragma unroll
        for (int dt = 0; dt < 8; ++dt) { const LAS unsigned char* p0 = Vimg + (32 * ks + 8 * q + (r >> 2)) * 272 + (16 * dt + 4 * (r & 3)) * 2;
            acc[dt] = mfma16(tr_frag(p0, p0 + 4 * 272), bfr, acc[dt]); }
    }
    const int i = 16 * w + r; const float bsv = b_s[g * 128 + i];
    const bf16* up = proj + (row0 + i) * NPROJ + C_AU + g * 128 + 4 * q;
    bf16* op = mix + (row0 + i) * DM + g * 128 + 4 * q;
#pragma unroll
    for (int dt = 0; dt < 8; ++dt) { const u32x2 uu = *(const u32x2*)(up + 16 * dt);
        f32x4 o; o[0] = gelu_tanh(bflo(uu.x)) * (acc[dt][0] + bsv); o[1] = gelu_tanh(bfhi(uu.x)) * (acc[dt][1] + bsv); o[2] = gelu_tanh(bflo(uu.y)) * (acc[dt][2] + bsv); o[3] = gelu_tanh(bfhi(uu.y)) * (acc[dt][3] + bsv);
        *(u32x2*)(op + 16 * dt) = pack4(o); }
    __syncthreads();
}

DI void attn_item(int item, const bf16* proj, const float* qg, const float* kg, bf16* obr, float* lse, LAS unsigned char* lds, int tid0) {
    const int tid = opaque(tid0);
    const int sub = item % 48, bh = item / 48, h = bh % NH, b = bh / NH;
    int br, rr, n;
    if (sub < 16) { br = 0; rr = 0; n = sub; } else if (sub < 32) { br = 1; rr = (sub - 16) >> 2; n = (sub - 16) & 3; } else { br = 2; rr = sub - 32; n = 0; }
    const int dil = 1 << (2 * br);
    LAS unsigned char* Kimg = lds; LAS unsigned char* Vimg = lds + 256 * 272;
    const bf16* base = proj + (size_t)b * SEQ * NPROJ + h * 128;
    {
        const int piece = tid & 15;
        float kgv[8];
#pragma unroll
        for (int e = 0; e < 8; ++e) kgv[e] = kg[piece * 8 + e];
#pragma unroll 2
        for (int i = 0; i < 8; ++i) {
            const int row = (tid >> 4) + 32 * i, L = (n - 1) * 128 + row;
            u32x4 kv = {0u, 0u, 0u, 0u}, vv = {0u, 0u, 0u, 0u};
            if (L >= 0) { const bf16* p = base + (size_t)(L * dil + rr) * NPROJ + piece * 8; kv = *(const u32x4*)(p + C_CK); vv = *(const u32x4*)(p + C_CV); }
            float kf[8]; unpack8(kv, kf); float ss = 0.f;
#pragma unroll
            for (int e = 0; e < 8; ++e) ss += kf[e] * kf[e];
            ss += __shfl_xor(ss, 1); ss += __shfl_xor(ss, 2); ss += __shfl_xor(ss, 4); ss += __shfl_xor(ss, 8);
            const float rs = 1.0f / sqrtf(ss * (1.0f / 128.0f) + EPS);
#pragma unroll
            for (int e = 0; e < 8; ++e) kf[e] = kf[e] * rs * kgv[e];
            *(LAS u32x4*)(Kimg + row * 272 + piece * 16) = pack8(kf);
            *(LAS u32x4*)(Vimg + row * 272 + piece * 16) = vv;
        }
    }
    const int w = tid >> 6, lane = tid & 63, r = lane & 15, q = lane >> 4;
    const int qi = 16 * w + r, tokq = (n * 128 + qi) * dil + rr;
    bf16x8 qf[4];
    {
        const bf16* qp = base + (size_t)tokq * NPROJ + C_CQ + 8 * q;
        float qv[32]; float ss = 0.f;
#pragma unroll
        for (int s = 0; s < 4; ++s) { const u32x4 raw = *(const u32x4*)(qp + 32 * s); unpack8(raw, qv + 8 * s); }
#pragma unroll
        for (int e = 0; e < 32; ++e) ss += qv[e] * qv[e];
        ss += __shfl_xor(ss, 16); ss += __shfl_xor(ss, 32);
        const float rs = (1.0f / sqrtf(ss * (1.0f / 128.0f) + EPS)) * (0.08838834764831845f * LOG2E);
#pragma unroll
        for (int s = 0; s < 4; ++s) { float t[8];
#pragma unroll
            for (int e = 0; e < 8; ++e) t[e] = qv[8 * s + e] * rs * qg[32 * s + 8 * q + e];
            qf[s] = __builtin_bit_cast(bf16x8, pack8(t)); }
    }
    __syncthreads();
    const int kt0 = 2 * (w >> 1);
    f32x4 sc[10];
#pragma unroll
    for (int t = 0; t < 10; ++t) { f32x4 a4 = {0.f, 0.f, 0.f, 0.f};
#pragma unroll
        for (int s = 0; s < 4; ++s) a4 = mfma16(ld_frag(Kimg + (16 * (kt0 + t) + r) * 272 + (32 * s + 8 * q) * 2), qf[s], a4);
        sc[t] = a4; }
    const float sl2 = exp2f(-8.0f * (float)(h + 1) / 6.0f) * (float)dil * LOG2E;
    float mx = -INFINITY;
#pragma unroll
    for (int t = 0; t < 10; ++t)
#pragma unroll
        for (int jj = 0; jj < 4; ++jj) { const int kj = 16 * (kt0 + t) + 4 * q + jj, delta = 128 + qi - kj;
            const bool valid = (delta >= 0) && (delta <= 128) && (n > 0 || kj >= 128);
            const float v = valid ? sc[t][jj] - sl2 * (float)delta : -INFINITY; sc[t][jj] = v; mx = fmaxf(mx, v); }
    mx = fmaxf(mx, __shfl_xor(mx, 16)); mx = fmaxf(mx, __shfl_xor(mx, 32));
    float l = 0.f;
#pragma unroll
    for (int t = 0; t < 10; ++t)
#pragma unroll
        for (int jj = 0; jj < 4; ++jj) { const float p = __builtin_amdgcn_exp2f(sc[t][jj] - mx); sc[t][jj] = p; l += p; }
    l += __shfl_xor(l, 16); l += __shfl_xor(l, 32);
    bf16x8 pf[5];
#pragma unroll
    for (int pp = 0; pp < 5; ++pp) { u32x4 wv; wv.x = pk2(sc[2 * pp][0], sc[2 * pp][1]); wv.y = pk2(sc[2 * pp][2], sc[2 * pp][3]); wv.z = pk2(sc[2 * pp + 1][0], sc[2 * pp + 1][1]); wv.w = pk2(sc[2 * pp + 1][2], sc[2 * pp + 1][3]);
        pf[pp] = __builtin_bit_cast(bf16x8, wv); }
    f32x4 o[8];
#pragma unroll
    for (int dt = 0; dt < 8; ++dt) o[dt] = (f32x4){0.f, 0.f, 0.f, 0.f};
#pragma unroll
    for (int pp = 0; pp < 5; ++pp)
#pragma unroll
        for (int dt = 0; dt < 8; ++dt) { const LAS unsigned char* p0 = Vimg + (16 * (kt0 + 2 * pp) + 4 * q + (r >> 2)) * 272 + (16 * dt + 4 * (r & 3)) * 2;
            o[dt] = mfma16(tr_frag(p0, p0 + 16 * 272), pf[pp], o[dt]); }
    const float inv = 1.0f / l;
    const size_t orow = (size_t)br * M + (size_t)b * SEQ + tokq;
    bf16* op = obr + orow * 768 + h * 128 + 4 * q;
#pragma unroll
    for (int dt = 0; dt < 8; ++dt) *(u32x2*)(op + 16 * dt) = pack4(o[dt] * inv);
    if (q == 0) lse[orow * 6 + h] = (mx + __builtin_amdgcn_logf(l)) * LN2;
    __syncthreads();
}
DI void attn_combine(const bf16* obr, const float* lse, bf16* mix, int gi0, int nthreads) {
    const int gi = opaque(gi0);
    for (int idx = gi; idx < M * 96; idx += nthreads) {
        const int row = idx / 96, c8 = idx % 96, h = c8 >> 4;
        const float l0 = lse[((size_t)0 * M + row) * 6 + h], l1 = lse[((size_t)1 * M + row) * 6 + h], l2 = lse[((size_t)2 * M + row) * 6 + h];
        const float mx = fmaxf(l0, fmaxf(l1, l2));
        float w0 = __expf(l0 - mx), w1 = __expf(l1 - mx), w2 = __expf(l2 - mx); const float inv = 1.0f / (w0 + w1 + w2); w0 *= inv; w1 *= inv; w2 *= inv;
        float a[8], bq[8], c[8];
        unpack8(*(const u32x4*)(obr + ((size_t)0 * M + row) * 768 + c8 * 8), a); unpack8(*(const u32x4*)(obr + ((size_t)1 * M + row) * 768 + c8 * 8), bq); unpack8(*(const u32x4*)(obr + ((size_t)2 * M + row) * 768 + c8 * 8), c);
#pragma unroll
        for (int e = 0; e < 8; ++e) a[e] = w0 * a[e] + w1 * bq[e] + w2 * c[e];
        *(u32x4*)(mix + (size_t)row * DM + 1280 + c8 * 8) = pack8(a);
    }
}
DI void dn_conv16(const bf16* proj, int b, int tpos, int col, const float* cw, float* y) {
    float acc[16];
#pragma unroll
    for (int e = 0; e < 16; ++e) acc[e] = 0.f;
#pragma unroll
    for (int j = 0; j < 4; ++j) { const int tt = tpos - 3 + j;
        u32x4 x0 = {0u, 0u, 0u, 0u}, x1 = {0u, 0u, 0u, 0u};
        if (tt >= 0) { const bf16* p = proj + ((size_t)b * SEQ + tt) * NPROJ + col; x0 = *(const u32x4*)p; x1 = *(const u32x4*)(p + 8); }
        float xf[16]; unpack8(x0, xf); unpack8(x1, xf + 8);
        const f32x4* wp = (const f32x4*)(cw + (size_t)j * 2304);
#pragma unroll
        for (int e4 = 0; e4 < 4; ++e4) { const f32x4 wv = wp[e4];
#pragma unroll
            for (int k = 0; k < 4; ++k) acc[4 * e4 + k] += wv[k] * xf[4 * e4 + k]; } }
#pragma unroll
    for (int e = 0; e < 16; ++e) y[e] = silu_f(acc[e]);
}
DI void dn_prep_item(int item, const bf16* proj, const float* bd, const float* conv_w, const float* a_log, const float* dt_bias, unsigned char* dnall, float* gl_out, LAS unsigned char* lds, int tid0) {
    const int tid = opaque(tid0);
    const int n = item & 31, bh = item >> 5, h = bh % NH, b = bh / NH, t0 = 64 * n;
    unsigned char* dn = dnall + (size_t)item * DN_STRIDE;
    LAS unsigned char* Kimg = lds; LAS unsigned char* Qimg = lds + 17408; LAS unsigned char* KBG = lds + 34816; LAS unsigned char* VB = lds + 52224;
    LAS unsigned char* Amat = lds + 69632; LAS unsigned char* Timg = lds + 87040; LAS float* G = (LAS float*)(lds + 96256); LAS float* BETA = (LAS float*)(lds + 96512);
    const int w = tid >> 6, lane = tid & 63, r = lane & 15, q = lane >> 4;
    if (w == 0) {
        const size_t row = (size_t)b * SEQ + t0 + lane;
        const float bl = bd[row * 12 + h], av = bd[row * 12 + 6 + h];
        const float xx = av + dt_bias[h];
        const float sp = xx > 20.f ? xx : log1pf(expf(xx));
        float gs = -expf(a_log[h]) * sp;
#pragma unroll
        for (int o = 1; o < 64; o <<= 1) { const float t = __shfl_up(gs, o); if (lane >= o) gs += t; }
        G[lane] = gs; BETA[lane] = 1.0f / (1.0f + expf(-bl));
    }
    __syncthreads();
    {
        const int i = tid >> 3, p = tid & 7;
        const float gi = G[i], bi = BETA[i], eg = expf(gi);
        float y[16];
        dn_conv16(proj, b, t0 + i, C_BQ + h * 128 + 16 * p, conv_w + h * 128 + 16 * p, y);
        { float ss = 0.f;
#pragma unroll
            for (int e = 0; e < 16; ++e) ss += y[e] * y[e];
            ss += __shfl_xor(ss, 1); ss += __shfl_xor(ss, 2); ss += __shfl_xor(ss, 4);
            const float rs = (1.0f / sqrtf(ss + EPS)) * 0.08838834764831845f;
            float t[16], tg[16];
#pragma unroll
            for (int e = 0; e < 16; ++e) { t[e] = y[e] * rs; tg[e] = t[e] * eg; }
            *(LAS u32x4*)(Qimg + i * 272 + p * 32) = pack8(t); *(LAS u32x4*)(Qimg + i * 272 + p * 32 + 16) = pack8(t + 8);
            *(u32x4*)(dn + DN_QG + (i * 128 + 16 * p) * 2) = pack8(tg); *(u32x4*)(dn + DN_QG + (i * 128 + 16 * p + 8) * 2) = pack8(tg + 8); }
        dn_conv16(proj, b, t0 + i, C_BK + h * 128 + 16 * p, conv_w + 768 + h * 128 + 16 * p, y);
        { float ss = 0.f;
#pragma unroll
            for (int e = 0; e < 16; ++e) ss += y[e] * y[e];
            ss += __shfl_xor(ss, 1); ss += __shfl_xor(ss, 2); ss += __shfl_xor(ss, 4);
            const float rs = 1.0f / sqrtf(ss + EPS);
            float t[16], tg[16];
#pragma unroll
            for (int e = 0; e < 16; ++e) { t[e] = y[e] * rs; tg[e] = t[e] * (bi * eg); }
            *(LAS u32x4*)(Kimg + i * 272 + p * 32) = pack8(t); *(LAS u32x4*)(Kimg + i * 272 + p * 32 + 16) = pack8(t + 8);
            *(LAS u32x4*)(KBG + i * 272 + p * 32) = pack8(tg); *(LAS u32x4*)(KBG + i * 272 + p * 32 + 16) = pack8(tg + 8); }
        dn_conv16(proj, b, t0 + i, C_BV + h * 128 + 16 * p, conv_w + 1536 + h * 128 + 16 * p, y);
        { float t[16];
#pragma unroll
            for (int e = 0; e < 16; ++e) t[e] = y[e] * bi;
            *(LAS u32x4*)(VB + i * 272 + p * 32) = pack8(t); *(LAS u32x4*)(VB + i * 272 + p * 32 + 16) = pack8(t + 8); }
    }
    __syncthreads();
    {
        const int it = w & 3;
        const int i = 16 * it + r; const float gi = G[i], bi = BETA[i];
#pragma unroll
        for (int e = 0; e < 2; ++e) { const int jt = 2 * (w >> 2) + e;
            f32x4 kk = {0.f, 0.f, 0.f, 0.f}, qk = {0.f, 0.f, 0.f, 0.f};
#pragma unroll
            for (int s = 0; s < 4; ++s) { const bf16x8 a = ld_frag(Kimg + (16 * jt + r) * 272 + (32 * s + 8 * q) * 2);
                kk = mfma16(a, ld_frag(Kimg + (16 * it + r) * 272 + (32 * s + 8 * q) * 2), kk);
                qk = mfma16(a, ld_frag(Qimg + (16 * it + r) * 272 + (32 * s + 8 * q) * 2), qk); }
            f32x4 av, at;
#pragma unroll
            for (int jj = 0; jj < 4; ++jj) { const int j = 16 * jt + 4 * q + jj; const float dec = (j <= i) ? expf(gi - G[j]) : 0.f;
                av[jj] = (j < i) ? bi * kk[jj] * dec : 0.f; at[jj] = qk[jj] * dec; }
            *(LAS f32x4*)(Amat + i * 272 + (16 * jt + 4 * q) * 4) = av;
            *(u32x2*)(dn + DN_ATT + (i * 64 + 16 * jt + 4 * q) * 2) = pack4(at); }
    }
    __syncthreads();
#ifndef NO_TINV
    if (w == 0) {
        LAS float* Tl = (LAS float*)(lds + 96768);
#pragma unroll 1
        for (int i = 0; i < 64; ++i) {
            const LAS float* arow = (const LAS float*)(Amat + i * 272);
            float s0 = arow[lane], s1 = 0.f, s2 = 0.f, s3 = 0.f;
            int j = 0;
            for (; j + 3 < i; j += 4) { const f32x4 a4 = *(const LAS f32x4*)(arow + j);
                s0 += a4[0] * Tl[(j + 0) * 64 + lane]; s1 += a4[1] * Tl[(j + 1) * 64 + lane]; s2 += a4[2] * Tl[(j + 2) * 64 + lane]; s3 += a4[3] * Tl[(j + 3) * 64 + lane]; }
            for (; j < i; ++j) s0 += arow[j] * Tl[j * 64 + lane];
            const float t = -((s0 + s1) + (s2 + s3));
            Tl[i * 64 + lane] = t;
            *(LAS unsigned short*)(Timg + i * 144 + lane * 2) = (unsigned short)(pk2(t, 0.f) & 0xffffu);
        }
        asm volatile("s_waitcnt lgkmcnt(0)" ::: "memory");
        *(LAS unsigned short*)(Timg + lane * 144 + lane * 2) = (unsigned short)0x3F80u;
    }
#endif
    __syncthreads();
    {
        const int ct = w & 3; const float glast = G[63];
        bf16x8 tf[2];
#pragma unroll
        for (int ks = 0; ks < 2; ++ks) tf[ks] = ld_frag(Timg + (16 * ct + r) * 144 + (32 * ks + 8 * q) * 2);
        float dk4[4];
#pragma unroll
        for (int jj = 0; jj < 4; ++jj) dk4[jj] = expf(glast - G[16 * ct + 4 * q + jj]);
#pragma unroll
        for (int e = 0; e < 4; ++e) { const int dt = 4 * (w >> 2) + e;
            f32x4 au = {0.f, 0.f, 0.f, 0.f}, aw = {0.f, 0.f, 0.f, 0.f};
#pragma unroll
            for (int ks = 0; ks < 2; ++ks) { const int ro = (32 * ks + 8 * q + (r >> 2)) * 272 + (16 * dt + 4 * (r & 3)) * 2;
                au = mfma16(tf[ks], tr_frag(VB + ro, VB + ro + 4 * 272), au);
                aw = mfma16(tr_frag(KBG + ro, KBG + ro + 4 * 272), tf[ks], aw); }
            *(u32x2*)(dn + DN_UT + ((16 * dt + r) * 64 + 16 * ct + 4 * q) * 2) = pack4(au);
            *(u32x2*)(dn + DN_WK + ((16 * ct + r) * 128 + 16 * dt + 4 * q) * 2) = pack4(aw);
            const s16x4 kv = tr4(Kimg + (16 * ct + 4 * q + (r >> 2)) * 272 + (16 * dt + 4 * (r & 3)) * 2);
            f32x4 kd;
#pragma unroll
            for (int jj = 0; jj < 4; ++jj) kd[jj] = __uint_as_float(((unsigned)(unsigned short)kv[jj]) << 16) * dk4[jj];
            *(u32x2*)(dn + DN_KDT + ((16 * dt + r) * 64 + 16 * ct + 4 * q) * 2) = pack4(kd); }
        if (tid == 0) gl_out[item] = expf(glast);
    }
    __syncthreads();
}
DI void dn_scan_item(int item, const unsigned char* dnall, const float* gl, float* odn, LAS unsigned char* lds, int tid0) {
    const int tid = opaque(tid0);
    const int dvs = item & 1, bh = item >> 1, h = bh % NH, b = bh / NH;
    LAS unsigned char* Simg = lds; LAS unsigned char* VNT = lds + 18432;
    for (int u = tid; u < 18432 / 16; u += NTHR) *(LAS u32x4*)(Simg + u * 16) = (u32x4){0u, 0u, 0u, 0u};
    const int w = tid >> 6, lane = tid & 63, r = lane & 15, q = lane >> 4;
    const int ct = w >> 1, dvt0 = 2 * (w & 1), mt = w & 3, nt0 = 4 * (w >> 2);
    f32x4 Sacc[4];
#pragma unroll
    for (int e = 0; e < 4; ++e) Sacc[e] = (f32x4){0.f, 0.f, 0.f, 0.f};
    __syncthreads();
#pragma unroll 1
    for (int n = 0; n < 32; ++n) {
        const unsigned char* dn = dnall + (size_t)(bh * 32 + n) * DN_STRIDE;
        f32x4 wsa[2], qsa[2];
#pragma unroll
        for (int e = 0; e < 2; ++e) { wsa[e] = (f32x4){0.f, 0.f, 0.f, 0.f}; qsa[e] = (f32x4){0.f, 0.f, 0.f, 0.f}; }
#pragma unroll
        for (int ks = 0; ks < 4; ++ks) {
            const bf16x8 wf = *(const bf16x8*)(dn + DN_WK + ((16 * ct + r) * 128 + 32 * ks + 8 * q) * 2);
            const bf16x8 qf = *(const bf16x8*)(dn + DN_QG + ((16 * ct + r) * 128 + 32 * ks + 8 * q) * 2);
#pragma unroll
            for (int e = 0; e < 2; ++e) { const LAS unsigned char* p0 = Simg + (32 * ks + 8 * q + (r >> 2)) * 144 + (16 * (dvt0 + e) + 4 * (r & 3)) * 2;
                const bf16x8 sf = tr_frag(p0, p0 + 4 * 144);
                wsa[e] = mfma16(wf, sf, wsa[e]); qsa[e] = mfma16(qf, sf, qsa[e]); }
        }
#pragma unroll
        for (int e = 0; e < 2; ++e) { const int dv = 16 * (dvt0 + e) + r;
            const u32x2 uu = *(const u32x2*)(dn + DN_UT + ((dvs * 64 + dv) * 64 + 16 * ct + 4 * q) * 2);
            f32x4 vn; vn[0] = bflo(uu.x) - wsa[e][0]; vn[1] = bfhi(uu.x) - wsa[e][1]; vn[2] = bflo(uu.y) - wsa[e][2]; vn[3] = bfhi(uu.y) - wsa[e][3];
            *(LAS u32x2*)(VNT + dv * 144 + (16 * ct + 4 * q) * 2) = pack4(vn); }
        __syncthreads();
#pragma unroll
        for (int ks = 0; ks < 2; ++ks) { const bf16x8 af = *(const bf16x8*)(dn + DN_ATT + ((16 * ct + r) * 64 + 32 * ks + 8 * q) * 2);
#pragma unroll
            for (int e = 0; e < 2; ++e) qsa[e] = mfma16(af, ld_frag(VNT + (16 * (dvt0 + e) + r) * 144 + (32 * ks + 8 * q) * 2), qsa[e]); }
        {
            float* op = odn + ((size_t)b * SEQ + 64 * n + 16 * ct + 4 * q) * 768 + h * 128 + dvs * 64 + r;
#pragma unroll
            for (int e = 0; e < 2; ++e)
#pragma unroll
                for (int jj = 0; jj < 4; ++jj) op[(size_t)jj * 768 + 16 * (dvt0 + e)] = qsa[e][jj];
        }
        const float g = gl[bh * 32 + n];
        bf16x8 af2[2];
#pragma unroll
        for (int ks = 0; ks < 2; ++ks) af2[ks] = ld_frag(VNT + (16 * mt + r) * 144 + (32 * ks + 8 * q) * 2);
#pragma unroll
        for (int e = 0; e < 4; ++e) { Sacc[e] = Sacc[e] * g;
#pragma unroll
            for (int ks = 0; ks < 2; ++ks) Sacc[e] = mfma16(af2[ks], *(const bf16x8*)(dn + DN_KDT + ((16 * (nt0 + e) + r) * 64 + 32 * ks + 8 * q) * 2), Sacc[e]);
            *(LAS u32x2*)(Simg + (16 * (nt0 + e) + r) * 144 + (16 * mt + 4 * q) * 2) = pack4(Sacc[e]); }
        __syncthreads();
    }
}
DI void dn_gate_phase(const float* odn, const bf16* proj, const float* ong, bf16* mix, int gw, int ngw, int lane0) {
    const int lane = opaque(lane0);
    const int sub = lane >> 4, l16 = lane & 15;
    float gv[8];
#pragma unroll
    for (int e = 0; e < 8; ++e) gv[e] = ong[l16 * 8 + e];
    for (int it = gw; it < M * NH / 4; it += ngw) {
        const int idx = it * 4 + sub, row = idx / NH, h = idx % NH;
        const f32x4 o0 = *(const f32x4*)(odn + (size_t)row * 768 + h * 128 + l16 * 8), o1 = *(const f32x4*)(odn + (size_t)row * 768 + h * 128 + l16 * 8 + 4);
        float ss = (o0[0] * o0[0] + o0[1] * o0[1]) + (o0[2] * o0[2] + o0[3] * o0[3]) + (o1[0] * o1[0] + o1[1] * o1[1]) + (o1[2] * o1[2] + o1[3] * o1[3]);
        ss += __shfl_xor(ss, 1); ss += __shfl_xor(ss, 2); ss += __shfl_xor(ss, 4); ss += __shfl_xor(ss, 8);
        const float rs = 1.0f / sqrtf(ss * (1.0f / 128.0f) + EPS);
        float gt[8]; unpack8(*(const u32x4*)(proj + (size_t)row * NPROJ + C_BG + h * 128 + l16 * 8), gt);
        float y[8];
#pragma unroll
        for (int e = 0; e < 4; ++e) { y[e] = o0[e] * rs * gv[e] * silu_f(gt[e]); y[4 + e] = o1[e] * rs * gv[4 + e] * silu_f(gt[4 + e]); }
        *(u32x4*)(mix + (size_t)row * DM + 512 + h * 128 + l16 * 8) = pack8(y);
    }
}

struct Args { const float* in[16]; float* out; unsigned char* ws; };
#ifndef MK_SKIP_MIX
#define MK_SKIP_MIX 0
#endif
__global__ void __launch_bounds__(NTHR, 2) hybrid_fwd(Args a) {
    extern __shared__ __attribute__((aligned(16))) unsigned char lds_raw[];
    LAS unsigned char* lds = (LAS unsigned char*)lds_raw;
    cg::grid_group grid = cg::this_grid();
    const int tid = threadIdx.x, lane = tid & 63, wave = __builtin_amdgcn_readfirstlane(tid >> 6);
    const int G = gridDim.x, bx = blockIdx.x, gw = bx * 8 + wave, ngw = G * 8;
    unsigned char* ws = a.ws;
    bf16* Hb = (bf16*)(ws + WS_H); bf16* PROJ = (bf16*)(ws + WS_PROJ); float* BD = (float*)(ws + WS_BD); unsigned char* DN = ws + WS_DN; float* GL = (float*)(ws + WS_GL);
    float* ODN = (float*)(ws + WS_ODN); bf16* OBR = (bf16*)(ws + WS_OBR); float* LSE = (float*)(ws + WS_LSE);
    bf16* MIX = Hb; bf16* ACT = PROJ;

#ifndef NO_P0
    weight_prep(a.in, ws, lds, gw, ngw, wave, lane);
#endif
    __syncthreads();
    norm_phase(a.in[I_X], a.in[I_N1G], Hb, a.in[I_WIN], BD, lds, gw, ngw, tid, lane);
    grid.sync();
#pragma unroll 1
    for (int l = 0; l < DEPTH; ++l) {
        const unsigned char* wl = ws + WS_W + (size_t)l * SZ_WL;
        const bf16* Win_t = (const bf16*)wl; const bf16* Wout_t = (const bf16*)(wl + SZ_WIN); const bf16* Wgu_t = (const bf16*)(wl + SZ_WIN + SZ_WOUT); const bf16* Wdn_t = (const bf16*)(wl + SZ_WIN + SZ_WOUT + SZ_WGU);
        const float* xin = (l == 0) ? a.in[I_X] : a.out;
        if (l > 0) { norm_phase(a.out, a.in[I_N1G] + (size_t)l * DM, Hb, a.in[I_WIN] + (size_t)l * DM * IN_TOTAL, BD, lds, gw, ngw, tid, lane); grid.sync(); }
#ifndef NO_G1
        { pg8::Gemm g{Hb, Win_t, M, NPROJ, DM}; pg8::StaticOrder S; S.init(M, NPROJ, G, bx);
          pg8::EpiBf16<0> E{PROJ, NPROJ, nullptr, 0, 0, 1.f};
          pg8::gemm_phase<pg8::EpiBf16<0>, pg8::StaticOrder, true, true>(lds, g, S, E); }
#endif
        grid.sync();
#if !MK_SKIP_MIX
        for (int it = bx; it < 2304 + 1536 + 512; it += G) {
            if (it < 2304) {
#ifndef NO_ATTN
 attn_item(it, PROJ, a.in[I_QNG] + l * HD, a.in[I_KNG] + l * HD, OBR, LSE, lds, tid);
#endif
 }
            else if (it < 2304 + 1536) {
#ifndef NO_PREP
 dn_prep_item(it - 2304, PROJ, BD, a.in[I_CONVW] + (size_t)l * 4 * 2304, a.in[I_ALOG] + l * NH, a.in[I_DTB] + l * NH, DN, GL, lds, tid);
#endif
 }
            else {
#ifndef NO_SGU
 sgu_item(it - 3840, PROJ, a.in[I_SGUG] + l * 512, a.in[I_WS] + (size_t)l * 4 * 128 * 128, a.in[I_BS] + l * 512, MIX, lds, tid);
#endif
 }
        }
        grid.sync();
        if (G > NSCAN) {
            if (bx < NSCAN) {
#ifndef NO_SCAN
 dn_scan_item(bx, DN, GL, ODN, lds, tid);
#endif
 }
            else attn_combine(OBR, LSE, MIX, (bx - NSCAN) * NTHR + tid, (G - NSCAN) * NTHR);
        } else {
            for (int it = bx; it < NSCAN; it += G) { dn_scan_item(it, DN, GL, ODN, lds, tid); __syncthreads(); }
            attn_combine(OBR, LSE, MIX, bx * NTHR + tid, G * NTHR);
        }
        grid.sync();
        dn_gate_phase(ODN, PROJ, a.in[I_ONG] + l * HD, MIX, gw, ngw, lane);
        grid.sync();
#else
        for (size_t u = (size_t)bx * NTHR + tid; u < (size_t)M * DM / 8; u += (size_t)G * NTHR) ((u32x4*)MIX)[u] = (u32x4){0u, 0u, 0u, 0u};
        grid.sync();
#endif
#ifndef NO_G2
        { pg8::Gemm g{MIX, Wout_t, M, DM, DM}; pg8::StaticOrder S; S.init(M, DM, G, bx);
          pg8::EpiResF32 E{xin, a.out, DM};
          pg8::gemm_phase<pg8::EpiResF32, pg8::StaticOrder, true, true>(lds, g, S, E); }
#endif
        grid.sync();
        norm_phase(a.out, a.in[I_N2G] + (size_t)l * DM, Hb, nullptr, nullptr, lds, gw, ngw, tid, lane);
        grid.sync();
#ifndef NO_G3
        { pg8::Gemm g{Hb, Wgu_t, M, 2 * FF, DM}; pg8::StaticOrder S; S.init(M, 2 * FF, G, bx);
          pg8::EpiSwiGLU E{ACT, FF};
          pg8::gemm_phase<pg8::EpiSwiGLU, pg8::StaticOrder, true, true>(lds, g, S, E); }
#endif
        grid.sync();
#ifndef NO_G4
        { pg8::Gemm g{ACT, Wdn_t, M, DM, FF}; pg8::StaticOrder S; S.init(M, DM, G, bx);
          pg8::EpiResF32 E{a.out, a.out, DM};
          pg8::gemm_phase<pg8::EpiResF32, pg8::StaticOrder, true, true>(lds, g, S, E); }
#endif
        if (l + 1 < DEPTH) grid.sync();
    }
}

extern "C" void kernel_launch(void* const* d_in, const int* in_sizes, int n_in, void* d_out, int out_size, void* d_ws, size_t ws_size, hipStream_t stream) {
    static int grid = 0;
    if (grid == 0) {
        if (n_in != 16 || in_sizes[0] != M * DM || out_size != M * DM || ws_size < WS_END) { fprintf(stderr, "kernel_launch: unexpected shapes / workspace (n_in %d, ws %zu, need %zu); nothing launched\n", n_in, ws_size, (size_t)WS_END); grid = -1; return; }
        int dev = 0, cus = 0, per_cu = 0;
        if (hipGetDevice(&dev) != hipSuccess || hipDeviceGetAttribute(&cus, hipDeviceAttributeMultiprocessorCount, dev) != hipSuccess) { grid = -1; return; }
        if (hipFuncSetAttribute((const void*)hybrid_fwd, hipFuncAttributeMaxDynamicSharedMemorySize, LDS_BYTES) != hipSuccess) { fprintf(stderr, "kernel_launch: hipFuncSetAttribute failed\n"); grid = -1; return; }
        if (hipOccupancyMaxActiveBlocksPerMultiprocessor(&per_cu, (const void*)hybrid_fwd, NTHR, LDS_BYTES) != hipSuccess || per_cu < 1) { fprintf(stderr, "kernel_launch: occupancy query says %d blocks per CU\n", per_cu); per_cu = 1; }
        (void)hipGetLastError();
        grid = cus;
    }
    if (grid < 0) return;
    Args a{};
    for (int i = 0; i < 16; ++i) a.in[i] = (const float*)d_in[i];
    a.out = (float*)d_out; a.ws = (unsigned char*)d_ws;
    void* args[] = {&a};
    hipError_t e = hipLaunchCooperativeKernel((const void*)hybrid_fwd, dim3(grid), dim3(NTHR), args, LDS_BYTES, stream);
    if (e != hipSuccess) fprintf(stderr, "kernel_launch: cooperative launch failed: %s (grid %d)\n", hipGetErrorString(e), grid);
}
```

```cpp
#include <hip/hip_runtime.h>
#include <hip/hip_cooperative_groups.h>
#include <cstdio>
#include <cstdint>
namespace cg = cooperative_groups;
namespace pg8 {
#define PG8_LAS __attribute__((address_space(3)))
typedef unsigned short bf16_t;
typedef short bf16x8 __attribute__((ext_vector_type(8)));
typedef float f32x4 __attribute__((ext_vector_type(4)));
typedef unsigned u32x4 __attribute__((ext_vector_type(4)));
constexpr int BM = 256, BK = 64, HALF = 128, HTB = HALF * BK * 2  , STAGE_BYTES = 8 * HTB, NXCD = 8, WGM = 8;

__host__ __device__ __forceinline__ int lds_byte(int r, int c) { const int st = (r >> 4) * 2 + (c >> 5), rr = r & 15, cc = c & 31, ob = rr * 64 + cc * 2; return st * 1024 + (ob ^ (((ob >> 9) & 1) << 5)); }
__host__ __device__ __forceinline__ void stage_rc(int b, int& R, int& C) { const int st = b / 1024, sb = b % 1024, swz = sb ^ (((sb >> 9) & 1) << 5); R = (st >> 1) * 16 + swz / 64; C = (st & 1) * 32 + (swz % 64) / 2; }
__host__ __device__ __forceinline__ int perm32(int rho) { const int n = rho >> 4, i = rho & 15; return 8 * (i >> 2) + 4 * n + (i & 3); }

struct Unit { int pm, pn; };
struct Gemm { const bf16_t* A; const bf16_t* Bt; int M, N, K; };

struct StaticOrder {
    int nM, nN, nwg, G, c;
    __host__ __device__ void init(int M, int N, int G_, int c_) { nM = M / BM; nN = N / BM; nwg = nM * nN; G = G_; c = c_; }
    __host__ __device__ bool next(int i, Unit& u) const {
        const long L = (long)i * G + c; if (L >= nwg) return false;
        int wgid = (int)L; { const int q = nwg / NXCD, r = nwg % NXCD, xcd = wgid % NXCD, off = wgid / NXCD; wgid = (xcd < r ? xcd * (q + 1) : r * (q + 1) + (xcd - r) * q) + off; }
        const int nig = WGM * nN, gid = wgid / nig, fm = gid * WGM, gsz = (nM - fm) < WGM ? (nM - fm) : WGM;
        u.pm = fm + ((wgid % nig) % gsz); u.pn = (wgid % nig) / gsz; return true;
    }
    __device__ __forceinline__ void a_ready(const Unit&) const {}
    __device__ __forceinline__ void done(const Unit&) const {}
};

__device__ __forceinline__ unsigned cvt_pk_bf16(float lo, float hi) { unsigned r; asm volatile("v_cvt_pk_bf16_f32 %0, %1, %2" : "=v"(r) : "v"(lo), "v"(hi)); return r; }
typedef float f32x2 __attribute__((ext_vector_type(2)));
__device__ __forceinline__ f32x2 gelu_pk(f32x2 v) {
    const f32x2 av = __builtin_elementwise_abs(v), d = av * 0.2316418882f + 1.0f;
    f32x2 t; t.x = __builtin_amdgcn_rcpf(d.x); t.y = __builtin_amdgcn_rcpf(d.y);
    f32x2 q = t * 0.5307027145f + (-0.7265760135f); q = q * t + 0.7107068705f; q = q * t + (-0.142248368f); q = q * t + 0.127414796f; q = q * t;
    const f32x2 s = (v * v) * (-0.72134752044f);
    f32x2 e; e.x = __builtin_amdgcn_exp2f(s.x); e.y = __builtin_amdgcn_exp2f(s.y);
    const f32x2 m = v * (q * e), r = v - m;
    f32x2 o; o.x = v.x < 0.f ? m.x : r.x; o.y = v.y < 0.f ? m.y : r.y; return o;
}

template <int ACT  > struct EpiBf16 {
    static constexpr bool PERM = true, AFTER_DRAIN = false; static_assert(ACT == 0 || ACT == 1, "EpiBf16: ACT is 0 (none) or 1 (gelu_pk)");
    bf16_t* O; int ldc; const float* bias; int split_cols; size_t split_stride; float scale0;
    __device__ __forceinline__ void operator()(const f32x4 (&acc)[2][2][4][2], const Unit& u, int wr, int wc, int fr, int fq) const {
        const int row0 = u.pm * BM + wr * 64 + fr; int colt = u.pn * BM; bf16_t* base = O;
        float sc = 1.f; if (split_cols) { const int t = colt / split_cols; base += (size_t)t * split_stride; colt -= t * split_cols; if (t == 0) sc = scale0; }
        const int col0 = colt + wc * 32 + 8 * fq, bcol0 = u.pn * BM + wc * 32 + 8 * fq;
        f32x4 bv[2][2];
#pragma unroll
        for (int bj = 0; bj < 2; ++bj)
#pragma unroll
            for (int n = 0; n < 2; ++n) bv[bj][n] = bias ? *(const f32x4*)(bias + bcol0 + bj * HALF + 4 * n) : (f32x4){0.f, 0.f, 0.f, 0.f};
#pragma unroll
        for (int ai = 0; ai < 2; ++ai)
#pragma unroll
            for (int m = 0; m < 4; ++m) { bf16_t* rowp = base + (size_t)(row0 + ai * HALF + m * 16) * ldc + col0;
#pragma unroll
                for (int bj = 0; bj < 2; ++bj) { f32x4 v0 = acc[ai][bj][m][0] + bv[bj][0], v1 = acc[ai][bj][m][1] + bv[bj][1];
                    if (ACT == 1) { f32x2 a = gelu_pk((f32x2){v0[0], v0[1]}), b = gelu_pk((f32x2){v0[2], v0[3]}), c = gelu_pk((f32x2){v1[0], v1[1]}), d = gelu_pk((f32x2){v1[2], v1[3]});
                        v0 = (f32x4){a.x, a.y, b.x, b.y}; v1 = (f32x4){c.x, c.y, d.x, d.y}; }
                    v0 = v0 * sc; v1 = v1 * sc; u32x4 w; w.x = cvt_pk_bf16(v0[0], v0[1]); w.y = cvt_pk_bf16(v0[2], v0[3]); w.z = cvt_pk_bf16(v1[0], v1[1]); w.w = cvt_pk_bf16(v1[2], v1[3]);
                    *(u32x4*)(rowp + bj * HALF) = w; } }
    }
};
struct EpiResF32 {
    static constexpr bool PERM = false, AFTER_DRAIN = false;
    const float* base; float* out; int ldc;
    __device__ __forceinline__ void operator()(const f32x4 (&acc)[2][2][4][2], const Unit& u, int wr, int wc, int fr, int fq) const {
        const int row0 = u.pm * BM + wr * 64 + fr; const int col0 = u.pn * BM + wc * 32 + 4 * fq;
#pragma unroll
        for (int ai = 0; ai < 2; ++ai)
#pragma unroll
            for (int m = 0; m < 4; ++m) { const size_t off = (size_t)(row0 + ai * HALF + m * 16) * ldc + col0;
#pragma unroll
                for (int bj = 0; bj < 2; ++bj)
#pragma unroll
                    for (int n = 0; n < 2; ++n) { const f32x4 b = *(const f32x4*)(base + off + bj * HALF + n * 16); *(f32x4*)(out + off + bj * HALF + n * 16) = b + acc[ai][bj][m][n]; } }
    }
};
__device__ __forceinline__ float silu_f(float g) { return g * __builtin_amdgcn_rcpf(1.0f + __expf(-g)); }
struct EpiSwiGLU {
    static constexpr bool PERM = true, AFTER_DRAIN = false;
    bf16_t* O; int ldo;
    __device__ __forceinline__ void operator()(const f32x4 (&acc)[2][2][4][2], const Unit& u, int wr, int wc, int fr, int fq) const {
        const int row0 = u.pm * BM + wr * 64 + fr; const int col0 = u.pn * HALF + wc * 32 + 8 * fq;
#pragma unroll
        for (int ai = 0; ai < 2; ++ai)
#pragma unroll
            for (int m = 0; m < 4; ++m) { bf16_t* rowp = O + (size_t)(row0 + ai * HALF + m * 16) * ldo + col0;
                const f32x4 g0 = acc[ai][0][m][0], g1 = acc[ai][0][m][1], u0 = acc[ai][1][m][0], u1 = acc[ai][1][m][1];
                u32x4 w; w.x = cvt_pk_bf16(silu_f(g0[0]) * u0[0], silu_f(g0[1]) * u0[1]); w.y = cvt_pk_bf16(silu_f(g0[2]) * u0[2], silu_f(g0[3]) * u0[3]);
                w.z = cvt_pk_bf16(silu_f(g1[0]) * u1[0], silu_f(g1[1]) * u1[1]); w.w = cvt_pk_bf16(silu_f(g1[2]) * u1[2], silu_f(g1[3]) * u1[3]);
                *(u32x4*)rowp = w; }
    }
};
template <class Epi, class Sched, bool ALIGN_EPI = false, bool SP2 = false>
__device__ __forceinline__ void gemm_phase(PG8_LAS unsigned char* lds, const Gemm g, const Sched& S, const Epi& E) {
    int tid_ = threadIdx.x; asm volatile("" : "+v"(tid_)); const int tid = tid_, wid = __builtin_amdgcn_readfirstlane(tid >> 6), lane = tid & 63, wr = wid >> 2, wc = wid & 3, fr = lane & 15, fq = lane >> 4;
    const int K = g.K, nt = K / BK;
    unsigned voffA[2], voffB[2];
#pragma unroll
    for (int i = 0; i < 2; ++i) { int R, C; stage_rc(tid * 16 + i * 8192, R, C); const int Rb = Epi::PERM ? ((R & ~31) + perm32(R & 31)) : R;
        voffA[i] = (unsigned)(R * K + C) * 2u; voffB[i] = (unsigned)(Rb * K + C) * 2u; }
    const size_t kstep = (size_t)(BK * 2);
    const size_t hstep = (size_t)HALF * K * 2;
    const size_t tstep = 2 * hstep;
    const unsigned ldsw = (unsigned)wid * 1024u;
    const int aoff = lds_byte(wr * 64 + fr, fq * 8), boff = lds_byte(wc * 32 + fr, fq * 8);
#define PG8_SA(b, h) (((b) * 2 + (h)) * HTB)
#define PG8_SB(b, h) ((4 + (b) * 2 + (h)) * HTB)
#define PG8_STAGE(bufoff, gbase, voff) do { _Pragma("unroll") for (int _i = 0; _i < 2; ++_i) \
        __builtin_amdgcn_global_load_lds((const unsigned*)((const char*)(gbase) + (voff)[_i]), (PG8_LAS unsigned*)(lds + (bufoff) + ldsw + _i * 8192), 16, 0, 0); } while (0)
#define PG8_LDA(dst, b, h) do { _Pragma("unroll") for (int m = 0; m < 4; ++m) _Pragma("unroll") for (int k = 0; k < 2; ++k) dst[m][k] = *(const PG8_LAS bf16x8*)(lds + PG8_SA(b, h) + aoff + m * 2048 + k * 1024); } while (0)
#define PG8_LDB(dst, b, h) do { _Pragma("unroll") for (int n = 0; n < 2; ++n) _Pragma("unroll") for (int k = 0; k < 2; ++k) dst[n][k] = *(const PG8_LAS bf16x8*)(lds + PG8_SB(b, h) + boff + n * 2048 + k * 1024); } while (0)
#define PG8_MMA(ai, bj, At, Bt) do { __builtin_amdgcn_s_setprio(1); _Pragma("unroll") for (int m = 0; m < 4; ++m) _Pragma("unroll") for (int n = 0; n < 2; ++n) _Pragma("unroll") for (int k = 0; k < 2; ++k) \
        acc[ai][bj][m][n] = __builtin_amdgcn_mfma_f32_16x16x32_bf16(Bt[n][k], At[m][k], acc[ai][bj][m][n], 0, 0, 0); __builtin_amdgcn_s_setprio(0); } while (0)
#define PG8_WAIT_V(n) asm volatile("s_waitcnt vmcnt(" #n ")" ::: "memory")
#define PG8_WAIT_L(n) asm volatile("s_waitcnt lgkmcnt(" #n ")" ::: "memory")
#define PG8_BAR __builtin_amdgcn_s_barrier()
#define PG8_SCHED __builtin_amdgcn_sched_barrier(0)
    Unit cur, nxt; int ui = 0;
    if (!S.next(0, cur)) return;
    f32x4 acc[2][2][4][2];
#pragma unroll
    for (int a = 0; a < 2; ++a)
#pragma unroll
        for (int b = 0; b < 2; ++b)
#pragma unroll
            for (int m = 0; m < 4; ++m)
#pragma unroll
                for (int n = 0; n < 2; ++n) acc[a][b][m][n] = (f32x4){0.f, 0.f, 0.f, 0.f};
    bf16x8 At[4][2], B0[2][2], B1[2][2];
    const char* cA = (const char*)g.A + (size_t)cur.pm * tstep; const char* cB = (const char*)g.Bt + (size_t)cur.pn * tstep;
    S.a_ready(cur);
    if constexpr (SP2) {
        PG8_STAGE(PG8_SB(0, 0), cB, voffB); PG8_STAGE(PG8_SB(0, 1), cB + hstep, voffB); PG8_STAGE(PG8_SA(0, 0), cA, voffA); PG8_STAGE(PG8_SA(0, 1), cA + hstep, voffA);
        if (wr == 1) PG8_BAR;
        PG8_WAIT_V(2); PG8_BAR;
        PG8_STAGE(PG8_SB(1, 0), cB + kstep, voffB); PG8_STAGE(PG8_SA(1, 0), cA + kstep, voffA); PG8_STAGE(PG8_SB(1, 1), cB + hstep + kstep, voffB);
        PG8_WAIT_V(6); PG8_BAR;
    } else {
        PG8_STAGE(PG8_SB(0, 0), cB, voffB); PG8_STAGE(PG8_SA(0, 0), cA, voffA); PG8_STAGE(PG8_SB(0, 1), cB + hstep, voffB); PG8_STAGE(PG8_SA(0, 1), cA + hstep, voffA);
        if (wr == 1) PG8_BAR;
        PG8_WAIT_V(4); PG8_BAR;
        PG8_STAGE(PG8_SB(1, 0), cB + kstep, voffB); PG8_STAGE(PG8_SA(1, 0), cA + kstep, voffA); PG8_STAGE(PG8_SB(1, 1), cB + hstep + kstep, voffB);
        PG8_WAIT_V(6); PG8_BAR;
    }
    for (;;) {
        const bool has_next = S.next(ui + 1, nxt);
        const char* nA = has_next ? (const char*)g.A + (size_t)nxt.pm * tstep : cA; const char* nB = has_next ? (const char*)g.Bt + (size_t)nxt.pn * tstep : cB;
        for (int t = 0; t < nt; t += 2) {
            const bool last = (t == nt - 2);
            const char* a1 = cA + (size_t)(t + 1) * kstep;
            const char* a2 = last ? nA : cA + (size_t)(t + 2) * kstep; const char* b2 = last ? nB : cB + (size_t)(t + 2) * kstep;
            const char* a3 = a2 + kstep; const char* b3 = b2 + kstep;
            if (last && has_next) S.a_ready(nxt);
            if constexpr (SP2) {
            PG8_LDB(B0, 0, 0); PG8_LDB(B1, 0, 1); PG8_SCHED; PG8_LDA(At, 0, 0); PG8_STAGE(PG8_SA(1, 1), a1 + hstep, voffA);
            PG8_WAIT_V(8); PG8_WAIT_L(0); PG8_BAR; PG8_MMA(0, 0, At, B0); PG8_MMA(0, 1, At, B1); PG8_BAR; PG8_SCHED;
            PG8_LDA(At, 0, 1); PG8_STAGE(PG8_SB(0, 0), b2, voffB); PG8_STAGE(PG8_SB(0, 1), b2 + hstep, voffB); PG8_STAGE(PG8_SA(0, 0), a2, voffA);
            PG8_WAIT_V(8); PG8_WAIT_L(0); PG8_BAR; PG8_MMA(1, 0, At, B0); PG8_MMA(1, 1, At, B1); PG8_BAR; PG8_SCHED;
            PG8_LDB(B0, 1, 0); PG8_LDB(B1, 1, 1); PG8_SCHED; PG8_LDA(At, 1, 0); PG8_STAGE(PG8_SA(0, 1), a2 + hstep, voffA);
            PG8_WAIT_V(8); PG8_WAIT_L(0); PG8_BAR; PG8_MMA(0, 0, At, B0); PG8_MMA(0, 1, At, B1); PG8_BAR; PG8_SCHED;
            PG8_LDA(At, 1, 1); PG8_STAGE(PG8_SB(1, 0), b3, voffB); PG8_STAGE(PG8_SB(1, 1), b3 + hstep, voffB); PG8_STAGE(PG8_SA(1, 0), a3, voffA);
            PG8_WAIT_V(8); PG8_WAIT_L(0); PG8_BAR; PG8_MMA(1, 0, At, B0); PG8_MMA(1, 1, At, B1); PG8_BAR; PG8_SCHED;
            } else {
            PG8_LDB(B0, 0, 0); PG8_SCHED; PG8_LDA(At, 0, 0); PG8_STAGE(PG8_SA(1, 1), a1 + hstep, voffA);
            PG8_WAIT_L(8); PG8_BAR; PG8_WAIT_L(0); PG8_MMA(0, 0, At, B0); PG8_BAR; PG8_SCHED;
            PG8_LDB(B1, 0, 1); PG8_STAGE(PG8_SB(0, 0), b2, voffB);
            PG8_BAR; PG8_WAIT_L(0); PG8_MMA(0, 1, At, B1); PG8_BAR;
            PG8_LDA(At, 0, 1); PG8_STAGE(PG8_SA(0, 0), a2, voffA);
            PG8_BAR; PG8_WAIT_L(0); PG8_MMA(1, 0, At, B0); PG8_BAR; PG8_SCHED;
            PG8_STAGE(PG8_SB(0, 1), b2 + hstep, voffB);
            PG8_WAIT_V(6); PG8_BAR; PG8_MMA(1, 1, At, B1); PG8_BAR;
            PG8_LDB(B0, 1, 0); PG8_SCHED; PG8_LDA(At, 1, 0); PG8_STAGE(PG8_SA(0, 1), a2 + hstep, voffA);
            PG8_WAIT_L(8); PG8_BAR; PG8_WAIT_L(0); PG8_MMA(0, 0, At, B0); PG8_BAR; PG8_SCHED;
            PG8_LDB(B1, 1, 1); PG8_STAGE(PG8_SB(1, 0), b3, voffB);
            PG8_BAR; PG8_WAIT_L(0); PG8_MMA(0, 1, At, B1); PG8_BAR;
            PG8_LDA(At, 1, 1); PG8_STAGE(PG8_SA(1, 0), a3, voffA);
            PG8_BAR; PG8_WAIT_L(0); PG8_MMA(1, 0, At, B0); PG8_BAR; PG8_SCHED;
            PG8_STAGE(PG8_SB(1, 1), b3 + hstep, voffB);
            PG8_WAIT_V(6); PG8_BAR; PG8_MMA(1, 1, At, B1); PG8_BAR;
            }
        }
        if constexpr (ALIGN_EPI) { if (wr == 0) PG8_BAR; }
        if constexpr (!Epi::AFTER_DRAIN) { E(acc, cur, wr, wc, fr, fq); S.done(cur); }
        if (!has_next) break;
#pragma unroll
        for (int a = 0; a < 2; ++a)
#pragma unroll
            for (int b = 0; b < 2; ++b)
#pragma unroll
                for (int m = 0; m < 4; ++m)
#pragma unroll
                    for (int n = 0; n < 2; ++n) acc[a][b][m][n] = (f32x4){0.f, 0.f, 0.f, 0.f};
        cur = nxt; cA = nA; cB = nB; ++ui;
        if constexpr (ALIGN_EPI) { if (wr == 1) PG8_BAR; }
    }
    PG8_WAIT_V(0);
    if constexpr (!ALIGN_EPI) { if (wr == 0) PG8_BAR; }
    PG8_BAR;
    if constexpr (Epi::AFTER_DRAIN) { E.fused(acc, cur, wr, wc, fr, fq, lds, wid, lane); S.done(cur); }
#undef PG8_SA
#undef PG8_SB
#undef PG8_STAGE
#undef PG8_LDA
#undef PG8_LDB
#undef PG8_MMA
#undef PG8_WAIT_V
#undef PG8_WAIT_L
#undef PG8_BAR
#undef PG8_SCHED
}
}
#define DI __device__ __forceinline__
#define LAS __attribute__((address_space(3)))
typedef unsigned short bf16;
typedef short bf16x8 __attribute__((ext_vector_type(8)));
typedef short s16x4 __attribute__((ext_vector_type(4)));
typedef short v4i16_t __attribute__((ext_vector_type(4)));
typedef float f32x4 __attribute__((ext_vector_type(4)));
typedef float f32x2 __attribute__((ext_vector_type(2)));
typedef unsigned u32x4 __attribute__((ext_vector_type(4)));
typedef unsigned u32x2 __attribute__((ext_vector_type(2)));
typedef __bf16 bf16x2_t __attribute__((ext_vector_type(2)));

constexpr int NB = 8, SEQ = 2048, DM = 2048, M = NB * SEQ, DEPTH = 2, HD = 128, NH = 6;
constexpr int NPROJ = 6400, IN_TOTAL = 6412, FF = 5632;
constexpr int C_AU = 0, C_AV = 512, C_BQ = 1024, C_BK = 1792, C_BV = 2560, C_BG = 3328, C_CQ = 4096, C_CK = 4864, C_CV = 5632;
constexpr float EPS = 1e-6f, LOG2E = 1.4426950408889634f, LN2 = 0.6931471805599453f;
enum { I_X = 0, I_N1G, I_WIN, I_SGUG, I_WS, I_BS, I_CONVW, I_ALOG, I_DTB, I_ONG, I_QNG, I_KNG, I_WOUT, I_N2G, I_WGU, I_WDN };

constexpr size_t SZ_WIN = (size_t)NPROJ * DM * 2, SZ_WOUT = (size_t)DM * DM * 2, SZ_WGU = (size_t)2 * FF * DM * 2, SZ_WDN = (size_t)DM * FF * 2;
constexpr size_t SZ_WL = SZ_WIN + SZ_WOUT + SZ_WGU + SZ_WDN;
constexpr size_t WS_W = 0;
constexpr size_t WS_H = WS_W + DEPTH * SZ_WL;
constexpr size_t WS_PROJ = WS_H + (size_t)M * DM * 2;
constexpr size_t WS_BD = WS_PROJ + (size_t)M * NPROJ * 2;
constexpr size_t WS_DN = WS_BD + (size_t)M * 12 * 4;
constexpr int NCHUNK = NB * NH * 32;
constexpr size_t DN_WK = 0, DN_QG = 16384, DN_KDT = 32768, DN_UT = 49152, DN_ATT = 65536, DN_STRIDE = 73728;
constexpr size_t WS_GL = WS_DN + (size_t)NCHUNK * DN_STRIDE;
constexpr size_t WS_ODN = WS_GL + 8192;
constexpr size_t WS_OBR = WS_ODN + (size_t)M * 768 * 4;
constexpr size_t WS_LSE = WS_OBR + (size_t)3 * M * 768 * 2;
constexpr size_t WS_END = WS_LSE + (size_t)3 * M * 6 * 4;
constexpr int LDS_BYTES = 143360;
constexpr int NTHR = 512;
constexpr int NSCAN = 96;

DI unsigned pk2(float lo, float hi) { f32x2 v = {lo, hi}; bf16x2_t b = __builtin_convertvector(v, bf16x2_t); return __builtin_bit_cast(unsigned, b); }
DI float bflo(unsigned w) { return __uint_as_float(w << 16); }
DI float bfhi(unsigned w) { return __uint_as_float(w & 0xffff0000u); }
DI f32x4 mfma16(bf16x8 a, bf16x8 b, f32x4 c) { return __builtin_amdgcn_mfma_f32_16x16x32_bf16(a, b, c, 0, 0, 0); }
DI s16x4 tr4(const LAS unsigned char* p) { return __builtin_bit_cast(s16x4, __builtin_amdgcn_ds_read_tr16_b64_v4i16((LAS v4i16_t*)p)); }
DI bf16x8 tr_frag(const LAS unsigned char* p0, const LAS unsigned char* p1) { const s16x4 lo = tr4(p0), hi = tr4(p1); return __builtin_shufflevector(lo, hi, 0, 1, 2, 3, 4, 5, 6, 7); }
DI bf16x8 ld_frag(const LAS unsigned char* p) { return *(const LAS bf16x8*)p; }
DI void lds_barrier() { asm volatile("s_waitcnt lgkmcnt(0)" ::: "memory"); __builtin_amdgcn_s_barrier(); asm volatile("" ::: "memory"); }
DI int opaque(int x) { asm volatile("" : "+v"(x)); return x; }
DI float wave_sum(float v) {
#pragma unroll
    for (int o = 1; o < 64; o <<= 1) v += __shfl_xor(v, o);
    return v;
}
DI float sigmoid_f(float x) { return __builtin_amdgcn_rcpf(1.0f + __expf(-x)); }
DI float silu_f(float x) { return x * sigmoid_f(x); }
DI float gelu_tanh(float x) { const float u = 0.7978845608028654f * (x + 0.044715f * x * x * x); return x * sigmoid_f(2.0f * u); }
DI void unpack8(const u32x4 w, float* f) { f[0] = bflo(w.x); f[1] = bfhi(w.x); f[2] = bflo(w.y); f[3] = bfhi(w.y); f[4] = bflo(w.z); f[5] = bfhi(w.z); f[6] = bflo(w.w); f[7] = bfhi(w.w); }
DI u32x4 pack8(const float* f) { u32x4 w; w.x = pk2(f[0], f[1]); w.y = pk2(f[2], f[3]); w.z = pk2(f[4], f[5]); w.w = pk2(f[6], f[7]); return w; }
DI u32x2 pack4(const f32x4 v) { u32x2 w; w.x = pk2(v[0], v[1]); w.y = pk2(v[2], v[3]); return w; }

DI void transpose_item(const float* W, int K, int Nsrc, int src_col0, bf16* WT, int dst_row0, int k0, LAS float* scr, int lane) {
#pragma unroll 8
    for (int i = 0; i < 32; ++i) { const int kk = 2 * i + (lane >> 5); scr[kk * 33 + (lane & 31)] = W[(size_t)(k0 + kk) * Nsrc + src_col0 + (lane & 31)]; }
    asm volatile("s_waitcnt lgkmcnt(0)" ::: "memory");
    const int c = lane & 7;
#pragma unroll
    for (int j = 0; j < 4; ++j) { const int n = (lane >> 3) + 8 * j; const LAS float* s = scr + (8 * c) * 33 + n;
        u32x4 o; o.x = pk2(s[0 * 33], s[1 * 33]); o.y = pk2(s[2 * 33], s[3 * 33]); o.z = pk2(s[4 * 33], s[5 * 33]); o.w = pk2(s[6 * 33], s[7 * 33]);
        *(u32x4*)(WT + (size_t)(dst_row0 + n) * K + k0 + 8 * c) = o; }
    asm volatile("s_waitcnt lgkmcnt(0)" ::: "memory");
}
DI void weight_prep(const float* const* in, unsigned char* ws, LAS unsigned char* lds, int gw, int ngw, int wave, int lane) {
    LAS float* scr = (LAS float*)(lds + wave * 16384);
    constexpr int I_IN = (DM / 64) * (NPROJ / 32), I_OUT = (DM / 64) * (DM / 32), I_GU = (DM / 64) * (2 * FF / 32), I_DN = (FF / 64) * (DM / 32);
    constexpr int PER_L = I_IN + I_OUT + I_GU + I_DN;
    for (int it = gw; it < DEPTH * PER_L; it += ngw) {
        const int l = it / PER_L; int r = it % PER_L;
        unsigned char* wl = ws + WS_W + (size_t)l * SZ_WL;
        if (r < I_IN) { const int nblk = NPROJ / 32, kb = r / nblk, nb = r % nblk, n0 = nb * 32;
            transpose_item(in[I_WIN] + (size_t)l * DM * IN_TOTAL, DM, IN_TOTAL, n0 < 4096 ? n0 : n0 + 12, (bf16*)wl, n0, kb * 64, scr, lane); continue; }
        r -= I_IN;
        if (r < I_OUT) { const int nblk = DM / 32, kb = r / nblk, nb = r % nblk, n0 = nb * 32;
            transpose_item(in[I_WOUT] + (size_t)l * DM * DM, DM, DM, n0, (bf16*)(wl + SZ_WIN), n0, kb * 64, scr, lane); continue; }
        r -= I_OUT;
        if (r < I_GU) { const int nblk = 2 * FF / 32, kb = r / nblk, nb = r % nblk, n0 = nb * 32, pn = n0 >> 8, j = n0 & 255;
            transpose_item(in[I_WGU] + (size_t)l * DM * 2 * FF, DM, 2 * FF, j < 128 ? 128 * pn + j : FF + 128 * pn + (j - 128), (bf16*)(wl + SZ_WIN + SZ_WOUT), n0, kb * 64, scr, lane); continue; }
        r -= I_GU;
        { const int nblk = DM / 32, kb = r / nblk, nb = r % nblk, n0 = nb * 32;
            transpose_item(in[I_WDN] + (size_t)l * FF * DM, FF, DM, n0, (bf16*)(wl + SZ_WIN + SZ_WOUT + SZ_WGU), n0, kb * 64, scr, lane); }
    }
}

DI void norm_phase(const float* x, const float* g, bf16* h, const float* w_in_l, float* bd, LAS unsigned char* lds, int gw, int ngw, int tid0, int lane0) {
    const int tid = opaque(tid0), lane = tid & 63; (void)lane0;
    LAS f32x4* wl = (LAS f32x4*)lds;
    if (w_in_l) {
        for (int k = tid; k < DM; k += NTHR) {
            const f32x4* src = (const f32x4*)(w_in_l + (size_t)k * IN_TOTAL + 4096);
            const f32x4 a = src[0], b = src[1], c = src[2];
            const int j = k >> 8, l = (k >> 2) & 63, e = k & 3;
            LAS float* dst = (LAS float*)lds + ((size_t)(j * 12) * 64 + l) * 4 + e;
            dst[0 * 256] = a[0]; dst[1 * 256] = a[1]; dst[2 * 256] = a[2]; dst[3 * 256] = a[3];
            dst[4 * 256] = b[0]; dst[5 * 256] = b[1]; dst[6 * 256] = b[2]; dst[7 * 256] = b[3];
            dst[8 * 256] = c[0]; dst[9 * 256] = c[1]; dst[10 * 256] = c[2]; dst[11 * 256] = c[3];
        }
        __syncthreads();
    }
    f32x4 gv[8];
#pragma unroll
    for (int j = 0; j < 8; ++j) gv[j] = ((const f32x4*)g)[64 * j + lane];
    for (int row = gw; row < M; row += ngw) {
        const f32x4* xr = (const f32x4*)(x + (size_t)row * DM) + lane;
        f32x4 v[8]; float s = 0.f;
#pragma unroll
        for (int j = 0; j < 8; ++j) { v[j] = xr[64 * j]; s += (v[j][0] * v[j][0] + v[j][1] * v[j][1]) + (v[j][2] * v[j][2] + v[j][3] * v[j][3]); }
        const float rs = 1.0f / sqrtf(wave_sum(s) * (1.0f / DM) + EPS);
        u32x2* o8 = (u32x2*)(h + (size_t)row * DM) + lane;
#pragma unroll
        for (int j = 0; j < 8; ++j) { v[j] = v[j] * rs * gv[j]; u32x2 w; w.x = pk2(v[j][0], v[j][1]); w.y = pk2(v[j][2], v[j][3]); o8[64 * j] = w; }
        if (w_in_l) {
            float outv = 0.f;
            asm volatile("" ::: "memory");
#pragma unroll 1
            for (int c = 0; c < 12; ++c) {
                float acc = 0.f;
#pragma unroll
                for (int j = 0; j < 8; ++j) { const f32x4 w = wl[(j * 12 + c) * 64 + lane]; acc += (v[j][0] * w[0] + v[j][1] * w[1]) + (v[j][2] * w[2] + v[j][3] * w[3]); }
                acc = wave_sum(acc);
                if (lane == c) outv = acc;
            }
            if (lane < 12) bd[(size_t)row * 12 + lane] = outv;
        }
    }
    if (w_in_l) __syncthreads();
}
DI void sgu_item(int item, const bf16* proj, const float* sgu_g, const float* w_s, const float* b_s, bf16* mix, LAS unsigned char* lds, int tid0) {
    const int tid = opaque(tid0);
    const int g = item & 3, c = (item >> 2) & 15, b = item >> 6;
    const size_t row0 = (size_t)b * SEQ + c * 128;
    LAS unsigned char* Vimg = lds; LAS unsigned char* Wimg = lds + 128 * 272;
    {
        const int i = tid >> 2, p = tid & 3;
        const bf16* src = proj + (row0 + i) * NPROJ + C_AV + g * 128 + p * 32;
        float y[32]; float ss = 0.f;
#pragma unroll
        for (int e = 0; e < 4; ++e) { const u32x4 raw = *(const u32x4*)(src + 8 * e); unpack8(raw, y + 8 * e); }
#pragma unroll
        for (int e = 0; e < 32; ++e) { y[e] = gelu_tanh(y[e]); ss += y[e] * y[e]; }
        ss += __shfl_xor(ss, 1); ss += __shfl_xor(ss, 2);
        const float rs = 1.0f / sqrtf(ss * (1.0f / 128.0f) + EPS);
        const float* gg = sgu_g + g * 128 + p * 32;
#pragma unroll
        for (int e = 0; e < 4; ++e) { float t[8];
#pragma unroll
            for (int k = 0; k < 8; ++k) t[k] = y[8 * e + k] * rs * gg[8 * e + k];
            *(LAS u32x4*)(Vimg + i * 272 + p * 64 + e * 16) = pack8(t); }
        const float* wsrc = w_s + ((size_t)g * 128 + i) * 128 + p * 32;
#pragma unroll
        for (int e = 0; e < 4; ++e) { const f32x4 a = *(const f32x4*)(wsrc + 8 * e), bb = *(const f32x4*)(wsrc + 8 * e + 4); float t[8];
#pragma unroll
            for (int k = 0; k < 4; ++k) { t[k] = (p * 32 + 8 * e + k <= i) ? a[k] : 0.f; t[4 + k] = (p * 32 + 8 * e + 4 + k <= i) ? bb[k] : 0.f; }
            *(LAS u32x4*)(Wimg + i * 272 + p * 64 + e * 16) = pack8(t); }
    }
    __syncthreads();
    const int w = tid >> 6, lane = tid & 63, r = lane & 15, q = lane >> 4;
    f32x4 acc[8];
#pragma unroll
    for (int dt = 0; dt < 8; ++dt) acc[dt] = (f32x4){0.f, 0.f, 0.f, 0.f};
    const int nks = (16 * (w + 1) + 31) >> 5;
    for (int ks = 0; ks < nks; ++ks) {
        const bf16x8 bfr = ld_frag(Wimg + (16 * w + r) * 272 + (32 * ks + 8 * q) * 2);
#pragma unroll
        for (int dt = 0; dt < 8; ++dt) { const LAS unsigned char* p0 = Vimg + (32 * ks + 8 * q + (r >> 2)) * 272 + (16 * dt + 4 * (r & 3)) * 2;
            acc[dt] = mfma16(tr_frag(p0, p0 + 4 * 272), bfr, acc[dt]); }
    }
    const int i = 16 * w + r; const float bsv = b_s[g * 128 + i];
    const bf16* up = proj + (row0 + i) * NPROJ + C_AU + g * 128 + 4 * q;
    bf16* op = mix + (row0 + i) * DM + g * 128 + 4 * q;
#pragma unroll
    for (int dt = 0; dt < 8; ++dt) { const u32x2 uu = *(const u32x2*)(up + 16 * dt);
        f32x4 o; o[0] = gelu_tanh(bflo(uu.x)) * (acc[dt][0] + bsv); o[1] = gelu_tanh(bfhi(uu.x)) * (acc[dt][1] + bsv); o[2] = gelu_tanh(bflo(uu.y)) * (acc[dt][2] + bsv); o[3] = gelu_tanh(bfhi(uu.y)) * (acc[dt][3] + bsv);
        *(u32x2*)(op + 16 * dt) = pack4(o); }
    __syncthreads();
}

DI void attn_item(int item, const bf16* proj, const float* qg, const float* kg, bf16* obr, float* lse, LAS unsigned char* lds, int tid0) {
    const int tid = opaque(tid0);
    const int sub = item % 48, bh = item / 48, h = bh % NH, b = bh / NH;
    int br, rr, n;
    if (sub < 16) { br = 0; rr = 0; n = sub; } else if (sub < 32) { br = 1; rr = (sub - 16) >> 2; n = (sub - 16) & 3; } else { br = 2; rr = sub - 32; n = 0; }
    const int dil = 1 << (2 * br);
    LAS unsigned char* Kimg = lds; LAS unsigned char* Vimg = lds + 256 * 272;
    const bf16* base = proj + (size_t)b * SEQ * NPROJ + h * 128;
    {
        const int piece = tid & 15;
        float kgv[8];
#pragma unroll
        for (int e = 0; e < 8; ++e) kgv[e] = kg[piece * 8 + e];
#pragma unroll 2
        for (int i = 0; i < 8; ++i) {
            const int row = (tid >> 4) + 32 * i, L = (n - 1) * 128 + row;
            u32x4 kv = {0u, 0u, 0u, 0u}, vv = {0u, 0u, 0u, 0u};
            if (L >= 0) { const bf16* p = base + (size_t)(L * dil + rr) * NPROJ + piece * 8; kv = *(const u32x4*)(p + C_CK); vv = *(const u32x4*)(p + C_CV); }
            float kf[8]; unpack8(kv, kf); float ss = 0.f;
#pragma unroll
            for (int e = 0; e < 8; ++e) ss += kf[e] * kf[e];
            ss += __shfl_xor(ss, 1); ss += __shfl_xor(ss, 2); ss += __shfl_xor(ss, 4); ss += __shfl_xor(ss, 8);
            const float rs = 1.0f / sqrtf(ss * (1.0f / 128.0f) + EPS);
#pragma unroll
            for (int e = 0; e < 8; ++e) kf[e] = kf[e] * rs * kgv[e];
            *(LAS u32x4*)(Kimg + row * 272 + piece * 16) = pack8(kf);
            *(LAS u32x4*)(Vimg + row * 272 + piece * 16) = vv;
        }
    }
    const int w = tid >> 6, lane = tid & 63, r = lane & 15, q = lane >> 4;
    const int qi = 16 * w + r, tokq = (n * 128 + qi) * dil + rr;
    bf16x8 qf[4];
    {
        const bf16* qp = base + (size_t)tokq * NPROJ + C_CQ + 8 * q;
        float qv[32]; float ss = 0.f;
#pragma unroll
        for (int s = 0; s < 4; ++s) { const u32x4 raw = *(const u32x4*)(qp + 32 * s); unpack8(raw, qv + 8 * s); }
#pragma unroll
        for (int e = 0; e < 32; ++e) ss += qv[e] * qv[e];
        ss += __shfl_xor(ss, 16); ss += __shfl_xor(ss, 32);
        const float rs = (1.0f / sqrtf(ss * (1.0f / 128.0f) + EPS)) * (0.08838834764831845f * LOG2E);
#pragma unroll
        for (int s = 0; s < 4; ++s) { float t[8];
#pragma unroll
            for (int e = 0; e < 8; ++e) t[e] = qv[8 * s + e] * rs * qg[32 * s + 8 * q + e];
            qf[s] = __builtin_bit_cast(bf16x8, pack8(t)); }
    }
    __syncthreads();
    const int kt0 = 2 * (w >> 1);
    f32x4 sc[10];
#pragma unroll
    for (int t = 0; t < 10; ++t) { f32x4 a4 = {0.f, 0.f, 0.f, 0.f};
#pragma unroll
        for (int s = 0; s < 4; ++s) a4 = mfma16(ld_frag(Kimg + (16 * (kt0 + t) + r) * 272 + (32 * s + 8 * q) * 2), qf[s], a4);
        sc[t] = a4; }
    const float sl2 = exp2f(-8.0f * (float)(h + 1) / 6.0f) * (float)dil * LOG2E;
    float mx = -INFINITY;
#pragma unroll
    for (int t = 0; t < 10; ++t)
#pragma unroll
        for (int jj = 0; jj < 4; ++jj) { const int kj = 16 * (kt0 + t) + 4 * q + jj, delta = 128 + qi - kj;
            const bool valid = (delta >= 0) && (delta <= 128) && (n > 0 || kj >= 128);
            const float v = valid ? sc[t][jj] - sl2 * (float)delta : -INFINITY; sc[t][jj] = v; mx = fmaxf(mx, v); }
    mx = fmaxf(mx, __shfl_xor(mx, 16)); mx = fmaxf(mx, __shfl_xor(mx, 32));
    float l = 0.f;
#pragma unroll
    for (int t = 0; t < 10; ++t)
#pragma unroll
        for (int jj = 0; jj < 4; ++jj) { const float p = __builtin_amdgcn_exp2f(sc[t][jj] - mx); sc[t][jj] = p; l += p; }
    l += __shfl_xor(l, 16); l += __shfl_xor(l, 32);
    bf16x8 pf[5];
#pragma unroll
    for (int pp = 0; pp < 5; ++pp) { u32x4 wv; wv.x = pk2(sc[2 * pp][0], sc[2 * pp][1]); wv.y = pk2(sc[2 * pp][2], sc[2 * pp][3]); wv.z = pk2(sc[2 * pp + 1][0], sc[2 * pp + 1][1]); wv.w = pk2(sc[2 * pp + 1][2], sc[2 * pp + 1][3]);
        pf[pp] = __builtin_bit_cast(bf16x8, wv); }
    f32x4 o[8];
#pragma unroll
    for (int dt = 0; dt < 8; ++dt) o[dt] = (f32x4){0.f, 0.f, 0.f, 0.f};
#pragma unroll
    for (int pp = 0; pp < 5; ++pp)
#pragma unroll
        for (int dt = 0; dt < 8; ++dt) { const LAS unsigned char* p0 = Vimg + (16 * (kt0 + 2 * pp) + 4 * q + (r >> 2)) * 272 + (16 * dt + 4 * (r & 3)) * 2;
            o[dt] = mfma16(tr_frag(p0, p0 + 16 * 272), pf[pp], o[dt]); }
    const float inv = 1.0f / l;
    const size_t orow = (size_t)br * M + (size_t)b * SEQ + tokq;
    bf16* op = obr + orow * 768 + h * 128 + 4 * q;
#pragma unroll
    for (int dt = 0; dt < 8; ++dt) *(u32x2*)(op + 16 * dt) = pack4(o[dt] * inv);
    if (q == 0) lse[orow * 6 + h] = (mx + __builtin_amdgcn_logf(l)) * LN2;
    __syncthreads();
}
DI void attn_combine(const bf16* obr, const float* lse, bf16* mix, int gi0, int nthreads) {
    const int gi = opaque(gi0);
    constexpr int UN = 4;
    for (int idx0 = gi; idx0 < M * 96; idx0 += nthreads * UN) {
        float l[UN][3]; u32x4 raw[UN][3]; int row[UN], c8[UN];
#pragma unroll
        for (int u = 0; u < UN; ++u) { int idx = idx0 + u * nthreads; if (idx >= M * 96) idx = M * 96 - 1; row[u] = idx / 96; c8[u] = idx % 96; const int h = c8[u] >> 4;
#pragma unroll
            for (int br = 0; br < 3; ++br) { l[u][br] = lse[((size_t)br * M + row[u]) * 6 + h]; raw[u][br] = *(const u32x4*)(obr + ((size_t)br * M + row[u]) * 768 + c8[u] * 8); } }
#pragma unroll
        for (int u = 0; u < UN; ++u) {
            const float mx = fmaxf(l[u][0], fmaxf(l[u][1], l[u][2]));
            float w0 = __expf(l[u][0] - mx), w1 = __expf(l[u][1] - mx), w2 = __expf(l[u][2] - mx); const float inv = 1.0f / (w0 + w1 + w2); w0 *= inv; w1 *= inv; w2 *= inv;
            float a[8], bq[8], cc[8]; unpack8(raw[u][0], a); unpack8(raw[u][1], bq); unpack8(raw[u][2], cc);
#pragma unroll
            for (int e = 0; e < 8; ++e) a[e] = w0 * a[e] + w1 * bq[e] + w2 * cc[e];
            if (idx0 + u * nthreads < M * 96) *(u32x4*)(mix + (size_t)row[u] * DM + 1280 + c8[u] * 8) = pack8(a);
        }
    }
}
DI void dn_conv16(const bf16* proj, int b, int tpos, int col, const float* cw, float* y) {
    float acc[16];
#pragma unroll
    for (int e = 0; e < 16; ++e) acc[e] = 0.f;
#pragma unroll
    for (int j = 0; j < 4; ++j) { const int tt = tpos - 3 + j;
        u32x4 x0 = {0u, 0u, 0u, 0u}, x1 = {0u, 0u, 0u, 0u};
        if (tt >= 0) { const bf16* p = proj + ((size_t)b * SEQ + tt) * NPROJ + col; x0 = *(const u32x4*)p; x1 = *(const u32x4*)(p + 8); }
        float xf[16]; unpack8(x0, xf); unpack8(x1, xf + 8);
        const f32x4* wp = (const f32x4*)(cw + (size_t)j * 2304);
#pragma unroll
        for (int e4 = 0; e4 < 4; ++e4) { const f32x4 wv = wp[e4];
#pragma unroll
            for (int k = 0; k < 4; ++k) acc[4 * e4 + k] += wv[k] * xf[4 * e4 + k]; } }
#pragma unroll
    for (int e = 0; e < 16; ++e) y[e] = silu_f(acc[e]);
}
DI void dn_prep_item(int item, const bf16* proj, const float* bd, const float* conv_w, const float* a_log, const float* dt_bias, unsigned char* dnall, float* gl_out, LAS unsigned char* lds, int tid0) {
    const int tid = opaque(tid0);
    const int n = item & 31, bh = item >> 5, h = bh % NH, b = bh / NH, t0 = 64 * n;
    unsigned char* dn = dnall + (size_t)item * DN_STRIDE;
    LAS unsigned char* Kimg = lds; LAS unsigned char* Qimg = lds + 17408; LAS unsigned char* KBG = lds + 34816; LAS unsigned char* VB = lds + 52224;
    LAS unsigned char* Amat = lds + 69632; LAS unsigned char* Timg = lds + 87040; LAS float* G = (LAS float*)(lds + 96256); LAS float* BETA = (LAS float*)(lds + 96512);
    const int w = tid >> 6, lane = tid & 63, r = lane & 15, q = lane >> 4;
    if (w == 0) {
        const size_t row = (size_t)b * SEQ + t0 + lane;
        const float bl = bd[row * 12 + h], av = bd[row * 12 + 6 + h];
        const float xx = av + dt_bias[h];
        const float sp = xx > 20.f ? xx : log1pf(expf(xx));
        float gs = -expf(a_log[h]) * sp;
#pragma unroll
        for (int o = 1; o < 64; o <<= 1) { const float t = __shfl_up(gs, o); if (lane >= o) gs += t; }
        G[lane] = gs; BETA[lane] = 1.0f / (1.0f + expf(-bl));
    }
    __syncthreads();
    {
        const int i = tid >> 3, p = tid & 7;
        const float gi = G[i], bi = BETA[i], eg = expf(gi);
        float y[16];
        dn_conv16(proj, b, t0 + i, C_BQ + h * 128 + 16 * p, conv_w + h * 128 + 16 * p, y);
        { float ss = 0.f;
#pragma unroll
            for (int e = 0; e < 16; ++e) ss += y[e] * y[e];
            ss += __shfl_xor(ss, 1); ss += __shfl_xor(ss, 2); ss += __shfl_xor(ss, 4);
            const float rs = (1.0f / sqrtf(ss + EPS)) * 0.08838834764831845f;
            float t[16], tg[16];
#pragma unroll
            for (int e = 0; e < 16; ++e) { t[e] = y[e] * rs; tg[e] = t[e] * eg; }
            *(LAS u32x4*)(Qimg + i * 272 + p * 32) = pack8(t); *(LAS u32x4*)(Qimg + i * 272 + p * 32 + 16) = pack8(t + 8);
            *(u32x4*)(dn + DN_QG + (i * 128 + 16 * p) * 2) = pack8(tg); *(u32x4*)(dn + DN_QG + (i * 128 + 16 * p + 8) * 2) = pack8(tg + 8); }
        dn_conv16(proj, b, t0 + i, C_BK + h * 128 + 16 * p, conv_w + 768 + h * 128 + 16 * p, y);
        { float ss = 0.f;
#pragma unroll
            for (int e = 0; e < 16; ++e) ss += y[e] * y[e];
            ss += __shfl_xor(ss, 1); ss += __shfl_xor(ss, 2); ss += __shfl_xor(ss, 4);
            const float rs = 1.0f / sqrtf(ss + EPS);
            float t[16], tg[16];
#pragma unroll
            for (int e = 0; e < 16; ++e) { t[e] = y[e] * rs; tg[e] = t[e] * (bi * eg); }
            *(LAS u32x4*)(Kimg + i * 272 + p * 32) = pack8(t); *(LAS u32x4*)(Kimg + i * 272 + p * 32 + 16) = pack8(t + 8);
            *(LAS u32x4*)(KBG + i * 272 + p * 32) = pack8(tg); *(LAS u32x4*)(KBG + i * 272 + p * 32 + 16) = pack8(tg + 8); }
        dn_conv16(proj, b, t0 + i, C_BV + h * 128 + 16 * p, conv_w + 1536 + h * 128 + 16 * p, y);
        { float t[16];
#pragma unroll
            for (int e = 0; e < 16; ++e) t[e] = y[e] * bi;
            *(LAS u32x4*)(VB + i * 272 + p * 32) = pack8(t); *(LAS u32x4*)(VB + i * 272 + p * 32 + 16) = pack8(t + 8); }
    }
    __syncthreads();
    {
        const int it = w & 3;
        const int i = 16 * it + r; const float gi = G[i], bi = BETA[i];
#pragma unroll
        for (int e = 0; e < 2; ++e) { const int jt = 2 * (w >> 2) + e;
            f32x4 kk = {0.f, 0.f, 0.f, 0.f}, qk = {0.f, 0.f, 0.f, 0.f};
#pragma unroll
            for (int s = 0; s < 4; ++s) { const bf16x8 a = ld_frag(Kimg + (16 * jt + r) * 272 + (32 * s + 8 * q) * 2);
                kk = mfma16(a, ld_frag(Kimg + (16 * it + r) * 272 + (32 * s + 8 * q) * 2), kk);
                qk = mfma16(a, ld_frag(Qimg + (16 * it + r) * 272 + (32 * s + 8 * q) * 2), qk); }
            f32x4 av, at;
#pragma unroll
            for (int jj = 0; jj < 4; ++jj) { const int j = 16 * jt + 4 * q + jj; const float dec = (j <= i) ? expf(gi - G[j]) : 0.f;
                av[jj] = (j < i) ? bi * kk[jj] * dec : 0.f; at[jj] = qk[jj] * dec; }
            *(LAS f32x4*)(Amat + i * 272 + (16 * jt + 4 * q) * 4) = av;
            *(u32x2*)(dn + DN_ATT + (i * 64 + 16 * jt + 4 * q) * 2) = pack4(at); }
    }
    __syncthreads();
#ifndef NO_TINV
    if (w == 0) {
        LAS float* Tl = (LAS float*)(lds + 96768);
#pragma unroll 1
        for (int i = 0; i < 64; ++i) {
            const LAS float* arow = (const LAS float*)(Amat + i * 272);
            float s0 = arow[lane], s1 = 0.f, s2 = 0.f, s3 = 0.f;
            int j = 0;
            for (; j + 3 < i; j += 4) { const f32x4 a4 = *(const LAS f32x4*)(arow + j);
                s0 += a4[0] * Tl[(j + 0) * 64 + lane]; s1 += a4[1] * Tl[(j + 1) * 64 + lane]; s2 += a4[2] * Tl[(j + 2) * 64 + lane]; s3 += a4[3] * Tl[(j + 3) * 64 + lane]; }
            for (; j < i; ++j) s0 += arow[j] * Tl[j * 64 + lane];
            const float t = -((s0 + s1) + (s2 + s3));
            Tl[i * 64 + lane] = t;
            *(LAS unsigned short*)(Timg + i * 144 + lane * 2) = (unsigned short)(pk2(t, 0.f) & 0xffffu);
        }
        asm volatile("s_waitcnt lgkmcnt(0)" ::: "memory");
        *(LAS unsigned short*)(Timg + lane * 144 + lane * 2) = (unsigned short)0x3F80u;
    }
#endif
    __syncthreads();
    {
        const int ct = w & 3; const float glast = G[63];
        bf16x8 tf[2];
#pragma unroll
        for (int ks = 0; ks < 2; ++ks) tf[ks] = ld_frag(Timg + (16 * ct + r) * 144 + (32 * ks + 8 * q) * 2);
        float dk4[4];
#pragma unroll
        for (int jj = 0; jj < 4; ++jj) dk4[jj] = expf(glast - G[16 * ct + 4 * q + jj]);
#pragma unroll
        for (int e = 0; e < 4; ++e) { const int dt = 4 * (w >> 2) + e;
            f32x4 au = {0.f, 0.f, 0.f, 0.f}, aw = {0.f, 0.f, 0.f, 0.f};
#pragma unroll
            for (int ks = 0; ks < 2; ++ks) { const int ro = (32 * ks + 8 * q + (r >> 2)) * 272 + (16 * dt + 4 * (r & 3)) * 2;
                au = mfma16(tf[ks], tr_frag(VB + ro, VB + ro + 4 * 272), au);
                aw = mfma16(tr_frag(KBG + ro, KBG + ro + 4 * 272), tf[ks], aw); }
            *(u32x2*)(dn + DN_UT + ((16 * dt + r) * 64 + 16 * ct + 4 * q) * 2) = pack4(au);
            *(u32x2*)(dn + DN_WK + ((16 * ct + r) * 128 + 16 * dt + 4 * q) * 2) = pack4(aw);
            const s16x4 kv = tr4(Kimg + (16 * ct + 4 * q + (r >> 2)) * 272 + (16 * dt + 4 * (r & 3)) * 2);
            f32x4 kd;
#pragma unroll
            for (int jj = 0; jj < 4; ++jj) kd[jj] = __uint_as_float(((unsigned)(unsigned short)kv[jj]) << 16) * dk4[jj];
            *(u32x2*)(dn + DN_KDT + ((16 * dt + r) * 64 + 16 * ct + 4 * q) * 2) = pack4(kd); }
        if (tid == 0) gl_out[item] = expf(glast);
    }
    __syncthreads();
}
struct ScanOps { bf16x8 wf[4], qf[4], af[2]; u32x2 uu[2]; float g; };
DI void scan_load(ScanOps& o, const unsigned char* dn, const float* gl, int ci, int ct, int dvs, int dvt0, int nt0, int r, int q) {
#pragma unroll
    for (int ks = 0; ks < 4; ++ks) { o.wf[ks] = *(const bf16x8*)(dn + DN_WK + ((16 * ct + r) * 128 + 32 * ks + 8 * q) * 2); o.qf[ks] = *(const bf16x8*)(dn + DN_QG + ((16 * ct + r) * 128 + 32 * ks + 8 * q) * 2); }
#pragma unroll
    for (int e = 0; e < 2; ++e) o.uu[e] = *(const u32x2*)(dn + DN_UT + ((dvs * 64 + 16 * (dvt0 + e) + r) * 64 + 16 * ct + 4 * q) * 2);
#pragma unroll
    for (int ks = 0; ks < 2; ++ks) o.af[ks] = *(const bf16x8*)(dn + DN_ATT + ((16 * ct + r) * 64 + 32 * ks + 8 * q) * 2);
    o.g = gl[ci];
}
DI void scan_step(const ScanOps& c, const unsigned char* dn, f32x4 (&Sacc)[4], float* op, LAS unsigned char* Simg, LAS unsigned char* VNT, int ct, int dvt0, int mt, int nt0, int r, int q) {
    f32x4 wsa[2], qsa[2];
    bf16x8 kf[4][2];
#pragma unroll
    for (int e = 0; e < 4; ++e)
#pragma unroll
        for (int ks = 0; ks < 2; ++ks) kf[e][ks] = *(const bf16x8*)(dn + DN_KDT + ((16 * (nt0 + e) + r) * 64 + 32 * ks + 8 * q) * 2);
#pragma unroll
    for (int e = 0; e < 2; ++e) { wsa[e] = (f32x4){0.f, 0.f, 0.f, 0.f}; qsa[e] = (f32x4){0.f, 0.f, 0.f, 0.f}; }
#pragma unroll
    for (int ks = 0; ks < 4; ++ks)
#pragma unroll
        for (int e = 0; e < 2; ++e) { const LAS unsigned char* p0 = Simg + (32 * ks + 8 * q + (r >> 2)) * 144 + (16 * (dvt0 + e) + 4 * (r & 3)) * 2;
            const bf16x8 sf = tr_frag(p0, p0 + 4 * 144);
            wsa[e] = mfma16(c.wf[ks], sf, wsa[e]); qsa[e] = mfma16(c.qf[ks], sf, qsa[e]); }
#pragma unroll
    for (int e = 0; e < 2; ++e) { const int dv = 16 * (dvt0 + e) + r; const u32x2 uu = c.uu[e];
        f32x4 vn; vn[0] = bflo(uu.x) - wsa[e][0]; vn[1] = bfhi(uu.x) - wsa[e][1]; vn[2] = bflo(uu.y) - wsa[e][2]; vn[3] = bfhi(uu.y) - wsa[e][3];
        *(LAS u32x2*)(VNT + dv * 144 + (16 * ct + 4 * q) * 2) = pack4(vn); }
    lds_barrier();
#pragma unroll
    for (int ks = 0; ks < 2; ++ks)
#pragma unroll
        for (int e = 0; e < 2; ++e) qsa[e] = mfma16(c.af[ks], ld_frag(VNT + (16 * (dvt0 + e) + r) * 144 + (32 * ks + 8 * q) * 2), qsa[e]);
#pragma unroll
    for (int e = 0; e < 2; ++e)
#pragma unroll
        for (int jj = 0; jj < 4; ++jj) op[(size_t)jj * 768 + 16 * (dvt0 + e)] = qsa[e][jj];
    bf16x8 af2[2];
#pragma unroll
    for (int ks = 0; ks < 2; ++ks) af2[ks] = ld_frag(VNT + (16 * mt + r) * 144 + (32 * ks + 8 * q) * 2);
#pragma unroll
    for (int e = 0; e < 4; ++e) { Sacc[e] = Sacc[e] * c.g;
#pragma unroll
        for (int ks = 0; ks < 2; ++ks) Sacc[e] = mfma16(af2[ks], kf[e][ks], Sacc[e]);
        *(LAS u32x2*)(Simg + (16 * (nt0 + e) + r) * 144 + (16 * mt + 4 * q) * 2) = pack4(Sacc[e]); }
    lds_barrier();
}
DI void dn_scan_item(int item, const unsigned char* dnall, const float* gl, float* odn, LAS unsigned char* lds, int tid0) {
    const int tid = opaque(tid0);
    const int dvs = item & 1, bh = item >> 1, h = bh % NH, b = bh / NH;
    LAS unsigned char* Simg = lds; LAS unsigned char* VNT = lds + 18432;
    for (int u = tid; u < 18432 / 16; u += NTHR) *(LAS u32x4*)(Simg + u * 16) = (u32x4){0u, 0u, 0u, 0u};
    const int w = tid >> 6, lane = tid & 63, r = lane & 15, q = lane >> 4;
    const int ct = w >> 1, dvt0 = 2 * (w & 1), mt = w & 3, nt0 = 4 * (w >> 2);
    f32x4 Sacc[4];
#pragma unroll
    for (int e = 0; e < 4; ++e) Sacc[e] = (f32x4){0.f, 0.f, 0.f, 0.f};
    const unsigned char* dn0 = dnall + (size_t)(bh * 32) * DN_STRIDE;
    float* op0 = odn + ((size_t)b * SEQ + 16 * ct + 4 * q) * 768 + h * 128 + dvs * 64 + r;
    ScanOps A, B;
    scan_load(A, dn0, gl, bh * 32, ct, dvs, dvt0, nt0, r, q);
    __syncthreads();
#pragma unroll 1
    for (int n = 0; n < 32; n += 2) {
        scan_load(B, dn0 + (size_t)(n + 1) * DN_STRIDE, gl, bh * 32 + n + 1, ct, dvs, dvt0, nt0, r, q);
        scan_step(A, dn0 + (size_t)n * DN_STRIDE, Sacc, op0 + (size_t)(64 * n) * 768, Simg, VNT, ct, dvt0, mt, nt0, r, q);
        const int n2 = (n + 2 < 32) ? n + 2 : 31;
        scan_load(A, dn0 + (size_t)n2 * DN_STRIDE, gl, bh * 32 + n2, ct, dvs, dvt0, nt0, r, q);
        scan_step(B, dn0 + (size_t)(n + 1) * DN_STRIDE, Sacc, op0 + (size_t)(64 * (n + 1)) * 768, Simg, VNT, ct, dvt0, mt, nt0, r, q);
    }
}
DI void dn_gate_phase(const float* odn, const bf16* proj, const float* ong, bf16* mix, int gw, int ngw, int lane0) {
    const int lane = opaque(lane0);
    const int sub = lane >> 4, l16 = lane & 15;
    float gv[8];
#pragma unroll
    for (int e = 0; e < 8; ++e) gv[e] = ong[l16 * 8 + e];
    constexpr int UN = 4, NIT = M * NH / 4;
    for (int it0 = gw; it0 < NIT; it0 += ngw * UN) {
        f32x4 o0[UN], o1[UN]; u32x4 graw[UN]; int row[UN], hh[UN];
#pragma unroll
        for (int u = 0; u < UN; ++u) { int it = it0 + u * ngw; if (it >= NIT) it = NIT - 1; const int idx = it * 4 + sub; row[u] = idx / NH; hh[u] = idx % NH;
            const float* op = odn + (size_t)row[u] * 768 + hh[u] * 128 + l16 * 8; o0[u] = *(const f32x4*)op; o1[u] = *(const f32x4*)(op + 4);
            graw[u] = *(const u32x4*)(proj + (size_t)row[u] * NPROJ + C_BG + hh[u] * 128 + l16 * 8); }
#pragma unroll
        for (int u = 0; u < UN; ++u) {
            float ss = (o0[u][0] * o0[u][0] + o0[u][1] * o0[u][1]) + (o0[u][2] * o0[u][2] + o0[u][3] * o0[u][3]) + (o1[u][0] * o1[u][0] + o1[u][1] * o1[u][1]) + (o1[u][2] * o1[u][2] + o1[u][3] * o1[u][3]);
            ss += __shfl_xor(ss, 1); ss += __shfl_xor(ss, 2); ss += __shfl_xor(ss, 4); ss += __shfl_xor(ss, 8);
            const float rs = 1.0f / sqrtf(ss * (1.0f / 128.0f) + EPS);
            float gt[8]; unpack8(graw[u], gt);
            float y[8];
#pragma unroll
            for (int e = 0; e < 4; ++e) { y[e] = o0[u][e] * rs * gv[e] * silu_f(gt[e]); y[4 + e] = o1[u][e] * rs * gv[4 + e] * silu_f(gt[4 + e]); }
            if (it0 + u * ngw < NIT) *(u32x4*)(mix + (size_t)row[u] * DM + 512 + hh[u] * 128 + l16 * 8) = pack8(y);
        }
    }
}

struct Args { const float* in[16]; float* out; unsigned char* ws; };
#ifndef MK_SKIP_MIX
#define MK_SKIP_MIX 0
#endif
#ifndef REP_M1
#define REP_M1 1
#endif
#ifndef REP_M2
#define REP_M2 1
#endif
#ifndef REP_G13
#define REP_G13 1
#endif
__global__ void __launch_bounds__(NTHR, 2) hybrid_fwd(Args a) {
    extern __shared__ __attribute__((aligned(16))) unsigned char lds_raw[];
    LAS unsigned char* lds = (LAS unsigned char*)lds_raw;
    cg::grid_group grid = cg::this_grid();
    const int tid = threadIdx.x, lane = tid & 63, wave = __builtin_amdgcn_readfirstlane(tid >> 6);
    const int G = gridDim.x, bx = blockIdx.x, gw = bx * 8 + wave, ngw = G * 8;
    unsigned char* ws = a.ws;
    bf16* Hb = (bf16*)(ws + WS_H); bf16* PROJ = (bf16*)(ws + WS_PROJ); float* BD = (float*)(ws + WS_BD); unsigned char* DN = ws + WS_DN; float* GL = (float*)(ws + WS_GL);
    float* ODN = (float*)(ws + WS_ODN); bf16* OBR = (bf16*)(ws + WS_OBR); float* LSE = (float*)(ws + WS_LSE);
    bf16* MIX = Hb; bf16* ACT = PROJ;

#ifndef NO_P0
    weight_prep(a.in, ws, lds, gw, ngw, wave, lane);
#endif
    __syncthreads();
    norm_phase(a.in[I_X], a.in[I_N1G], Hb, a.in[I_WIN], BD, lds, gw, ngw, tid, lane);
    grid.sync();
#pragma unroll 1
    for (int l = 0; l < DEPTH; ++l) {
        const unsigned char* wl = ws + WS_W + (size_t)l * SZ_WL;
        const bf16* Win_t = (const bf16*)wl; const bf16* Wout_t = (const bf16*)(wl + SZ_WIN); const bf16* Wgu_t = (const bf16*)(wl + SZ_WIN + SZ_WOUT); const bf16* Wdn_t = (const bf16*)(wl + SZ_WIN + SZ_WOUT + SZ_WGU);
        const float* xin = (l == 0) ? a.in[I_X] : a.out;
        if (l > 0) { norm_phase(a.out, a.in[I_N1G] + (size_t)l * DM, Hb, a.in[I_WIN] + (size_t)l * DM * IN_TOTAL, BD, lds, gw, ngw, tid, lane); grid.sync(); }
#ifndef NO_G1
        { pg8::Gemm g{Hb, Win_t, M, NPROJ, DM}; pg8::StaticOrder S; S.init(M, NPROJ, G, bx);
          pg8::EpiBf16<0> E{PROJ, NPROJ, nullptr, 0, 0, 1.f};
          pg8::gemm_phase<pg8::EpiBf16<0>, pg8::StaticOrder, true, true>(lds, g, S, E); }
#endif
        grid.sync();
#if !MK_SKIP_MIX
        for (int rep = 0; rep < REP_M1; ++rep) {
        for (int it = bx; it < 2304 + 1536 + 512; it += G) {
            if (it < 2304) {
#ifndef NO_ATTN
 attn_item(it, PROJ, a.in[I_QNG] + l * HD, a.in[I_KNG] + l * HD, OBR, LSE, lds, tid);
#endif
 }
            else if (it < 2304 + 1536) {
#ifndef NO_PREP
 dn_prep_item(it - 2304, PROJ, BD, a.in[I_CONVW] + (size_t)l * 4 * 2304, a.in[I_ALOG] + l * NH, a.in[I_DTB] + l * NH, DN, GL, lds, tid);
#endif
 }
            else {
#ifndef NO_SGU
 sgu_item(it - 3840, PROJ, a.in[I_SGUG] + l * 512, a.in[I_WS] + (size_t)l * 4 * 128 * 128, a.in[I_BS] + l * 512, MIX, lds, tid);
#endif
 }
        }
        grid.sync();
        }
        for (int rep = 0; rep < REP_M2; ++rep) {
        if (G > NSCAN) {
            if (bx < NSCAN) {
#ifndef NO_SCAN
 dn_scan_item(bx, DN, GL, ODN, lds, tid);
#endif
 }
            else attn_combine(OBR, LSE, MIX, (bx - NSCAN) * NTHR + tid, (G - NSCAN) * NTHR);
        } else {
            for (int it = bx; it < NSCAN; it += G) { dn_scan_item(it, DN, GL, ODN, lds, tid); __syncthreads(); }
            attn_combine(OBR, LSE, MIX, bx * NTHR + tid, G * NTHR);
        }
        grid.sync();
        dn_gate_phase(ODN, PROJ, a.in[I_ONG] + l * HD, MIX, gw, ngw, lane);
        grid.sync();
        }
#else
        for (size_t u = (size_t)bx * NTHR + tid; u < (size_t)M * DM / 8; u += (size_t)G * NTHR) ((u32x4*)MIX)[u] = (u32x4){0u, 0u, 0u, 0u};
        grid.sync();
#endif
#ifndef NO_G2
        { pg8::Gemm g{MIX, Wout_t, M, DM, DM}; pg8::StaticOrder S; S.init(M, DM, G, bx);
          pg8::EpiResF32 E{xin, a.out, DM};
          pg8::gemm_phase<pg8::EpiResF32, pg8::StaticOrder, true, true>(lds, g, S, E); }
#endif
        grid.sync();
        norm_phase(a.out, a.in[I_N2G] + (size_t)l * DM, Hb, nullptr, nullptr, lds, gw, ngw, tid, lane);
        grid.sync();
#ifndef NO_G3
        { pg8::Gemm g{Hb, Wgu_t, M, 2 * FF, DM}; pg8::StaticOrder S; S.init(M, 2 * FF, G, bx);
          pg8::EpiSwiGLU E{ACT, FF};
          pg8::gemm_phase<pg8::EpiSwiGLU, pg8::StaticOrder, true, true>(lds, g, S, E); }
#endif
        grid.sync();
#ifndef NO_G4
        { pg8::Gemm g{ACT, Wdn_t, M, DM, FF}; pg8::StaticOrder S; S.init(M, DM, G, bx);
          pg8::EpiResF32 E{a.out, a.out, DM};
          pg8::gemm_phase<pg8::EpiResF32, pg8::StaticOrder, true, true>(lds, g, S, E); }
#endif
        if (l + 1 < DEPTH) grid.sync();
    }
}

extern "C" void kernel_launch(void* const* d_in, const int* in_sizes, int n_in, void* d_out, int out_size, void* d_ws, size_t ws_size, hipStream_t stream) {
    static int grid = 0;
    if (grid == 0) {
        if (n_in != 16 || in_sizes[0] != M * DM || out_size != M * DM || ws_size < WS_END) { fprintf(stderr, "kernel_launch: unexpected shapes / workspace (n_in %d, ws %zu, need %zu); nothing launched\n", n_in, ws_size, (size_t)WS_END); grid = -1; return; }
        int dev = 0, cus = 0, per_cu = 0;
        if (hipGetDevice(&dev) != hipSuccess || hipDeviceGetAttribute(&cus, hipDeviceAttributeMultiprocessorCount, dev) != hipSuccess) { grid = -1; return; }
        if (hipFuncSetAttribute((const void*)hybrid_fwd, hipFuncAttributeMaxDynamicSharedMemorySize, LDS_BYTES) != hipSuccess) { fprintf(stderr, "kernel_launch: hipFuncSetAttribute failed\n"); grid = -1; return; }
        if (hipOccupancyMaxActiveBlocksPerMultiprocessor(&per_cu, (const void*)hybrid_fwd, NTHR, LDS_BYTES) != hipSuccess || per_cu < 1) { fprintf(stderr, "kernel_launch: occupancy query says %d blocks per CU\n", per_cu); per_cu = 1; }
        (void)hipGetLastError();
        grid = cus;
    }
    if (grid < 0) return;
    Args a{};
    for (int i = 0; i < 16; ++i) a.in[i] = (const float*)d_in[i];
    a.out = (float*)d_out; a.ws = (unsigned char*)d_ws;
    void* args[] = {&a};
    hipError_t e = hipLaunchCooperativeKernel((const void*)hybrid_fwd, dim3(grid), dim3(NTHR), args, LDS_BYTES, stream);
    if (e != hipSuccess) fprintf(stderr, "kernel_launch: cooperative launch failed: %s (grid %d)\n", hipGetErrorString(e), grid);
}
```

```cpp
#include <hip/hip_runtime.h>
#include <hip/hip_cooperative_groups.h>
#include <cstdio>
#include <cstdint>
namespace cg = cooperative_groups;
namespace pg8 {
#define PG8_LAS __attribute__((address_space(3)))
typedef unsigned short bf16_t;
typedef short bf16x8 __attribute__((ext_vector_type(8)));
typedef float f32x4 __attribute__((ext_vector_type(4)));
typedef unsigned u32x4 __attribute__((ext_vector_type(4)));
constexpr int BM = 256, BK = 64, HALF = 128, HTB = HALF * BK * 2  , STAGE_BYTES = 8 * HTB, NXCD = 8, WGM = 8;

__host__ __device__ __forceinline__ int lds_byte(int r, int c) { const int st = (r >> 4) * 2 + (c >> 5), rr = r & 15, cc = c & 31, ob = rr * 64 + cc * 2; return st * 1024 + (ob ^ (((ob >> 9) & 1) << 5)); }
__host__ __device__ __forceinline__ void stage_rc(int b, int& R, int& C) { const int st = b / 1024, sb = b % 1024, swz = sb ^ (((sb >> 9) & 1) << 5); R = (st >> 1) * 16 + swz / 64; C = (st & 1) * 32 + (swz % 64) / 2; }
__host__ __device__ __forceinline__ int perm32(int rho) { const int n = rho >> 4, i = rho & 15; return 8 * (i >> 2) + 4 * n + (i & 3); }

struct Unit { int pm, pn; };
struct Gemm { const bf16_t* A; const bf16_t* Bt; int M, N, K; };

struct StaticOrder {
    int nM, nN, nwg, G, c;
    __host__ __device__ void init(int M, int N, int G_, int c_) { nM = M / BM; nN = N / BM; nwg = nM * nN; G = G_; c = c_; }
    __host__ __device__ bool next(int i, Unit& u) const {
        const long L = (long)i * G + c; if (L >= nwg) return false;
        int wgid = (int)L; { const int q = nwg / NXCD, r = nwg % NXCD, xcd = wgid % NXCD, off = wgid / NXCD; wgid = (xcd < r ? xcd * (q + 1) : r * (q + 1) + (xcd - r) * q) + off; }
        const int nig = WGM * nN, gid = wgid / nig, fm = gid * WGM, gsz = (nM - fm) < WGM ? (nM - fm) : WGM;
        u.pm = fm + ((wgid % nig) % gsz); u.pn = (wgid % nig) / gsz; return true;
    }
    __device__ __forceinline__ void a_ready(const Unit&) const {}
    __device__ __forceinline__ void done(const Unit&) const {}
};

__device__ __forceinline__ unsigned cvt_pk_bf16(float lo, float hi) { unsigned r; asm volatile("v_cvt_pk_bf16_f32 %0, %1, %2" : "=v"(r) : "v"(lo), "v"(hi)); return r; }
typedef float f32x2 __attribute__((ext_vector_type(2)));
__device__ __forceinline__ f32x2 gelu_pk(f32x2 v) {
    const f32x2 av = __builtin_elementwise_abs(v), d = av * 0.2316418882f + 1.0f;
    f32x2 t; t.x = __builtin_amdgcn_rcpf(d.x); t.y = __builtin_amdgcn_rcpf(d.y);
    f32x2 q = t * 0.5307027145f + (-0.7265760135f); q = q * t + 0.7107068705f; q = q * t + (-0.142248368f); q = q * t + 0.127414796f; q = q * t;
    const f32x2 s = (v * v) * (-0.72134752044f);
    f32x2 e; e.x = __builtin_amdgcn_exp2f(s.x); e.y = __builtin_amdgcn_exp2f(s.y);
    const f32x2 m = v * (q * e), r = v - m;
    f32x2 o; o.x = v.x < 0.f ? m.x : r.x; o.y = v.y < 0.f ? m.y : r.y; return o;
}

template <int ACT  > struct EpiBf16 {
    static constexpr bool PERM = true, AFTER_DRAIN = false; static_assert(ACT == 0 || ACT == 1, "EpiBf16: ACT is 0 (none) or 1 (gelu_pk)");
    bf16_t* O; int ldc; const float* bias; int split_cols; size_t split_stride; float scale0;
    __device__ __forceinline__ void operator()(const f32x4 (&acc)[2][2][4][2], const Unit& u, int wr, int wc, int fr, int fq) const {
        const int row0 = u.pm * BM + wr * 64 + fr; int colt = u.pn * BM; bf16_t* base = O;
        float sc = 1.f; if (split_cols) { const int t = colt / split_cols; base += (size_t)t * split_stride; colt -= t * split_cols; if (t == 0) sc = scale0; }
        const int col0 = colt + wc * 32 + 8 * fq, bcol0 = u.pn * BM + wc * 32 + 8 * fq;
        f32x4 bv[2][2];
#pragma unroll
        for (int bj = 0; bj < 2; ++bj)
#pragma unroll
            for (int n = 0; n < 2; ++n) bv[bj][n] = bias ? *(const f32x4*)(bias + bcol0 + bj * HALF + 4 * n) : (f32x4){0.f, 0.f, 0.f, 0.f};
#pragma unroll
        for (int ai = 0; ai < 2; ++ai)
#pragma unroll
            for (int m = 0; m < 4; ++m) { bf16_t* rowp = base + (size_t)(row0 + ai * HALF + m * 16) * ldc + col0;
#pragma unroll
                for (int bj = 0; bj < 2; ++bj) { f32x4 v0 = acc[ai][bj][m][0] + bv[bj][0], v1 = acc[ai][bj][m][1] + bv[bj][1];
                    if (ACT == 1) { f32x2 a = gelu_pk((f32x2){v0[0], v0[1]}), b = gelu_pk((f32x2){v0[2], v0[3]}), c = gelu_pk((f32x2){v1[0], v1[1]}), d = gelu_pk((f32x2){v1[2], v1[3]});
                        v0 = (f32x4){a.x, a.y, b.x, b.y}; v1 = (f32x4){c.x, c.y, d.x, d.y}; }
                    v0 = v0 * sc; v1 = v1 * sc; u32x4 w; w.x = cvt_pk_bf16(v0[0], v0[1]); w.y = cvt_pk_bf16(v0[2], v0[3]); w.z = cvt_pk_bf16(v1[0], v1[1]); w.w = cvt_pk_bf16(v1[2], v1[3]);
                    *(u32x4*)(rowp + bj * HALF) = w; } }
    }
};
struct EpiResF32 {
    static constexpr bool PERM = false, AFTER_DRAIN = false;
    const float* base; float* out; int ldc;
    __device__ __forceinline__ void operator()(const f32x4 (&acc)[2][2][4][2], const Unit& u, int wr, int wc, int fr, int fq) const {
        const int row0 = u.pm * BM + wr * 64 + fr; const int col0 = u.pn * BM + wc * 32 + 4 * fq;
#pragma unroll
        for (int ai = 0; ai < 2; ++ai)
#pragma unroll
            for (int m = 0; m < 4; ++m) { const size_t off = (size_t)(row0 + ai * HALF + m * 16) * ldc + col0;
#pragma unroll
                for (int bj = 0; bj < 2; ++bj)
#pragma unroll
                    for (int n = 0; n < 2; ++n) { const f32x4 b = *(const f32x4*)(base + off + bj * HALF + n * 16); *(f32x4*)(out + off + bj * HALF + n * 16) = b + acc[ai][bj][m][n]; } }
    }
};
__device__ __forceinline__ float silu_f(float g) { return g * __builtin_amdgcn_rcpf(1.0f + __expf(-g)); }
struct EpiSwiGLU {
    static constexpr bool PERM = true, AFTER_DRAIN = false;
    bf16_t* O; int ldo;
    __device__ __forceinline__ void operator()(const f32x4 (&acc)[2][2][4][2], const Unit& u, int wr, int wc, int fr, int fq) const {
        const int row0 = u.pm * BM + wr * 64 + fr; const int col0 = u.pn * HALF + wc * 32 + 8 * fq;
#pragma unroll
        for (int ai = 0; ai < 2; ++ai)
#pragma unroll
            for (int m = 0; m < 4; ++m) { bf16_t* rowp = O + (size_t)(row0 + ai * HALF + m * 16) * ldo + col0;
                const f32x4 g0 = acc[ai][0][m][0], g1 = acc[ai][0][m][1], u0 = acc[ai][1][m][0], u1 = acc[ai][1][m][1];
                u32x4 w; w.x = cvt_pk_bf16(silu_f(g0[0]) * u0[0], silu_f(g0[1]) * u0[1]); w.y = cvt_pk_bf16(silu_f(g0[2]) * u0[2], silu_f(g0[3]) * u0[3]);
                w.z = cvt_pk_bf16(silu_f(g1[0]) * u1[0], silu_f(g1[1]) * u1[1]); w.w = cvt_pk_bf16(silu_f(g1[2]) * u1[2], silu_f(g1[3]) * u1[3]);
                *(u32x4*)rowp = w; }
    }
};
template <class Epi, class Sched, bool ALIGN_EPI = false, bool SP2 = false>
__device__ __forceinline__ void gemm_phase(PG8_LAS unsigned char* lds, const Gemm g, const Sched& S, const Epi& E) {
    int tid_ = threadIdx.x; asm volatile("" : "+v"(tid_)); const int tid = tid_, wid = __builtin_amdgcn_readfirstlane(tid >> 6), lane = tid & 63, wr = wid >> 2, wc = wid & 3, fr = lane & 15, fq = lane >> 4;
    const int K = g.K, nt = K / BK;
    unsigned voffA[2], voffB[2];
#pragma unroll
    for (int i = 0; i < 2; ++i) { int R, C; stage_rc(tid * 16 + i * 8192, R, C); const int Rb = Epi::PERM ? ((R & ~31) + perm32(R & 31)) : R;
        voffA[i] = (unsigned)(R * K + C) * 2u; voffB[i] = (unsigned)(Rb * K + C) * 2u; }
    const size_t kstep = (size_t)(BK * 2);
    const size_t hstep = (size_t)HALF * K * 2;
    const size_t tstep = 2 * hstep;
    const unsigned ldsw = (unsigned)wid * 1024u;
    const int aoff = lds_byte(wr * 64 + fr, fq * 8), boff = lds_byte(wc * 32 + fr, fq * 8);
#define PG8_SA(b, h) (((b) * 2 + (h)) * HTB)
#define PG8_SB(b, h) ((4 + (b) * 2 + (h)) * HTB)
#define PG8_STAGE(bufoff, gbase, voff) do { _Pragma("unroll") for (int _i = 0; _i < 2; ++_i) \
        __builtin_amdgcn_global_load_lds((const unsigned*)((const char*)(gbase) + (voff)[_i]), (PG8_LAS unsigned*)(lds + (bufoff) + ldsw + _i * 8192), 16, 0, 0); } while (0)
#define PG8_LDA(dst, b, h) do { _Pragma("unroll") for (int m = 0; m < 4; ++m) _Pragma("unroll") for (int k = 0; k < 2; ++k) dst[m][k] = *(const PG8_LAS bf16x8*)(lds + PG8_SA(b, h) + aoff + m * 2048 + k * 1024); } while (0)
#define PG8_LDB(dst, b, h) do { _Pragma("unroll") for (int n = 0; n < 2; ++n) _Pragma("unroll") for (int k = 0; k < 2; ++k) dst[n][k] = *(const PG8_LAS bf16x8*)(lds + PG8_SB(b, h) + boff + n * 2048 + k * 1024); } while (0)
#define PG8_MMA(ai, bj, At, Bt) do { __builtin_amdgcn_s_setprio(1); _Pragma("unroll") for (int m = 0; m < 4; ++m) _Pragma("unroll") for (int n = 0; n < 2; ++n) _Pragma("unroll") for (int k = 0; k < 2; ++k) \
        acc[ai][bj][m][n] = __builtin_amdgcn_mfma_f32_16x16x32_bf16(Bt[n][k], At[m][k], acc[ai][bj][m][n], 0, 0, 0); __builtin_amdgcn_s_setprio(0); } while (0)
#define PG8_WAIT_V(n) asm volatile("s_waitcnt vmcnt(" #n ")" ::: "memory")
#define PG8_WAIT_L(n) asm volatile("s_waitcnt lgkmcnt(" #n ")" ::: "memory")
#define PG8_BAR __builtin_amdgcn_s_barrier()
#define PG8_SCHED __builtin_amdgcn_sched_barrier(0)
    Unit cur, nxt; int ui = 0;
    if (!S.next(0, cur)) return;
    f32x4 acc[2][2][4][2];
#pragma unroll
    for (int a = 0; a < 2; ++a)
#pragma unroll
        for (int b = 0; b < 2; ++b)
#pragma unroll
            for (int m = 0; m < 4; ++m)
#pragma unroll
                for (int n = 0; n < 2; ++n) acc[a][b][m][n] = (f32x4){0.f, 0.f, 0.f, 0.f};
    bf16x8 At[4][2], B0[2][2], B1[2][2];
    const char* cA = (const char*)g.A + (size_t)cur.pm * tstep; const char* cB = (const char*)g.Bt + (size_t)cur.pn * tstep;
    S.a_ready(cur);
    if constexpr (SP2) {
        PG8_STAGE(PG8_SB(0, 0), cB, voffB); PG8_STAGE(PG8_SB(0, 1), cB + hstep, voffB); PG8_STAGE(PG8_SA(0, 0), cA, voffA); PG8_STAGE(PG8_SA(0, 1), cA + hstep, voffA);
        if (wr == 1) PG8_BAR;
        PG8_WAIT_V(2); PG8_BAR;
        PG8_STAGE(PG8_SB(1, 0), cB + kstep, voffB); PG8_STAGE(PG8_SA(1, 0), cA + kstep, voffA); PG8_STAGE(PG8_SB(1, 1), cB + hstep + kstep, voffB);
        PG8_WAIT_V(6); PG8_BAR;
    } else {
        PG8_STAGE(PG8_SB(0, 0), cB, voffB); PG8_STAGE(PG8_SA(0, 0), cA, voffA); PG8_STAGE(PG8_SB(0, 1), cB + hstep, voffB); PG8_STAGE(PG8_SA(0, 1), cA + hstep, voffA);
        if (wr == 1) PG8_BAR;
        PG8_WAIT_V(4); PG8_BAR;
        PG8_STAGE(PG8_SB(1, 0), cB + kstep, voffB); PG8_STAGE(PG8_SA(1, 0), cA + kstep, voffA); PG8_STAGE(PG8_SB(1, 1), cB + hstep + kstep, voffB);
        PG8_WAIT_V(6); PG8_BAR;
    }
    for (;;) {
        const bool has_next = S.next(ui + 1, nxt);
        const char* nA = has_next ? (const char*)g.A + (size_t)nxt.pm * tstep : cA; const char* nB = has_next ? (const char*)g.Bt + (size_t)nxt.pn * tstep : cB;
        for (int t = 0; t < nt; t += 2) {
            const bool last = (t == nt - 2);
            const char* a1 = cA + (size_t)(t + 1) * kstep;
            const char* a2 = last ? nA : cA + (size_t)(t + 2) * kstep; const char* b2 = last ? nB : cB + (size_t)(t + 2) * kstep;
            const char* a3 = a2 + kstep; const char* b3 = b2 + kstep;
            if (last && has_next) S.a_ready(nxt);
            if constexpr (SP2) {
            PG8_LDB(B0, 0, 0); PG8_LDB(B1, 0, 1); PG8_SCHED; PG8_LDA(At, 0, 0); PG8_STAGE(PG8_SA(1, 1), a1 + hstep, voffA);
            PG8_WAIT_V(8); PG8_WAIT_L(0); PG8_BAR; PG8_MMA(0, 0, At, B0); PG8_MMA(0, 1, At, B1); PG8_BAR; PG8_SCHED;
            PG8_LDA(At, 0, 1); PG8_STAGE(PG8_SB(0, 0), b2, voffB); PG8_STAGE(PG8_SB(0, 1), b2 + hstep, voffB); PG8_STAGE(PG8_SA(0, 0), a2, voffA);
            PG8_WAIT_V(8); PG8_WAIT_L(0); PG8_BAR; PG8_MMA(1, 0, At, B0); PG8_MMA(1, 1, At, B1); PG8_BAR; PG8_SCHED;
            PG8_LDB(B0, 1, 0); PG8_LDB(B1, 1, 1); PG8_SCHED; PG8_LDA(At, 1, 0); PG8_STAGE(PG8_SA(0, 1), a2 + hstep, voffA);
            PG8_WAIT_V(8); PG8_WAIT_L(0); PG8_BAR; PG8_MMA(0, 0, At, B0); PG8_MMA(0, 1, At, B1); PG8_BAR; PG8_SCHED;
            PG8_LDA(At, 1, 1); PG8_STAGE(PG8_SB(1, 0), b3, voffB); PG8_STAGE(PG8_SB(1, 1), b3 + hstep, voffB); PG8_STAGE(PG8_SA(1, 0), a3, voffA);
            PG8_WAIT_V(8); PG8_WAIT_L(0); PG8_BAR; PG8_MMA(1, 0, At, B0); PG8_MMA(1, 1, At, B1); PG8_BAR; PG8_SCHED;
            } else {
            PG8_LDB(B0, 0, 0); PG8_SCHED; PG8_LDA(At, 0, 0); PG8_STAGE(PG8_SA(1, 1), a1 + hstep, voffA);
            PG8_WAIT_L(8); PG8_BAR; PG8_WAIT_L(0); PG8_MMA(0, 0, At, B0); PG8_BAR; PG8_SCHED;
            PG8_LDB(B1, 0, 1); PG8_STAGE(PG8_SB(0, 0), b2, voffB);
            PG8_BAR; PG8_WAIT_L(0); PG8_MMA(0, 1, At, B1); PG8_BAR;
            PG8_LDA(At, 0, 1); PG8_STAGE(PG8_SA(0, 0), a2, voffA);
            PG8_BAR; PG8_WAIT_L(0); PG8_MMA(1, 0, At, B0); PG8_BAR; PG8_SCHED;
            PG8_STAGE(PG8_SB(0, 1), b2 + hstep, voffB);
            PG8_WAIT_V(6); PG8_BAR; PG8_MMA(1, 1, At, B1); PG8_BAR;
            PG8_LDB(B0, 1, 0); PG8_SCHED; PG8_LDA(At, 1, 0); PG8_STAGE(PG8_SA(0, 1), a2 + hstep, voffA);
            PG8_WAIT_L(8); PG8_BAR; PG8_WAIT_L(0); PG8_MMA(0, 0, At, B0); PG8_BAR; PG8_SCHED;
            PG8_LDB(B1, 1, 1); PG8_STAGE(PG8_SB(1, 0), b3, voffB);
            PG8_BAR; PG8_WAIT_L(0); PG8_MMA(0, 1, At, B1); PG8_BAR;
            PG8_LDA(At, 1, 1); PG8_STAGE(PG8_SA(1, 0), a3, voffA);
            PG8_BAR; PG8_WAIT_L(0); PG8_MMA(1, 0, At, B0); PG8_BAR; PG8_SCHED;
            PG8_STAGE(PG8_SB(1, 1), b3 + hstep, voffB);
            PG8_WAIT_V(6); PG8_BAR; PG8_MMA(1, 1, At, B1); PG8_BAR;
            }
        }
        if constexpr (ALIGN_EPI) { if (wr == 0) PG8_BAR; }
        if constexpr (!Epi::AFTER_DRAIN) { E(acc, cur, wr, wc, fr, fq); S.done(cur); }
        if (!has_next) break;
#pragma unroll
        for (int a = 0; a < 2; ++a)
#pragma unroll
            for (int b = 0; b < 2; ++b)
#pragma unroll
                for (int m = 0; m < 4; ++m)
#pragma unroll
                    for (int n = 0; n < 2; ++n) acc[a][b][m][n] = (f32x4){0.f, 0.f, 0.f, 0.f};
        cur = nxt; cA = nA; cB = nB; ++ui;
        if constexpr (ALIGN_EPI) { if (wr == 1) PG8_BAR; }
    }
    PG8_WAIT_V(0);
    if constexpr (!ALIGN_EPI) { if (wr == 0) PG8_BAR; }
    PG8_BAR;
    if constexpr (Epi::AFTER_DRAIN) { E.fused(acc, cur, wr, wc, fr, fq, lds, wid, lane); S.done(cur); }
#undef PG8_SA
#undef PG8_SB
#undef PG8_STAGE
#undef PG8_LDA
#undef PG8_LDB
#undef PG8_MMA
#undef PG8_WAIT_V
#undef PG8_WAIT_L
#undef PG8_BAR
#undef PG8_SCHED
}
}
#define DI __device__ __forceinline__
#define LAS __attribute__((address_space(3)))
typedef unsigned short bf16;
typedef short bf16x8 __attribute__((ext_vector_type(8)));
typedef short s16x4 __attribute__((ext_vector_type(4)));
typedef short v4i16_t __attribute__((ext_vector_type(4)));
typedef float f32x4 __attribute__((ext_vector_type(4)));
typedef float f32x2 __attribute__((ext_vector_type(2)));
typedef unsigned u32x4 __attribute__((ext_vector_type(4)));
typedef unsigned u32x2 __attribute__((ext_vector_type(2)));
typedef __bf16 bf16x2_t __attribute__((ext_vector_type(2)));

constexpr int NB = 8, SEQ = 2048, DM = 2048, M = NB * SEQ, DEPTH = 2, HD = 128, NH = 6;
constexpr int NPROJ = 6400, IN_TOTAL = 6412, FF = 5632;
constexpr int C_AU = 0, C_AV = 512, C_BQ = 1024, C_BK = 1792, C_BV = 2560, C_BG = 3328, C_CQ = 4096, C_CK = 4864, C_CV = 5632;
constexpr float EPS = 1e-6f, LOG2E = 1.4426950408889634f, LN2 = 0.6931471805599453f;
enum { I_X = 0, I_N1G, I_WIN, I_SGUG, I_WS, I_BS, I_CONVW, I_ALOG, I_DTB, I_ONG, I_QNG, I_KNG, I_WOUT, I_N2G, I_WGU, I_WDN };

constexpr size_t SZ_WIN = (size_t)NPROJ * DM * 2, SZ_WOUT = (size_t)DM * DM * 2, SZ_WGU = (size_t)2 * FF * DM * 2, SZ_WDN = (size_t)DM * FF * 2;
constexpr size_t SZ_WL = SZ_WIN + SZ_WOUT + SZ_WGU + SZ_WDN;
constexpr size_t WS_W = 0;
constexpr size_t WS_H = WS_W + DEPTH * SZ_WL;
constexpr size_t WS_PROJ = WS_H + (size_t)M * DM * 2;
constexpr size_t WS_BD = WS_PROJ + (size_t)M * NPROJ * 2;
constexpr size_t WS_DN = WS_BD + (size_t)M * 12 * 4;
constexpr int NCHUNK = NB * NH * 32;
constexpr size_t DN_WK = 0, DN_QG = 16384, DN_KDT = 32768, DN_UT = 49152, DN_ATT = 65536, DN_STRIDE = 73728;
constexpr size_t WS_GL = WS_DN + (size_t)NCHUNK * DN_STRIDE;
constexpr size_t WS_ODN = WS_GL + 8192;
constexpr size_t WS_OBR = WS_ODN + (size_t)M * 768 * 4;
constexpr size_t WS_LSE = WS_OBR + (size_t)3 * M * 768 * 2;
constexpr size_t WS_CTL = WS_LSE + (size_t)3 * M * 6 * 4;
constexpr size_t CTL_BYTES = 16384;
constexpr size_t WS_END = WS_CTL + CTL_BYTES;
constexpr int LDS_BYTES = 143360;
constexpr int NTHR = 512;
constexpr int NSCAN = 96;

DI unsigned pk2(float lo, float hi) { f32x2 v = {lo, hi}; bf16x2_t b = __builtin_convertvector(v, bf16x2_t); return __builtin_bit_cast(unsigned, b); }
DI float bflo(unsigned w) { return __uint_as_float(w << 16); }
DI float bfhi(unsigned w) { return __uint_as_float(w & 0xffff0000u); }
DI f32x4 mfma16(bf16x8 a, bf16x8 b, f32x4 c) { return __builtin_amdgcn_mfma_f32_16x16x32_bf16(a, b, c, 0, 0, 0); }
DI s16x4 tr4(const LAS unsigned char* p) { return __builtin_bit_cast(s16x4, __builtin_amdgcn_ds_read_tr16_b64_v4i16((LAS v4i16_t*)p)); }
DI bf16x8 tr_frag(const LAS unsigned char* p0, const LAS unsigned char* p1) { const s16x4 lo = tr4(p0), hi = tr4(p1); return __builtin_shufflevector(lo, hi, 0, 1, 2, 3, 4, 5, 6, 7); }
DI bf16x8 ld_frag(const LAS unsigned char* p) { return *(const LAS bf16x8*)p; }
DI void lds_barrier() { asm volatile("s_waitcnt lgkmcnt(0)" ::: "memory"); __builtin_amdgcn_s_barrier(); asm volatile("" ::: "memory"); }
DI int opaque(int x) { asm volatile("" : "+v"(x)); return x; }
DI float wave_sum(float v) {
#pragma unroll
    for (int o = 1; o < 64; o <<= 1) v += __shfl_xor(v, o);
    return v;
}
DI float sigmoid_f(float x) { return __builtin_amdgcn_rcpf(1.0f + __expf(-x)); }
DI float silu_f(float x) { return x * sigmoid_f(x); }
DI float gelu_tanh(float x) { const float u = 0.7978845608028654f * (x + 0.044715f * x * x * x); return x * sigmoid_f(2.0f * u); }
DI void unpack8(const u32x4 w, float* f) { f[0] = bflo(w.x); f[1] = bfhi(w.x); f[2] = bflo(w.y); f[3] = bfhi(w.y); f[4] = bflo(w.z); f[5] = bfhi(w.z); f[6] = bflo(w.w); f[7] = bfhi(w.w); }
DI u32x4 pack8(const float* f) { u32x4 w; w.x = pk2(f[0], f[1]); w.y = pk2(f[2], f[3]); w.z = pk2(f[4], f[5]); w.w = pk2(f[6], f[7]); return w; }
DI u32x2 pack4(const f32x4 v) { u32x2 w; w.x = pk2(v[0], v[1]); w.y = pk2(v[2], v[3]); return w; }

DI void transpose_item(const float* W, int K, int Nsrc, int src_col0, bf16* WT, int dst_row0, int k0, LAS float* scr, int lane) {
#pragma unroll 8
    for (int i = 0; i < 32; ++i) { const int kk = 2 * i + (lane >> 5); scr[kk * 33 + (lane & 31)] = W[(size_t)(k0 + kk) * Nsrc + src_col0 + (lane & 31)]; }
    asm volatile("s_waitcnt lgkmcnt(0)" ::: "memory");
    const int c = lane & 7;
#pragma unroll
    for (int j = 0; j < 4; ++j) { const int n = (lane >> 3) + 8 * j; const LAS float* s = scr + (8 * c) * 33 + n;
        u32x4 o; o.x = pk2(s[0 * 33], s[1 * 33]); o.y = pk2(s[2 * 33], s[3 * 33]); o.z = pk2(s[4 * 33], s[5 * 33]); o.w = pk2(s[6 * 33], s[7 * 33]);
        *(u32x4*)(WT + (size_t)(dst_row0 + n) * K + k0 + 8 * c) = o; }
    asm volatile("s_waitcnt lgkmcnt(0)" ::: "memory");
}
DI void weight_prep(const float* const* in, unsigned char* ws, LAS unsigned char* lds, int gw, int ngw, int wave, int lane) {
    LAS float* scr = (LAS float*)(lds + wave * 16384);
    constexpr int I_IN = (DM / 64) * (NPROJ / 32), I_OUT = (DM / 64) * (DM / 32), I_GU = (DM / 64) * (2 * FF / 32), I_DN = (FF / 64) * (DM / 32);
    constexpr int PER_L = I_IN + I_OUT + I_GU + I_DN;
    for (int it = gw; it < DEPTH * PER_L; it += ngw) {
        const int l = it / PER_L; int r = it % PER_L;
        unsigned char* wl = ws + WS_W + (size_t)l * SZ_WL;
        if (r < I_IN) { const int nblk = NPROJ / 32, kb = r / nblk, nb = r % nblk, n0 = nb * 32;
            transpose_item(in[I_WIN] + (size_t)l * DM * IN_TOTAL, DM, IN_TOTAL, n0 < 4096 ? n0 : n0 + 12, (bf16*)wl, n0, kb * 64, scr, lane); continue; }
        r -= I_IN;
        if (r < I_OUT) { const int nblk = DM / 32, kb = r / nblk, nb = r % nblk, n0 = nb * 32;
            transpose_item(in[I_WOUT] + (size_t)l * DM * DM, DM, DM, n0, (bf16*)(wl + SZ_WIN), n0, kb * 64, scr, lane); continue; }
        r -= I_OUT;
        if (r < I_GU) { const int nblk = 2 * FF / 32, kb = r / nblk, nb = r % nblk, n0 = nb * 32, pn = n0 >> 8, j = n0 & 255;
            transpose_item(in[I_WGU] + (size_t)l * DM * 2 * FF, DM, 2 * FF, j < 128 ? 128 * pn + j : FF + 128 * pn + (j - 128), (bf16*)(wl + SZ_WIN + SZ_WOUT), n0, kb * 64, scr, lane); continue; }
        r -= I_GU;
        { const int nblk = DM / 32, kb = r / nblk, nb = r % nblk, n0 = nb * 32;
            transpose_item(in[I_WDN] + (size_t)l * FF * DM, FF, DM, n0, (bf16*)(wl + SZ_WIN + SZ_WOUT + SZ_WGU), n0, kb * 64, scr, lane); }
    }
}

DI void norm_phase(const float* x, const float* g, bf16* h, const float* w_in_l, float* bd, LAS unsigned char* lds, int gw, int ngw, int tid0, int lane0) {
    const int tid = opaque(tid0), lane = tid & 63; (void)lane0;
    LAS f32x4* wl = (LAS f32x4*)lds;
    if (w_in_l) {
        for (int k = tid; k < DM; k += NTHR) {
            const f32x4* src = (const f32x4*)(w_in_l + (size_t)k * IN_TOTAL + 4096);
            const f32x4 a = src[0], b = src[1], c = src[2];
            const int j = k >> 8, l = (k >> 2) & 63, e = k & 3;
            LAS float* dst = (LAS float*)lds + ((size_t)(j * 12) * 64 + l) * 4 + e;
            dst[0 * 256] = a[0]; dst[1 * 256] = a[1]; dst[2 * 256] = a[2]; dst[3 * 256] = a[3];
            dst[4 * 256] = b[0]; dst[5 * 256] = b[1]; dst[6 * 256] = b[2]; dst[7 * 256] = b[3];
            dst[8 * 256] = c[0]; dst[9 * 256] = c[1]; dst[10 * 256] = c[2]; dst[11 * 256] = c[3];
        }
        __syncthreads();
    }
    f32x4 gv[8];
#pragma unroll
    for (int j = 0; j < 8; ++j) gv[j] = ((const f32x4*)g)[64 * j + lane];
    for (int row = gw; row < M; row += ngw) {
        const f32x4* xr = (const f32x4*)(x + (size_t)row * DM) + lane;
        f32x4 v[8]; float s = 0.f;
#pragma unroll
        for (int j = 0; j < 8; ++j) { v[j] = xr[64 * j]; s += (v[j][0] * v[j][0] + v[j][1] * v[j][1]) + (v[j][2] * v[j][2] + v[j][3] * v[j][3]); }
        const float rs = 1.0f / sqrtf(wave_sum(s) * (1.0f / DM) + EPS);
        u32x2* o8 = (u32x2*)(h + (size_t)row * DM) + lane;
#pragma unroll
        for (int j = 0; j < 8; ++j) { v[j] = v[j] * rs * gv[j]; u32x2 w; w.x = pk2(v[j][0], v[j][1]); w.y = pk2(v[j][2], v[j][3]); o8[64 * j] = w; }
        if (w_in_l) {
            float outv = 0.f;
            asm volatile("" ::: "memory");
#pragma unroll 1
            for (int c = 0; c < 12; ++c) {
                float acc = 0.f;
#pragma unroll
                for (int j = 0; j < 8; ++j) { const f32x4 w = wl[(j * 12 + c) * 64 + lane]; acc += (v[j][0] * w[0] + v[j][1] * w[1]) + (v[j][2] * w[2] + v[j][3] * w[3]); }
                acc = wave_sum(acc);
                if (lane == c) outv = acc;
            }
            if (lane < 12) bd[(size_t)row * 12 + lane] = outv;
        }
    }
    if (w_in_l) __syncthreads();
}
#define XB_TMO      128
#define XB_XCNT(j)  (256  + 64 * (j))
#define XB_XSUB(j)  (1280 + 64 * (j))
#define XB_XGEN(j)  (2304 + 64 * (j))
#define XB_TOP      3328
#define XB_TOPGEN   3392
#define XCD_BAR_WORDS 3456
#define XB_SPIN_CAP (1u << 18)

__device__ __forceinline__ unsigned xb_ld(unsigned* p)              { return __hip_atomic_load(p, __ATOMIC_RELAXED, __HIP_MEMORY_SCOPE_AGENT); }
__device__ __forceinline__ unsigned xb_add(unsigned* p, unsigned v) { return __hip_atomic_fetch_add(p, v, __ATOMIC_RELAXED, __HIP_MEMORY_SCOPE_AGENT); }
__device__ __forceinline__ unsigned xb_xcc_id() { return (unsigned)__builtin_amdgcn_s_getreg((3 << 11) | 20) & 0xFu; }
#define XB_SPIN(cond, bar) do { unsigned _sp = 0; while (cond) { __builtin_amdgcn_s_sleep(1); \
    if ((++_sp & 255u) == 0u) { if (xb_ld(&(bar)[XB_TMO])) break; if (_sp > XB_SPIN_CAP) { atomicAdd(&(bar)[XB_TMO], 1u); break; } } } } while (0)

struct XcdBarrier {
    unsigned* bar; unsigned x;
    volatile LAS unsigned* st;
};

__device__ __forceinline__ XcdBarrier xcd_barrier_post(unsigned* bar, volatile LAS unsigned* st) {
    XcdBarrier b; b.bar = bar; b.x = xb_xcc_id(); b.st = st;
    if (threadIdx.x == 0) (void)xb_add(&bar[XB_XCNT(b.x)], 1u);
    return b;
}
__device__ __forceinline__ void xcd_barrier_complete(unsigned* bar, unsigned x, unsigned& nloc, unsigned& nx) {
    const unsigned G = gridDim.x * gridDim.y * gridDim.z;
    unsigned sum, cnt, mine, sp = 0u;
    for (;;) {
        sum = 0u; cnt = 0u; mine = 0u;
#pragma unroll
        for (unsigned j = 0; j < 16; ++j) { const unsigned c = xb_ld(&bar[XB_XCNT(j)]); sum += c; cnt += (c > 0u) ? 1u : 0u; mine = (j == x) ? c : mine; }
        if (sum == G) break;
        __builtin_amdgcn_s_sleep(1);
        if ((++sp & 255u) == 0u) { if (xb_ld(&bar[XB_TMO])) break; if (sp > XB_SPIN_CAP) { atomicAdd(&bar[XB_TMO], 1u); break; } }
    }
    nloc = mine > 0u ? mine : 1u; nx = cnt > 0u ? cnt : 1u;
}

__device__ __forceinline__ void xcd_barrier(const XcdBarrier& b) {
    asm volatile("s_waitcnt vmcnt(0)" ::: "memory");
    __syncthreads();
    if (threadIdx.x == 0) {
        unsigned* bar = b.bar;
        __builtin_amdgcn_s_waitcnt(0);
        unsigned nloc = b.st[0], nx = b.st[1];
        if (nloc == 0u) { xcd_barrier_complete(bar, b.x, nloc, nx); b.st[0] = nloc; b.st[1] = nx; }
        const unsigned old = xb_add(&bar[XB_XSUB(b.x)], 1u);
        const unsigned gen = old / nloc;
        if (old + 1u == (gen + 1u) * nloc) {
            __builtin_amdgcn_fence(__ATOMIC_RELEASE, "agent");
            asm volatile("s_waitcnt vmcnt(0)" ::: "memory");
            const unsigned og = xb_add(&bar[XB_TOP], 1u);
            const unsigned tg = og / nx;
            if (og + 1u == (tg + 1u) * nx) xb_add(&bar[XB_TOPGEN], 1u);
            else XB_SPIN(xb_ld(&bar[XB_TOPGEN]) == tg, bar);
            __builtin_amdgcn_fence(__ATOMIC_ACQUIRE, "agent");
            xb_add(&bar[XB_XGEN(b.x)], 1u);
            asm volatile("s_waitcnt vmcnt(0)" ::: "memory");
        } else {
            XB_SPIN(xb_ld(&bar[XB_XGEN(b.x)]) == gen, bar);
            __builtin_amdgcn_fence(__ATOMIC_ACQUIRE, "agent");
            asm volatile("s_waitcnt vmcnt(0)" ::: "memory");
        }
    }
    __syncthreads();
}
DI void sgu_item(int item, const bf16* proj, const float* sgu_g, const float* w_s, const float* b_s, bf16* mix, LAS unsigned char* lds, int tid0) {
    const int tid = opaque(tid0);
    const int g = item & 3, c = (item >> 2) & 15, b = item >> 6;
    const size_t row0 = (size_t)b * SEQ + c * 128;
    LAS unsigned char* Vimg = lds; LAS unsigned char* Wimg = lds + 128 * 272;
    {
        const int i = tid >> 2, p = tid & 3;
        const bf16* src = proj + (row0 + i) * NPROJ + C_AV + g * 128 + p * 32;
        float y[32]; float ss = 0.f;
#pragma unroll
        for (int e = 0; e < 4; ++e) { const u32x4 raw = *(const u32x4*)(src + 8 * e); unpack8(raw, y + 8 * e); }
#pragma unroll
        for (int e = 0; e < 32; ++e) { y[e] = gelu_tanh(y[e]); ss += y[e] * y[e]; }
        ss += __shfl_xor(ss, 1); ss += __shfl_xor(ss, 2);
        const float rs = 1.0f / sqrtf(ss * (1.0f / 128.0f) + EPS);
        const float* gg = sgu_g + g * 128 + p * 32;
#pragma unroll
        for (int e = 0; e < 4; ++e) { float t[8];
#pragma unroll
            for (int k = 0; k < 8; ++k) t[k] = y[8 * e + k] * rs * gg[8 * e + k];
            *(LAS u32x4*)(Vimg + i * 272 + p * 64 + e * 16) = pack8(t); }
        const float* wsrc = w_s + ((size_t)g * 128 + i) * 128 + p * 32;
#pragma unroll
        for (int e = 0; e < 4; ++e) { const f32x4 a = *(const f32x4*)(wsrc + 8 * e), bb = *(const f32x4*)(wsrc + 8 * e + 4); float t[8];
#pragma unroll
            for (int k = 0; k < 4; ++k) { t[k] = (p * 32 + 8 * e + k <= i) ? a[k] : 0.f; t[4 + k] = (p * 32 + 8 * e + 4 + k <= i) ? bb[k] : 0.f; }
            *(LAS u32x4*)(Wimg + i * 272 + p * 64 + e * 16) = pack8(t); }
    }
    __syncthreads();
    const int w = tid >> 6, lane = tid & 63, r = lane & 15, q = lane >> 4;
    f32x4 acc[8];
#pragma unroll
    for (int dt = 0; dt < 8; ++dt) acc[dt] = (f32x4){0.f, 0.f, 0.f, 0.f};
    const int nks = (16 * (w + 1) + 31) >> 5;
    for (int ks = 0; ks < nks; ++ks) {
        const bf16x8 bfr = ld_frag(Wimg + (16 * w + r) * 272 + (32 * ks + 8 * q) * 2);
#pragma unroll
        for (int dt = 0; dt < 8; ++dt) { const LAS unsigned char* p0 = Vimg + (32 * ks + 8 * q + (r >> 2)) * 272 + (16 * dt + 4 * (r & 3)) * 2;
            acc[dt] = mfma16(tr_frag(p0, p0 + 4 * 272), bfr, acc[dt]); }
    }
    const int i = 16 * w + r; const float bsv = b_s[g * 128 + i];
    const bf16* up = proj + (row0 + i) * NPROJ + C_AU + g * 128 + 4 * q;
    bf16* op = mix + (row0 + i) * DM + g * 128 + 4 * q;
#pragma unroll
    for (int dt = 0; dt < 8; ++dt) { const u32x2 uu = *(const u32x2*)(up + 16 * dt);
        f32x4 o; o[0] = gelu_tanh(bflo(uu.x)) * (acc[dt][0] + bsv); o[1] = gelu_tanh(bfhi(uu.x)) * (acc[dt][1] + bsv); o[2] = gelu_tanh(bflo(uu.y)) * (acc[dt][2] + bsv); o[3] = gelu_tanh(bfhi(uu.y)) * (acc[dt][3] + bsv);
        *(u32x2*)(op + 16 * dt) = pack4(o); }
    __syncthreads();
}

DI void attn_item(int item, const bf16* proj, const float* qg, const float* kg, bf16* obr, float* lse, LAS unsigned char* lds, int tid0) {
    const int tid = opaque(tid0);
    const int sub = item % 48, bh = item / 48, h = bh % NH, b = bh / NH;
    int br, rr, n;
    if (sub < 16) { br = 0; rr = 0; n = sub; } else if (sub < 32) { br = 1; rr = (sub - 16) >> 2; n = (sub - 16) & 3; } else { br = 2; rr = sub - 32; n = 0; }
    const int dil = 1 << (2 * br);
    LAS unsigned char* Kimg = lds; LAS unsigned char* Vimg = lds + 256 * 272;
    const bf16* base = proj + (size_t)b * SEQ * NPROJ + h * 128;
    {
        const int piece = tid & 15;
        float kgv[8];
#pragma unroll
        for (int e = 0; e < 8; ++e) kgv[e] = kg[piece * 8 + e];
#pragma unroll 2
        for (int i = 0; i < 8; ++i) {
            const int row = (tid >> 4) + 32 * i, L = (n - 1) * 128 + row;
            u32x4 kv = {0u, 0u, 0u, 0u}, vv = {0u, 0u, 0u, 0u};
            if (L >= 0) { const bf16* p = base + (size_t)(L * dil + rr) * NPROJ + piece * 8; kv = *(const u32x4*)(p + C_CK); vv = *(const u32x4*)(p + C_CV); }
            float kf[8]; unpack8(kv, kf); float ss = 0.f;
#pragma unroll
            for (int e = 0; e < 8; ++e) ss += kf[e] * kf[e];
            ss += __shfl_xor(ss, 1); ss += __shfl_xor(ss, 2); ss += __shfl_xor(ss, 4); ss += __shfl_xor(ss, 8);
            const float rs = 1.0f / sqrtf(ss * (1.0f / 128.0f) + EPS);
#pragma unroll
            for (int e = 0; e < 8; ++e) kf[e] = kf[e] * rs * kgv[e];
            *(LAS u32x4*)(Kimg + row * 272 + piece * 16) = pack8(kf);
            *(LAS u32x4*)(Vimg + row * 272 + piece * 16) = vv;
        }
    }
    const int w = tid >> 6, lane = tid & 63, r = lane & 15, q = lane >> 4;
    const int qi = 16 * w + r, tokq = (n * 128 + qi) * dil + rr;
    bf16x8 qf[4];
    {
        const bf16* qp = base + (size_t)tokq * NPROJ + C_CQ + 8 * q;
        float qv[32]; float ss = 0.f;
#pragma unroll
        for (int s = 0; s < 4; ++s) { const u32x4 raw = *(const u32x4*)(qp + 32 * s); unpack8(raw, qv + 8 * s); }
#pragma unroll
        for (int e = 0; e < 32; ++e) ss += qv[e] * qv[e];
        ss += __shfl_xor(ss, 16); ss += __shfl_xor(ss, 32);
        const float rs = (1.0f / sqrtf(ss * (1.0f / 128.0f) + EPS)) * (0.08838834764831845f * LOG2E);
#pragma unroll
        for (int s = 0; s < 4; ++s) { float t[8];
#pragma unroll
            for (int e = 0; e < 8; ++e) t[e] = qv[8 * s + e] * rs * qg[32 * s + 8 * q + e];
            qf[s] = __builtin_bit_cast(bf16x8, pack8(t)); }
    }
    __syncthreads();
    const int kt0 = 2 * (w >> 1);
    f32x4 sc[10];
#pragma unroll
    for (int t = 0; t < 10; ++t) { f32x4 a4 = {0.f, 0.f, 0.f, 0.f};
#pragma unroll
        for (int s = 0; s < 4; ++s) a4 = mfma16(ld_frag(Kimg + (16 * (kt0 + t) + r) * 272 + (32 * s + 8 * q) * 2), qf[s], a4);
        sc[t] = a4; }
    const float sl2 = exp2f(-8.0f * (float)(h + 1) / 6.0f) * (float)dil * LOG2E;
    float mx = -INFINITY;
#pragma unroll
    for (int t = 0; t < 10; ++t)
#pragma unroll
        for (int jj = 0; jj < 4; ++jj) { const int kj = 16 * (kt0 + t) + 4 * q + jj, delta = 128 + qi - kj;
            const bool valid = (delta >= 0) && (delta <= 128) && (n > 0 || kj >= 128);
            const float v = valid ? sc[t][jj] - sl2 * (float)delta : -INFINITY; sc[t][jj] = v; mx = fmaxf(mx, v); }
    mx = fmaxf(mx, __shfl_xor(mx, 16)); mx = fmaxf(mx, __shfl_xor(mx, 32));
    float l = 0.f;
#pragma unroll
    for (int t = 0; t < 10; ++t)
#pragma unroll
        for (int jj = 0; jj < 4; ++jj) { const float p = __builtin_amdgcn_exp2f(sc[t][jj] - mx); sc[t][jj] = p; l += p; }
    l += __shfl_xor(l, 16); l += __shfl_xor(l, 32);
    bf16x8 pf[5];
#pragma unroll
    for (int pp = 0; pp < 5; ++pp) { u32x4 wv; wv.x = pk2(sc[2 * pp][0], sc[2 * pp][1]); wv.y = pk2(sc[2 * pp][2], sc[2 * pp][3]); wv.z = pk2(sc[2 * pp + 1][0], sc[2 * pp + 1][1]); wv.w = pk2(sc[2 * pp + 1][2], sc[2 * pp + 1][3]);
        pf[pp] = __builtin_bit_cast(bf16x8, wv); }
    f32x4 o[8];
#pragma unroll
    for (int dt = 0; dt < 8; ++dt) o[dt] = (f32x4){0.f, 0.f, 0.f, 0.f};
#pragma unroll
    for (int pp = 0; pp < 5; ++pp)
#pragma unroll
        for (int dt = 0; dt < 8; ++dt) { const LAS unsigned char* p0 = Vimg + (16 * (kt0 + 2 * pp) + 4 * q + (r >> 2)) * 272 + (16 * dt + 4 * (r & 3)) * 2;
            o[dt] = mfma16(tr_frag(p0, p0 + 16 * 272), pf[pp], o[dt]); }
    const float inv = 1.0f / l;
    const size_t orow = (size_t)br * M + (size_t)b * SEQ + tokq;
    bf16* op = obr + orow * 768 + h * 128 + 4 * q;
#pragma unroll
    for (int dt = 0; dt < 8; ++dt) *(u32x2*)(op + 16 * dt) = pack4(o[dt] * inv);
    if (q == 0) lse[orow * 6 + h] = (mx + __builtin_amdgcn_logf(l)) * LN2;
    __syncthreads();
}
DI void attn_combine(const bf16* obr, const float* lse, bf16* mix, int gi0, int nthreads) {
    const int gi = opaque(gi0);
    constexpr int UN = 4;
    for (int idx0 = gi; idx0 < M * 96; idx0 += nthreads * UN) {
        float l[UN][3]; u32x4 raw[UN][3]; int row[UN], c8[UN];
#pragma unroll
        for (int u = 0; u < UN; ++u) { int idx = idx0 + u * nthreads; if (idx >= M * 96) idx = M * 96 - 1; row[u] = idx / 96; c8[u] = idx % 96; const int h = c8[u] >> 4;
#pragma unroll
            for (int br = 0; br < 3; ++br) { l[u][br] = lse[((size_t)br * M + row[u]) * 6 + h]; raw[u][br] = *(const u32x4*)(obr + ((size_t)br * M + row[u]) * 768 + c8[u] * 8); } }
#pragma unroll
        for (int u = 0; u < UN; ++u) {
            const float mx = fmaxf(l[u][0], fmaxf(l[u][1], l[u][2]));
            float w0 = __expf(l[u][0] - mx), w1 = __expf(l[u][1] - mx), w2 = __expf(l[u][2] - mx); const float inv = 1.0f / (w0 + w1 + w2); w0 *= inv; w1 *= inv; w2 *= inv;
            float a[8], bq[8], cc[8]; unpack8(raw[u][0], a); unpack8(raw[u][1], bq); unpack8(raw[u][2], cc);
#pragma unroll
            for (int e = 0; e < 8; ++e) a[e] = w0 * a[e] + w1 * bq[e] + w2 * cc[e];
            if (idx0 + u * nthreads < M * 96) *(u32x4*)(mix + (size_t)row[u] * DM + 1280 + c8[u] * 8) = pack8(a);
        }
    }
}
DI void dn_conv16(const bf16* proj, int b, int tpos, int col, const float* cw, float* y) {
    float acc[16];
#pragma unroll
    for (int e = 0; e < 16; ++e) acc[e] = 0.f;
#pragma unroll
    for (int j = 0; j < 4; ++j) { const int tt = tpos - 3 + j;
        u32x4 x0 = {0u, 0u, 0u, 0u}, x1 = {0u, 0u, 0u, 0u};
        if (tt >= 0) { const bf16* p = proj + ((size_t)b * SEQ + tt) * NPROJ + col; x0 = *(const u32x4*)p; x1 = *(const u32x4*)(p + 8); }
        float xf[16]; unpack8(x0, xf); unpack8(x1, xf + 8);
        const f32x4* wp = (const f32x4*)(cw + (size_t)j * 2304);
#pragma unroll
        for (int e4 = 0; e4 < 4; ++e4) { const f32x4 wv = wp[e4];
#pragma unroll
            for (int k = 0; k < 4; ++k) acc[4 * e4 + k] += wv[k] * xf[4 * e4 + k]; } }
#pragma unroll
    for (int e = 0; e < 16; ++e) y[e] = silu_f(acc[e]);
}
DI void dn_prep_item(int item, const bf16* proj, const float* bd, const float* conv_w, const float* a_log, const float* dt_bias, unsigned char* dnall, float* gl_out, LAS unsigned char* lds, int tid0) {
    const int tid = opaque(tid0);
    const int n = item & 31, bh = item >> 5, h = bh % NH, b = bh / NH, t0 = 64 * n;
    unsigned char* dn = dnall + (size_t)item * DN_STRIDE;
    LAS unsigned char* Kimg = lds; LAS unsigned char* Qimg = lds + 17408; LAS unsigned char* KBG = lds + 34816; LAS unsigned char* VB = lds + 52224;
    LAS unsigned char* Amat = lds + 69632; LAS unsigned char* Timg = lds + 87040; LAS float* G = (LAS float*)(lds + 96256); LAS float* BETA = (LAS float*)(lds + 96512);
    const int w = tid >> 6, lane = tid & 63, r = lane & 15, q = lane >> 4;
    if (w == 0) {
        const size_t row = (size_t)b * SEQ + t0 + lane;
        const float bl = bd[row * 12 + h], av = bd[row * 12 + 6 + h];
        const float xx = av + dt_bias[h];
        const float sp = xx > 20.f ? xx : log1pf(expf(xx));
        float gs = -expf(a_log[h]) * sp;
#pragma unroll
        for (int o = 1; o < 64; o <<= 1) { const float t = __shfl_up(gs, o); if (lane >= o) gs += t; }
        G[lane] = gs; BETA[lane] = 1.0f / (1.0f + expf(-bl));
    }
    __syncthreads();
    {
        const int i = tid >> 3, p = tid & 7;
        const float gi = G[i], bi = BETA[i], eg = expf(gi);
        float y[16];
        dn_conv16(proj, b, t0 + i, C_BQ + h * 128 + 16 * p, conv_w + h * 128 + 16 * p, y);
        { float ss = 0.f;
#pragma unroll
            for (int e = 0; e < 16; ++e) ss += y[e] * y[e];
            ss += __shfl_xor(ss, 1); ss += __shfl_xor(ss, 2); ss += __shfl_xor(ss, 4);
            const float rs = (1.0f / sqrtf(ss + EPS)) * 0.08838834764831845f;
            float t[16], tg[16];
#pragma unroll
            for (int e = 0; e < 16; ++e) { t[e] = y[e] * rs; tg[e] = t[e] * eg; }
            *(LAS u32x4*)(Qimg + i * 272 + p * 32) = pack8(t); *(LAS u32x4*)(Qimg + i * 272 + p * 32 + 16) = pack8(t + 8);
            *(u32x4*)(dn + DN_QG + (i * 128 + 16 * p) * 2) = pack8(tg); *(u32x4*)(dn + DN_QG + (i * 128 + 16 * p + 8) * 2) = pack8(tg + 8); }
        dn_conv16(proj, b, t0 + i, C_BK + h * 128 + 16 * p, conv_w + 768 + h * 128 + 16 * p, y);
        { float ss = 0.f;
#pragma unroll
            for (int e = 0; e < 16; ++e) ss += y[e] * y[e];
            ss += __shfl_xor(ss, 1); ss += __shfl_xor(ss, 2); ss += __shfl_xor(ss, 4);
            const float rs = 1.0f / sqrtf(ss + EPS);
            float t[16], tg[16];
#pragma unroll
            for (int e = 0; e < 16; ++e) { t[e] = y[e] * rs; tg[e] = t[e] * (bi * eg); }
            *(LAS u32x4*)(Kimg + i * 272 + p * 32) = pack8(t); *(LAS u32x4*)(Kimg + i * 272 + p * 32 + 16) = pack8(t + 8);
            *(LAS u32x4*)(KBG + i * 272 + p * 32) = pack8(tg); *(LAS u32x4*)(KBG + i * 272 + p * 32 + 16) = pack8(tg + 8); }
        dn_conv16(proj, b, t0 + i, C_BV + h * 128 + 16 * p, conv_w + 1536 + h * 128 + 16 * p, y);
        { float t[16];
#pragma unroll
            for (int e = 0; e < 16; ++e) t[e] = y[e] * bi;
            *(LAS u32x4*)(VB + i * 272 + p * 32) = pack8(t); *(LAS u32x4*)(VB + i * 272 + p * 32 + 16) = pack8(t + 8); }
    }
    __syncthreads();
    {
        const int it = w & 3;
        const int i = 16 * it + r; const float gi = G[i], bi = BETA[i];
#pragma unroll
        for (int e = 0; e < 2; ++e) { const int jt = 2 * (w >> 2) + e;
            f32x4 kk = {0.f, 0.f, 0.f, 0.f}, qk = {0.f, 0.f, 0.f, 0.f};
#pragma unroll
            for (int s = 0; s < 4; ++s) { const bf16x8 a = ld_frag(Kimg + (16 * jt + r) * 272 + (32 * s + 8 * q) * 2);
                kk = mfma16(a, ld_frag(Kimg + (16 * it + r) * 272 + (32 * s + 8 * q) * 2), kk);
                qk = mfma16(a, ld_frag(Qimg + (16 * it + r) * 272 + (32 * s + 8 * q) * 2), qk); }
            f32x4 av, at;
#pragma unroll
            for (int jj = 0; jj < 4; ++jj) { const int j = 16 * jt + 4 * q + jj; const float dec = (j <= i) ? expf(gi - G[j]) : 0.f;
                av[jj] = (j < i) ? bi * kk[jj] * dec : 0.f; at[jj] = qk[jj] * dec; }
            *(LAS f32x4*)(Amat + i * 272 + (16 * jt + 4 * q) * 4) = av;
            *(u32x2*)(dn + DN_ATT + (i * 64 + 16 * jt + 4 * q) * 2) = pack4(at); }
    }
    __syncthreads();
#ifndef NO_TINV
    if (w == 0) {
        LAS float* Tl = (LAS float*)(lds + 96768);
#pragma unroll 1
        for (int i = 0; i < 64; ++i) {
            const LAS float* arow = (const LAS float*)(Amat + i * 272);
            float s0 = arow[lane], s1 = 0.f, s2 = 0.f, s3 = 0.f;
            int j = 0;
            for (; j + 3 < i; j += 4) { const f32x4 a4 = *(const LAS f32x4*)(arow + j);
                s0 += a4[0] * Tl[(j + 0) * 64 + lane]; s1 += a4[1] * Tl[(j + 1) * 64 + lane]; s2 += a4[2] * Tl[(j + 2) * 64 + lane]; s3 += a4[3] * Tl[(j + 3) * 64 + lane]; }
            for (; j < i; ++j) s0 += arow[j] * Tl[j * 64 + lane];
            const float t = -((s0 + s1) + (s2 + s3));
            Tl[i * 64 + lane] = t;
            *(LAS unsigned short*)(Timg + i * 144 + lane * 2) = (unsigned short)(pk2(t, 0.f) & 0xffffu);
        }
        asm volatile("s_waitcnt lgkmcnt(0)" ::: "memory");
        *(LAS unsigned short*)(Timg + lane * 144 + lane * 2) = (unsigned short)0x3F80u;
    }
#endif
    __syncthreads();
    {
        const int ct = w & 3; const float glast = G[63];
        bf16x8 tf[2];
#pragma unroll
        for (int ks = 0; ks < 2; ++ks) tf[ks] = ld_frag(Timg + (16 * ct + r) * 144 + (32 * ks + 8 * q) * 2);
        float dk4[4];
#pragma unroll
        for (int jj = 0; jj < 4; ++jj) dk4[jj] = expf(glast - G[16 * ct + 4 * q + jj]);
#pragma unroll
        for (int e = 0; e < 4; ++e) { const int dt = 4 * (w >> 2) + e;
            f32x4 au = {0.f, 0.f, 0.f, 0.f}, aw = {0.f, 0.f, 0.f, 0.f};
#pragma unroll
            for (int ks = 0; ks < 2; ++ks) { const int ro = (32 * ks + 8 * q + (r >> 2)) * 272 + (16 * dt + 4 * (r & 3)) * 2;
                au = mfma16(tf[ks], tr_frag(VB + ro, VB + ro + 4 * 272), au);
                aw = mfma16(tr_frag(KBG + ro, KBG + ro + 4 * 272), tf[ks], aw); }
            *(u32x2*)(dn + DN_UT + ((16 * dt + r) * 64 + 16 * ct + 4 * q) * 2) = pack4(au);
            *(u32x2*)(dn + DN_WK + ((16 * ct + r) * 128 + 16 * dt + 4 * q) * 2) = pack4(aw);
            const s16x4 kv = tr4(Kimg + (16 * ct + 4 * q + (r >> 2)) * 272 + (16 * dt + 4 * (r & 3)) * 2);
            f32x4 kd;
#pragma unroll
            for (int jj = 0; jj < 4; ++jj) kd[jj] = __uint_as_float(((unsigned)(unsigned short)kv[jj]) << 16) * dk4[jj];
            *(u32x2*)(dn + DN_KDT + ((16 * dt + r) * 64 + 16 * ct + 4 * q) * 2) = pack4(kd); }
        if (tid == 0) gl_out[item] = expf(glast);
    }
    __syncthreads();
}
struct ScanOps { bf16x8 wf[4], qf[4], af[2]; u32x2 uu[2]; float g; };
DI void scan_load(ScanOps& o, const unsigned char* dn, const float* gl, int ci, int ct, int dvs, int dvt0, int nt0, int r, int q) {
#pragma unroll
    for (int ks = 0; ks < 4; ++ks) { o.wf[ks] = *(const bf16x8*)(dn + DN_WK + ((16 * ct + r) * 128 + 32 * ks + 8 * q) * 2); o.qf[ks] = *(const bf16x8*)(dn + DN_QG + ((16 * ct + r) * 128 + 32 * ks + 8 * q) * 2); }
#pragma unroll
    for (int e = 0; e < 2; ++e) o.uu[e] = *(const u32x2*)(dn + DN_UT + ((dvs * 64 + 16 * (dvt0 + e) + r) * 64 + 16 * ct + 4 * q) * 2);
#pragma unroll
    for (int ks = 0; ks < 2; ++ks) o.af[ks] = *(const bf16x8*)(dn + DN_ATT + ((16 * ct + r) * 64 + 32 * ks + 8 * q) * 2);
    o.g = gl[ci];
}
DI void scan_step(const ScanOps& c, const unsigned char* dn, f32x4 (&Sacc)[4], float* op, LAS unsigned char* Simg, LAS unsigned char* VNT, int ct, int dvt0, int mt, int nt0, int r, int q) {
    f32x4 wsa[2], qsa[2];
    bf16x8 kf[4][2];
#pragma unroll
    for (int e = 0; e < 4; ++e)
#pragma unroll
        for (int ks = 0; ks < 2; ++ks) kf[e][ks] = *(const bf16x8*)(dn + DN_KDT + ((16 * (nt0 + e) + r) * 64 + 32 * ks + 8 * q) * 2);
#pragma unroll
    for (int e = 0; e < 2; ++e) { wsa[e] = (f32x4){0.f, 0.f, 0.f, 0.f}; qsa[e] = (f32x4){0.f, 0.f, 0.f, 0.f}; }
#pragma unroll
    for (int ks = 0; ks < 4; ++ks)
#pragma unroll
        for (int e = 0; e < 2; ++e) { const LAS unsigned char* p0 = Simg + (32 * ks + 8 * q + (r >> 2)) * 144 + (16 * (dvt0 + e) + 4 * (r & 3)) * 2;
            const bf16x8 sf = tr_frag(p0, p0 + 4 * 144);
            wsa[e] = mfma16(c.wf[ks], sf, wsa[e]); qsa[e] = mfma16(c.qf[ks], sf, qsa[e]); }
#pragma unroll
    for (int e = 0; e < 2; ++e) { const int dv = 16 * (dvt0 + e) + r; const u32x2 uu = c.uu[e];
        f32x4 vn; vn[0] = bflo(uu.x) - wsa[e][0]; vn[1] = bfhi(uu.x) - wsa[e][1]; vn[2] = bflo(uu.y) - wsa[e][2]; vn[3] = bfhi(uu.y) - wsa[e][3];
        *(LAS u32x2*)(VNT + dv * 144 + (16 * ct + 4 * q) * 2) = pack4(vn); }
    lds_barrier();
#pragma unroll
    for (int ks = 0; ks < 2; ++ks)
#pragma unroll
        for (int e = 0; e < 2; ++e) qsa[e] = mfma16(c.af[ks], ld_frag(VNT + (16 * (dvt0 + e) + r) * 144 + (32 * ks + 8 * q) * 2), qsa[e]);
#pragma unroll
    for (int e = 0; e < 2; ++e)
#pragma unroll
        for (int jj = 0; jj < 4; ++jj) op[(size_t)jj * 768 + 16 * (dvt0 + e)] = qsa[e][jj];
    bf16x8 af2[2];
#pragma unroll
    for (int ks = 0; ks < 2; ++ks) af2[ks] = ld_frag(VNT + (16 * mt + r) * 144 + (32 * ks + 8 * q) * 2);
#pragma unroll
    for (int e = 0; e < 4; ++e) { Sacc[e] = Sacc[e] * c.g;
#pragma unroll
        for (int ks = 0; ks < 2; ++ks) Sacc[e] = mfma16(af2[ks], kf[e][ks], Sacc[e]);
        *(LAS u32x2*)(Simg + (16 * (nt0 + e) + r) * 144 + (16 * mt + 4 * q) * 2) = pack4(Sacc[e]); }
    lds_barrier();
}
DI void dn_scan_item(int item, const unsigned char* dnall, const float* gl, float* odn, LAS unsigned char* lds, int tid0) {
    const int tid = opaque(tid0);
    const int dvs = item & 1, bh = item >> 1, h = bh % NH, b = bh / NH;
    LAS unsigned char* Simg = lds; LAS unsigned char* VNT = lds + 18432;
    for (int u = tid; u < 18432 / 16; u += NTHR) *(LAS u32x4*)(Simg + u * 16) = (u32x4){0u, 0u, 0u, 0u};
    const int w = tid >> 6, lane = tid & 63, r = lane & 15, q = lane >> 4;
    const int ct = w >> 1, dvt0 = 2 * (w & 1), mt = w & 3, nt0 = 4 * (w >> 2);
    f32x4 Sacc[4];
#pragma unroll
    for (int e = 0; e < 4; ++e) Sacc[e] = (f32x4){0.f, 0.f, 0.f, 0.f};
    const unsigned char* dn0 = dnall + (size_t)(bh * 32) * DN_STRIDE;
    float* op0 = odn + ((size_t)b * SEQ + 16 * ct + 4 * q) * 768 + h * 128 + dvs * 64 + r;
    ScanOps A, B;
    scan_load(A, dn0, gl, bh * 32, ct, dvs, dvt0, nt0, r, q);
    __syncthreads();
#pragma unroll 1
    for (int n = 0; n < 32; n += 2) {
        scan_load(B, dn0 + (size_t)(n + 1) * DN_STRIDE, gl, bh * 32 + n + 1, ct, dvs, dvt0, nt0, r, q);
        scan_step(A, dn0 + (size_t)n * DN_STRIDE, Sacc, op0 + (size_t)(64 * n) * 768, Simg, VNT, ct, dvt0, mt, nt0, r, q);
        const int n2 = (n + 2 < 32) ? n + 2 : 31;
        scan_load(A, dn0 + (size_t)n2 * DN_STRIDE, gl, bh * 32 + n2, ct, dvs, dvt0, nt0, r, q);
        scan_step(B, dn0 + (size_t)(n + 1) * DN_STRIDE, Sacc, op0 + (size_t)(64 * (n + 1)) * 768, Simg, VNT, ct, dvt0, mt, nt0, r, q);
    }
}
DI void dn_gate_phase(const float* odn, const bf16* proj, const float* ong, bf16* mix, int gw, int ngw, int lane0) {
    const int lane = opaque(lane0);
    const int sub = lane >> 4, l16 = lane & 15;
    float gv[8];
#pragma unroll
    for (int e = 0; e < 8; ++e) gv[e] = ong[l16 * 8 + e];
    constexpr int UN = 4, NIT = M * NH / 4;
    for (int it0 = gw; it0 < NIT; it0 += ngw * UN) {
        f32x4 o0[UN], o1[UN]; u32x4 graw[UN]; int row[UN], hh[UN];
#pragma unroll
        for (int u = 0; u < UN; ++u) { int it = it0 + u * ngw; if (it >= NIT) it = NIT - 1; const int idx = it * 4 + sub; row[u] = idx / NH; hh[u] = idx % NH;
            const float* op = odn + (size_t)row[u] * 768 + hh[u] * 128 + l16 * 8; o0[u] = *(const f32x4*)op; o1[u] = *(const f32x4*)(op + 4);
            graw[u] = *(const u32x4*)(proj + (size_t)row[u] * NPROJ + C_BG + hh[u] * 128 + l16 * 8); }
#pragma unroll
        for (int u = 0; u < UN; ++u) {
            float ss = (o0[u][0] * o0[u][0] + o0[u][1] * o0[u][1]) + (o0[u][2] * o0[u][2] + o0[u][3] * o0[u][3]) + (o1[u][0] * o1[u][0] + o1[u][1] * o1[u][1]) + (o1[u][2] * o1[u][2] + o1[u][3] * o1[u][3]);
            ss += __shfl_xor(ss, 1); ss += __shfl_xor(ss, 2); ss += __shfl_xor(ss, 4); ss += __shfl_xor(ss, 8);
            const float rs = 1.0f / sqrtf(ss * (1.0f / 128.0f) + EPS);
            float gt[8]; unpack8(graw[u], gt);
            float y[8];
#pragma unroll
            for (int e = 0; e < 4; ++e) { y[e] = o0[u][e] * rs * gv[e] * silu_f(gt[e]); y[4 + e] = o1[u][e] * rs * gv[4 + e] * silu_f(gt[4 + e]); }
            if (it0 + u * ngw < NIT) *(u32x4*)(mix + (size_t)row[u] * DM + 512 + hh[u] * 128 + l16 * 8) = pack8(y);
        }
    }
}

struct Args { const float* in[16]; float* out; unsigned char* ws; };
#ifndef MK_SKIP_MIX
#define MK_SKIP_MIX 0
#endif
#ifndef REP_M1
#define REP_M1 1
#endif
#ifndef REP_M2
#define REP_M2 1
#endif
#ifndef REP_G13
#define REP_G13 1
#endif
__global__ void __launch_bounds__(NTHR, 2) hybrid_fwd(Args a) {
    extern __shared__ __attribute__((aligned(16))) unsigned char lds_raw[];
    LAS unsigned char* lds = (LAS unsigned char*)lds_raw;
    cg::grid_group grid = cg::this_grid();
    volatile LAS unsigned* bst = (volatile LAS unsigned*)(lds + LDS_BYTES - 64);
    if (threadIdx.x < 2) bst[threadIdx.x] = 0u;
    __syncthreads();
    const XcdBarrier xbar = xcd_barrier_post((unsigned*)(a.ws + WS_CTL), bst);
    const int tid = threadIdx.x, lane = tid & 63, wave = __builtin_amdgcn_readfirstlane(tid >> 6);
    const int G = gridDim.x, bx = blockIdx.x, gw = bx * 8 + wave, ngw = G * 8;
    unsigned char* ws = a.ws;
    bf16* Hb = (bf16*)(ws + WS_H); bf16* PROJ = (bf16*)(ws + WS_PROJ); float* BD = (float*)(ws + WS_BD); unsigned char* DN = ws + WS_DN; float* GL = (float*)(ws + WS_GL);
    float* ODN = (float*)(ws + WS_ODN); bf16* OBR = (bf16*)(ws + WS_OBR); float* LSE = (float*)(ws + WS_LSE);
    bf16* MIX = Hb; bf16* ACT = PROJ;

#ifdef EXTRA_SYNCS
    for (int es = 0; es < EXTRA_SYNCS; ++es) xcd_barrier(xbar);
#endif
    weight_prep(a.in, ws, lds, gw, ngw, wave, lane);
    __syncthreads();
    norm_phase(a.in[I_X], a.in[I_N1G], Hb, a.in[I_WIN], BD, lds, gw, ngw, tid, lane);
    grid.sync();
#pragma unroll 1
    for (int s = 1; s < DEPTH * 9; ++s) {
        const int l = s / 9, ph = s - 9 * l;
        const unsigned char* wl = ws + WS_W + (size_t)l * SZ_WL;
        if (ph == 0) {
            norm_phase(a.out, a.in[I_N1G] + (size_t)l * DM, Hb, a.in[I_WIN] + (size_t)l * DM * IN_TOTAL, BD, lds, gw, ngw, tid, lane);
        } else if (ph == 1) {
            pg8::Gemm g{Hb, (const bf16*)wl, M, NPROJ, DM}; pg8::StaticOrder S; S.init(M, NPROJ, G, bx);
            pg8::EpiBf16<0> E{PROJ, NPROJ, nullptr, 0, 0, 1.f};
            pg8::gemm_phase<pg8::EpiBf16<0>, pg8::StaticOrder, true, true>(lds, g, S, E);
        } else if (ph == 2) {
            for (int it = bx; it < 2304 + 1536 + 512; it += G) {
                if (it < 2304) attn_item(it, PROJ, a.in[I_QNG] + l * HD, a.in[I_KNG] + l * HD, OBR, LSE, lds, tid);
                else if (it < 2304 + 1536) dn_prep_item(it - 2304, PROJ, BD, a.in[I_CONVW] + (size_t)l * 4 * 2304, a.in[I_ALOG] + l * NH, a.in[I_DTB] + l * NH, DN, GL, lds, tid);
                else sgu_item(it - 3840, PROJ, a.in[I_SGUG] + l * 512, a.in[I_WS] + (size_t)l * 4 * 128 * 128, a.in[I_BS] + l * 512, MIX, lds, tid);
            }
        } else if (ph == 3) {
            if (G > NSCAN) {
                if (bx < NSCAN) dn_scan_item(bx, DN, GL, ODN, lds, tid);
                else attn_combine(OBR, LSE, MIX, (bx - NSCAN) * NTHR + tid, (G - NSCAN) * NTHR);
            } else {
                for (int it = bx; it < NSCAN; it += G) { dn_scan_item(it, DN, GL, ODN, lds, tid); __syncthreads(); }
                attn_combine(OBR, LSE, MIX, bx * NTHR + tid, G * NTHR);
            }
        } else if (ph == 4) {
            dn_gate_phase(ODN, PROJ, a.in[I_ONG] + l * HD, MIX, gw, ngw, lane);
        } else if (ph == 5) {
            pg8::Gemm g{MIX, (const bf16*)(wl + SZ_WIN), M, DM, DM}; pg8::StaticOrder S; S.init(M, DM, G, bx);
            pg8::EpiResF32 E{(l == 0) ? a.in[I_X] : a.out, a.out, DM};
            pg8::gemm_phase<pg8::EpiResF32, pg8::StaticOrder, true, true>(lds, g, S, E);
        } else if (ph == 6) {
            norm_phase(a.out, a.in[I_N2G] + (size_t)l * DM, Hb, nullptr, nullptr, lds, gw, ngw, tid, lane);
        } else if (ph == 7) {
            pg8::Gemm g{Hb, (const bf16*)(wl + SZ_WIN + SZ_WOUT), M, 2 * FF, DM}; pg8::StaticOrder S; S.init(M, 2 * FF, G, bx);
            pg8::EpiSwiGLU E{ACT, FF};
            pg8::gemm_phase<pg8::EpiSwiGLU, pg8::StaticOrder, true, true>(lds, g, S, E);
        } else {
            pg8::Gemm g{ACT, (const bf16*)(wl + SZ_WIN + SZ_WOUT + SZ_WGU), M, DM, FF}; pg8::StaticOrder S; S.init(M, DM, G, bx);
            pg8::EpiResF32 E{a.out, a.out, DM};
            pg8::gemm_phase<pg8::EpiResF32, pg8::StaticOrder, true, true>(lds, g, S, E);
        }
        if (s + 1 < DEPTH * 9) xcd_barrier(xbar);
    }
}

extern "C" void kernel_launch(void* const* d_in, const int* in_sizes, int n_in, void* d_out, int out_size, void* d_ws, size_t ws_size, hipStream_t stream) {
    static int grid = 0;
    if (grid == 0) {
        if (n_in != 16 || in_sizes[0] != M * DM || out_size != M * DM || ws_size < WS_END) { fprintf(stderr, "kernel_launch: unexpected shapes / workspace (n_in %d, ws %zu, need %zu); nothing launched\n", n_in, ws_size, (size_t)WS_END); grid = -1; return; }
        int dev = 0, cus = 0, per_cu = 0;
        if (hipGetDevice(&dev) != hipSuccess || hipDeviceGetAttribute(&cus, hipDeviceAttributeMultiprocessorCount, dev) != hipSuccess) { grid = -1; return; }
        if (hipFuncSetAttribute((const void*)hybrid_fwd, hipFuncAttributeMaxDynamicSharedMemorySize, LDS_BYTES) != hipSuccess) { fprintf(stderr, "kernel_launch: hipFuncSetAttribute failed\n"); grid = -1; return; }
        if (hipOccupancyMaxActiveBlocksPerMultiprocessor(&per_cu, (const void*)hybrid_fwd, NTHR, LDS_BYTES) != hipSuccess || per_cu < 1) { fprintf(stderr, "kernel_launch: occupancy query says %d blocks per CU\n", per_cu); per_cu = 1; }
        (void)hipGetLastError();
        grid = cus;
    }
    if (grid < 0) return;
    if (hipMemsetAsync((char*)d_ws + WS_CTL, 0, CTL_BYTES, stream) != hipSuccess) { fprintf(stderr, "kernel_launch: memset of the barrier words failed\n"); return; }
    Args a{};
    for (int i = 0; i < 16; ++i) a.in[i] = (const float*)d_in[i];
    a.out = (float*)d_out; a.ws = (unsigned char*)d_ws;
    void* args[] = {&a};
    hipError_t e = hipLaunchCooperativeKernel((const void*)hybrid_fwd, dim3(grid), dim3(NTHR), args, LDS_BYTES, stream);
    if (e != hipSuccess) fprintf(stderr, "kernel_launch: cooperative launch failed: %s (grid %d)\n", hipGetErrorString(e), grid);
}
```

```cpp
#include <hip/hip_runtime.h>
#include <hip/hip_cooperative_groups.h>
#include <cstdio>
#include <cstdint>
namespace cg = cooperative_groups;
namespace pg8 {
#define PG8_LAS __attribute__((address_space(3)))
typedef unsigned short bf16_t;
typedef short bf16x8 __attribute__((ext_vector_type(8)));
typedef float f32x4 __attribute__((ext_vector_type(4)));
typedef unsigned u32x4 __attribute__((ext_vector_type(4)));
constexpr int BM = 256, BK = 64, HALF = 128, HTB = HALF * BK * 2  , STAGE_BYTES = 8 * HTB, NXCD = 8, WGM = 8;

__host__ __device__ __forceinline__ int lds_byte(int r, int c) { const int st = (r >> 4) * 2 + (c >> 5), rr = r & 15, cc = c & 31, ob = rr * 64 + cc * 2; return st * 1024 + (ob ^ (((ob >> 9) & 1) << 5)); }
__host__ __device__ __forceinline__ void stage_rc(int b, int& R, int& C) { const int st = b / 1024, sb = b % 1024, swz = sb ^ (((sb >> 9) & 1) << 5); R = (st >> 1) * 16 + swz / 64; C = (st & 1) * 32 + (swz % 64) / 2; }
__host__ __device__ __forceinline__ int perm32(int rho) { const int n = rho >> 4, i = rho & 15; return 8 * (i >> 2) + 4 * n + (i & 3); }

struct Unit { int pm, pn; };
struct Gemm { const bf16_t* A; const bf16_t* Bt; int M, N, K; };

struct StaticOrder {
    int nM, nN, nwg, G, c;
    __host__ __device__ void init(int M, int N, int G_, int c_) { nM = M / BM; nN = N / BM; nwg = nM * nN; G = G_; c = c_; }
    __host__ __device__ bool next(int i, Unit& u) const {
        const long L = (long)i * G + c; if (L >= nwg) return false;
        int wgid = (int)L; { const int q = nwg / NXCD, r = nwg % NXCD, xcd = wgid % NXCD, off = wgid / NXCD; wgid = (xcd < r ? xcd * (q + 1) : r * (q + 1) + (xcd - r) * q) + off; }
        const int nig = WGM * nN, gid = wgid / nig, fm = gid * WGM, gsz = (nM - fm) < WGM ? (nM - fm) : WGM;
        u.pm = fm + ((wgid % nig) % gsz); u.pn = (wgid % nig) / gsz; return true;
    }
    __device__ __forceinline__ void a_ready(const Unit&) const {}
    __device__ __forceinline__ void done(const Unit&) const {}
};

__device__ __forceinline__ unsigned cvt_pk_bf16(float lo, float hi) { unsigned r; asm volatile("v_cvt_pk_bf16_f32 %0, %1, %2" : "=v"(r) : "v"(lo), "v"(hi)); return r; }
typedef float f32x2 __attribute__((ext_vector_type(2)));
__device__ __forceinline__ f32x2 gelu_pk(f32x2 v) {
    const f32x2 av = __builtin_elementwise_abs(v), d = av * 0.2316418882f + 1.0f;
    f32x2 t; t.x = __builtin_amdgcn_rcpf(d.x); t.y = __builtin_amdgcn_rcpf(d.y);
    f32x2 q = t * 0.5307027145f + (-0.7265760135f); q = q * t + 0.7107068705f; q = q * t + (-0.142248368f); q = q * t + 0.127414796f; q = q * t;
    const f32x2 s = (v * v) * (-0.72134752044f);
    f32x2 e; e.x = __builtin_amdgcn_exp2f(s.x); e.y = __builtin_amdgcn_exp2f(s.y);
    const f32x2 m = v * (q * e), r = v - m;
    f32x2 o; o.x = v.x < 0.f ? m.x : r.x; o.y = v.y < 0.f ? m.y : r.y; return o;
}

template <int ACT  > struct EpiBf16 {
    static constexpr bool PERM = true, AFTER_DRAIN = false; static_assert(ACT == 0 || ACT == 1, "EpiBf16: ACT is 0 (none) or 1 (gelu_pk)");
    bf16_t* O; int ldc; const float* bias; int split_cols; size_t split_stride; float scale0;
    __device__ __forceinline__ void operator()(const f32x4 (&acc)[2][2][4][2], const Unit& u, int wr, int wc, int fr, int fq) const {
        const int row0 = u.pm * BM + wr * 64 + fr; int colt = u.pn * BM; bf16_t* base = O;
        float sc = 1.f; if (split_cols) { const int t = colt / split_cols; base += (size_t)t * split_stride; colt -= t * split_cols; if (t == 0) sc = scale0; }
        const int col0 = colt + wc * 32 + 8 * fq, bcol0 = u.pn * BM + wc * 32 + 8 * fq;
        f32x4 bv[2][2];
#pragma unroll
        for (int bj = 0; bj < 2; ++bj)
#pragma unroll
            for (int n = 0; n < 2; ++n) bv[bj][n] = bias ? *(const f32x4*)(bias + bcol0 + bj * HALF + 4 * n) : (f32x4){0.f, 0.f, 0.f, 0.f};
#pragma unroll
        for (int ai = 0; ai < 2; ++ai)
#pragma unroll
            for (int m = 0; m < 4; ++m) { bf16_t* rowp = base + (size_t)(row0 + ai * HALF + m * 16) * ldc + col0;
#pragma unroll
                for (int bj = 0; bj < 2; ++bj) { f32x4 v0 = acc[ai][bj][m][0] + bv[bj][0], v1 = acc[ai][bj][m][1] + bv[bj][1];
                    if (ACT == 1) { f32x2 a = gelu_pk((f32x2){v0[0], v0[1]}), b = gelu_pk((f32x2){v0[2], v0[3]}), c = gelu_pk((f32x2){v1[0], v1[1]}), d = gelu_pk((f32x2){v1[2], v1[3]});
                        v0 = (f32x4){a.x, a.y, b.x, b.y}; v1 = (f32x4){c.x, c.y, d.x, d.y}; }
                    v0 = v0 * sc; v1 = v1 * sc; u32x4 w; w.x = cvt_pk_bf16(v0[0], v0[1]); w.y = cvt_pk_bf16(v0[2], v0[3]); w.z = cvt_pk_bf16(v1[0], v1[1]); w.w = cvt_pk_bf16(v1[2], v1[3]);
                    *(u32x4*)(rowp + bj * HALF) = w; } }
    }
};
struct EpiResF32 {
    static constexpr bool PERM = false, AFTER_DRAIN = false;
    const float* base; float* out; int ldc;
    __device__ __forceinline__ void operator()(const f32x4 (&acc)[2][2][4][2], const Unit& u, int wr, int wc, int fr, int fq) const {
        const int row0 = u.pm * BM + wr * 64 + fr; const int col0 = u.pn * BM + wc * 32 + 4 * fq;
#pragma unroll
        for (int ai = 0; ai < 2; ++ai)
#pragma unroll
            for (int m = 0; m < 4; ++m) { const size_t off = (size_t)(row0 + ai * HALF + m * 16) * ldc + col0;
#pragma unroll
                for (int bj = 0; bj < 2; ++bj)
#pragma unroll
                    for (int n = 0; n < 2; ++n) { const f32x4 b = *(const f32x4*)(base + off + bj * HALF + n * 16); *(f32x4*)(out + off + bj * HALF + n * 16) = b + acc[ai][bj][m][n]; } }
    }
};
__device__ __forceinline__ float silu_f(float g) { return g * __builtin_amdgcn_rcpf(1.0f + __expf(-g)); }
struct EpiSwiGLU {
    static constexpr bool PERM = true, AFTER_DRAIN = false;
    bf16_t* O; int ldo;
    __device__ __forceinline__ void operator()(const f32x4 (&acc)[2][2][4][2], const Unit& u, int wr, int wc, int fr, int fq) const {
        const int row0 = u.pm * BM + wr * 64 + fr; const int col0 = u.pn * HALF + wc * 32 + 8 * fq;
#pragma unroll
        for (int ai = 0; ai < 2; ++ai)
#pragma unroll
            for (int m = 0; m < 4; ++m) { bf16_t* rowp = O + (size_t)(row0 + ai * HALF + m * 16) * ldo + col0;
                const f32x4 g0 = acc[ai][0][m][0], g1 = acc[ai][0][m][1], u0 = acc[ai][1][m][0], u1 = acc[ai][1][m][1];
                u32x4 w; w.x = cvt_pk_bf16(silu_f(g0[0]) * u0[0], silu_f(g0[1]) * u0[1]); w.y = cvt_pk_bf16(silu_f(g0[2]) * u0[2], silu_f(g0[3]) * u0[3]);
                w.z = cvt_pk_bf16(silu_f(g1[0]) * u1[0], silu_f(g1[1]) * u1[1]); w.w = cvt_pk_bf16(silu_f(g1[2]) * u1[2], silu_f(g1[3]) * u1[3]);
                *(u32x4*)rowp = w; }
    }
};
template <class Epi, class Sched, bool ALIGN_EPI = false, bool SP2 = false>
__device__ __forceinline__ void gemm_phase(PG8_LAS unsigned char* lds, const Gemm g, const Sched& S, const Epi& E) {
    int tid_ = threadIdx.x; asm volatile("" : "+v"(tid_)); const int tid = tid_, wid = __builtin_amdgcn_readfirstlane(tid >> 6), lane = tid & 63, wr = wid >> 2, wc = wid & 3, fr = lane & 15, fq = lane >> 4;
    const int K = g.K, nt = K / BK;
    unsigned voffA[2], voffB[2];
#pragma unroll
    for (int i = 0; i < 2; ++i) { int R, C; stage_rc(tid * 16 + i * 8192, R, C); const int Rb = Epi::PERM ? ((R & ~31) + perm32(R & 31)) : R;
        voffA[i] = (unsigned)(R * K + C) * 2u; voffB[i] = (unsigned)(Rb * K + C) * 2u; }
    const size_t kstep = (size_t)(BK * 2);
    const size_t hstep = (size_t)HALF * K * 2;
    const size_t tstep = 2 * hstep;
    const unsigned ldsw = (unsigned)wid * 1024u;
    const int aoff = lds_byte(wr * 64 + fr, fq * 8), boff = lds_byte(wc * 32 + fr, fq * 8);
#define PG8_SA(b, h) (((b) * 2 + (h)) * HTB)
#define PG8_SB(b, h) ((4 + (b) * 2 + (h)) * HTB)
#define PG8_STAGE(bufoff, gbase, voff) do { _Pragma("unroll") for (int _i = 0; _i < 2; ++_i) \
        __builtin_amdgcn_global_load_lds((const unsigned*)((const char*)(gbase) + (voff)[_i]), (PG8_LAS unsigned*)(lds + (bufoff) + ldsw + _i * 8192), 16, 0, 0); } while (0)
#define PG8_LDA(dst, b, h) do { _Pragma("unroll") for (int m = 0; m < 4; ++m) _Pragma("unroll") for (int k = 0; k < 2; ++k) dst[m][k] = *(const PG8_LAS bf16x8*)(lds + PG8_SA(b, h) + aoff + m * 2048 + k * 1024); } while (0)
#define PG8_LDB(dst, b, h) do { _Pragma("unroll") for (int n = 0; n < 2; ++n) _Pragma("unroll") for (int k = 0; k < 2; ++k) dst[n][k] = *(const PG8_LAS bf16x8*)(lds + PG8_SB(b, h) + boff + n * 2048 + k * 1024); } while (0)
#define PG8_MMA(ai, bj, At, Bt) do { __builtin_amdgcn_s_setprio(1); _Pragma("unroll") for (int m = 0; m < 4; ++m) _Pragma("unroll") for (int n = 0; n < 2; ++n) _Pragma("unroll") for (int k = 0; k < 2; ++k) \
        acc[ai][bj][m][n] = __builtin_amdgcn_mfma_f32_16x16x32_bf16(Bt[n][k], At[m][k], acc[ai][bj][m][n], 0, 0, 0); __builtin_amdgcn_s_setprio(0); } while (0)
#define PG8_WAIT_V(n) asm volatile("s_waitcnt vmcnt(" #n ")" ::: "memory")
#define PG8_WAIT_L(n) asm volatile("s_waitcnt lgkmcnt(" #n ")" ::: "memory")
#define PG8_BAR __builtin_amdgcn_s_barrier()
#define PG8_SCHED __builtin_amdgcn_sched_barrier(0)
    Unit cur, nxt; int ui = 0;
    if (!S.next(0, cur)) return;
    f32x4 acc[2][2][4][2];
#pragma unroll
    for (int a = 0; a < 2; ++a)
#pragma unroll
        for (int b = 0; b < 2; ++b)
#pragma unroll
            for (int m = 0; m < 4; ++m)
#pragma unroll
                for (int n = 0; n < 2; ++n) acc[a][b][m][n] = (f32x4){0.f, 0.f, 0.f, 0.f};
    bf16x8 At[4][2], B0[2][2], B1[2][2];
    const char* cA = (const char*)g.A + (size_t)cur.pm * tstep; const char* cB = (const char*)g.Bt + (size_t)cur.pn * tstep;
    S.a_ready(cur);
    if constexpr (SP2) {
        PG8_STAGE(PG8_SB(0, 0), cB, voffB); PG8_STAGE(PG8_SB(0, 1), cB + hstep, voffB); PG8_STAGE(PG8_SA(0, 0), cA, voffA); PG8_STAGE(PG8_SA(0, 1), cA + hstep, voffA);
        if (wr == 1) PG8_BAR;
        PG8_WAIT_V(2); PG8_BAR;
        PG8_STAGE(PG8_SB(1, 0), cB + kstep, voffB); PG8_STAGE(PG8_SA(1, 0), cA + kstep, voffA); PG8_STAGE(PG8_SB(1, 1), cB + hstep + kstep, voffB);
        PG8_WAIT_V(6); PG8_BAR;
    } else {
        PG8_STAGE(PG8_SB(0, 0), cB, voffB); PG8_STAGE(PG8_SA(0, 0), cA, voffA); PG8_STAGE(PG8_SB(0, 1), cB + hstep, voffB); PG8_STAGE(PG8_SA(0, 1), cA + hstep, voffA);
        if (wr == 1) PG8_BAR;
        PG8_WAIT_V(4); PG8_BAR;
        PG8_STAGE(PG8_SB(1, 0), cB + kstep, voffB); PG8_STAGE(PG8_SA(1, 0), cA + kstep, voffA); PG8_STAGE(PG8_SB(1, 1), cB + hstep + kstep, voffB);
        PG8_WAIT_V(6); PG8_BAR;
    }
    for (;;) {
        const bool has_next = S.next(ui + 1, nxt);
        const char* nA = has_next ? (const char*)g.A + (size_t)nxt.pm * tstep : cA; const char* nB = has_next ? (const char*)g.Bt + (size_t)nxt.pn * tstep : cB;
        for (int t = 0; t < nt; t += 2) {
            const bool last = (t == nt - 2);
            const char* a1 = cA + (size_t)(t + 1) * kstep;
            const char* a2 = last ? nA : cA + (size_t)(t + 2) * kstep; const char* b2 = last ? nB : cB + (size_t)(t + 2) * kstep;
            const char* a3 = a2 + kstep; const char* b3 = b2 + kstep;
            if (last && has_next) S.a_ready(nxt);
            if constexpr (SP2) {
            PG8_LDB(B0, 0, 0); PG8_LDB(B1, 0, 1); PG8_SCHED; PG8_LDA(At, 0, 0); PG8_STAGE(PG8_SA(1, 1), a1 + hstep, voffA);
            PG8_WAIT_V(8); PG8_WAIT_L(0); PG8_BAR; PG8_MMA(0, 0, At, B0); PG8_MMA(0, 1, At, B1); PG8_BAR; PG8_SCHED;
            PG8_LDA(At, 0, 1); PG8_STAGE(PG8_SB(0, 0), b2, voffB); PG8_STAGE(PG8_SB(0, 1), b2 + hstep, voffB); PG8_STAGE(PG8_SA(0, 0), a2, voffA);
            PG8_WAIT_V(8); PG8_WAIT_L(0); PG8_BAR; PG8_MMA(1, 0, At, B0); PG8_MMA(1, 1, At, B1); PG8_BAR; PG8_SCHED;
            PG8_LDB(B0, 1, 0); PG8_LDB(B1, 1, 1); PG8_SCHED; PG8_LDA(At, 1, 0); PG8_STAGE(PG8_SA(0, 1), a2 + hstep, voffA);
            PG8_WAIT_V(8); PG8_WAIT_L(0); PG8_BAR; PG8_MMA(0, 0, At, B0); PG8_MMA(0, 1, At, B1); PG8_BAR; PG8_SCHED;
            PG8_LDA(At, 1, 1); PG8_STAGE(PG8_SB(1, 0), b3, voffB); PG8_STAGE(PG8_SB(1, 1), b3 + hstep, voffB); PG8_STAGE(PG8_SA(1, 0), a3, voffA);
            PG8_WAIT_V(8); PG8_WAIT_L(0); PG8_BAR; PG8_MMA(1, 0, At, B0); PG8_MMA(1, 1, At, B1); PG8_BAR; PG8_SCHED;
            } else {
            PG8_LDB(B0, 0, 0); PG8_SCHED; PG8_LDA(At, 0, 0); PG8_STAGE(PG8_SA(1, 1), a1 + hstep, voffA);
            PG8_WAIT_L(8); PG8_BAR; PG8_WAIT_L(0); PG8_MMA(0, 0, At, B0); PG8_BAR; PG8_SCHED;
            PG8_LDB(B1, 0, 1); PG8_STAGE(PG8_SB(0, 0), b2, voffB);
            PG8_BAR; PG8_WAIT_L(0); PG8_MMA(0, 1, At, B1); PG8_BAR;
            PG8_LDA(At, 0, 1); PG8_STAGE(PG8_SA(0, 0), a2, voffA);
            PG8_BAR; PG8_WAIT_L(0); PG8_MMA(1, 0, At, B0); PG8_BAR; PG8_SCHED;
            PG8_STAGE(PG8_SB(0, 1), b2 + hstep, voffB);
            PG8_WAIT_V(6); PG8_BAR; PG8_MMA(1, 1, At, B1); PG8_BAR;
            PG8_LDB(B0, 1, 0); PG8_SCHED; PG8_LDA(At, 1, 0); PG8_STAGE(PG8_SA(0, 1), a2 + hstep, voffA);
            PG8_WAIT_L(8); PG8_BAR; PG8_WAIT_L(0); PG8_MMA(0, 0, At, B0); PG8_BAR; PG8_SCHED;
            PG8_LDB(B1, 1, 1); PG8_STAGE(PG8_SB(1, 0), b3, voffB);
            PG8_BAR; PG8_WAIT_L(0); PG8_MMA(0, 1, At, B1); PG8_BAR;
            PG8_LDA(At, 1, 1); PG8_STAGE(PG8_SA(1, 0), a3, voffA);
            PG8_BAR; PG8_WAIT_L(0); PG8_MMA(1, 0, At, B0); PG8_BAR; PG8_SCHED;
            PG8_STAGE(PG8_SB(1, 1), b3 + hstep, voffB);
            PG8_WAIT_V(6); PG8_BAR; PG8_MMA(1, 1, At, B1); PG8_BAR;
            }
        }
        if constexpr (ALIGN_EPI) { if (wr == 0) PG8_BAR; }
        if constexpr (!Epi::AFTER_DRAIN) { E(acc, cur, wr, wc, fr, fq); S.done(cur); }
        if (!has_next) break;
#pragma unroll
        for (int a = 0; a < 2; ++a)
#pragma unroll
            for (int b = 0; b < 2; ++b)
#pragma unroll
                for (int m = 0; m < 4; ++m)
#pragma unroll
                    for (int n = 0; n < 2; ++n) acc[a][b][m][n] = (f32x4){0.f, 0.f, 0.f, 0.f};
        cur = nxt; cA = nA; cB = nB; ++ui;
        if constexpr (ALIGN_EPI) { if (wr == 1) PG8_BAR; }
    }
    PG8_WAIT_V(0);
    if constexpr (!ALIGN_EPI) { if (wr == 0) PG8_BAR; }
    PG8_BAR;
    if constexpr (Epi::AFTER_DRAIN) { E.fused(acc, cur, wr, wc, fr, fq, lds, wid, lane); S.done(cur); }
#undef PG8_SA
#undef PG8_SB
#undef PG8_STAGE
#undef PG8_LDA
#undef PG8_LDB
#undef PG8_MMA
#undef PG8_WAIT_V
#undef PG8_WAIT_L
#undef PG8_BAR
#undef PG8_SCHED
}
}
#define DI __device__ __forceinline__
#define LAS __attribute__((address_space(3)))
typedef unsigned short bf16;
typedef short bf16x8 __attribute__((ext_vector_type(8)));
typedef short s16x4 __attribute__((ext_vector_type(4)));
typedef short v4i16_t __attribute__((ext_vector_type(4)));
typedef float f32x4 __attribute__((ext_vector_type(4)));
typedef float f32x2 __attribute__((ext_vector_type(2)));
typedef unsigned u32x4 __attribute__((ext_vector_type(4)));
typedef unsigned u32x2 __attribute__((ext_vector_type(2)));
typedef __bf16 bf16x2_t __attribute__((ext_vector_type(2)));

constexpr int NB = 8, SEQ = 2048, DM = 2048, M = NB * SEQ, DEPTH = 2, HD = 128, NH = 6;
constexpr int NPROJ = 6400, IN_TOTAL = 6412, FF = 5632;
constexpr int C_AU = 0, C_AV = 512, C_BQ = 1024, C_BK = 1792, C_BV = 2560, C_BG = 3328, C_CQ = 4096, C_CK = 4864, C_CV = 5632;
constexpr float EPS = 1e-6f, LOG2E = 1.4426950408889634f, LN2 = 0.6931471805599453f;
enum { I_X = 0, I_N1G, I_WIN, I_SGUG, I_WS, I_BS, I_CONVW, I_ALOG, I_DTB, I_ONG, I_QNG, I_KNG, I_WOUT, I_N2G, I_WGU, I_WDN };

constexpr size_t SZ_WIN = (size_t)NPROJ * DM * 2, SZ_WOUT = (size_t)DM * DM * 2, SZ_WGU = (size_t)2 * FF * DM * 2, SZ_WDN = (size_t)DM * FF * 2;
constexpr size_t SZ_WL = SZ_WIN + SZ_WOUT + SZ_WGU + SZ_WDN;
constexpr size_t WS_W = 0;
constexpr size_t WS_H = WS_W + DEPTH * SZ_WL;
constexpr size_t WS_PROJ = WS_H + (size_t)M * DM * 2;
constexpr size_t WS_BD = WS_PROJ + (size_t)M * NPROJ * 2;
constexpr size_t WS_DN = WS_BD + (size_t)M * 12 * 4;
constexpr int NCHUNK = NB * NH * 32;
constexpr size_t DN_WK = 0, DN_QG = 16384, DN_KDT = 32768, DN_UT = 49152, DN_ATT = 65536, DN_STRIDE = 73728;
constexpr size_t WS_GL = WS_DN + (size_t)NCHUNK * DN_STRIDE;
constexpr size_t WS_ODN = WS_GL + 8192;
constexpr size_t WS_OBR = WS_ODN + (size_t)M * 768 * 4;
constexpr size_t WS_LSE = WS_OBR + (size_t)3 * M * 768 * 2;
constexpr size_t WS_CTL = WS_LSE + (size_t)3 * M * 6 * 4;
constexpr size_t CTL_BYTES = 16384;
constexpr size_t WS_END = WS_CTL + CTL_BYTES;
constexpr int LDS_BYTES = 143360;
constexpr int NTHR = 512;
constexpr int NSCAN = 96;

DI unsigned pk2(float lo, float hi) { f32x2 v = {lo, hi}; bf16x2_t b = __builtin_convertvector(v, bf16x2_t); return __builtin_bit_cast(unsigned, b); }
DI float bflo(unsigned w) { return __uint_as_float(w << 16); }
DI float bfhi(unsigned w) { return __uint_as_float(w & 0xffff0000u); }
DI f32x4 mfma16(bf16x8 a, bf16x8 b, f32x4 c) { return __builtin_amdgcn_mfma_f32_16x16x32_bf16(a, b, c, 0, 0, 0); }
DI s16x4 tr4(const LAS unsigned char* p) { return __builtin_bit_cast(s16x4, __builtin_amdgcn_ds_read_tr16_b64_v4i16((LAS v4i16_t*)p)); }
DI bf16x8 tr_frag(const LAS unsigned char* p0, const LAS unsigned char* p1) { const s16x4 lo = tr4(p0), hi = tr4(p1); return __builtin_shufflevector(lo, hi, 0, 1, 2, 3, 4, 5, 6, 7); }
DI bf16x8 ld_frag(const LAS unsigned char* p) { return *(const LAS bf16x8*)p; }
DI void lds_barrier() { asm volatile("s_waitcnt lgkmcnt(0)" ::: "memory"); __builtin_amdgcn_s_barrier(); asm volatile("" ::: "memory"); }
DI int opaque(int x) { asm volatile("" : "+v"(x)); return x; }
DI float wave_sum(float v) {
#pragma unroll
    for (int o = 1; o < 64; o <<= 1) v += __shfl_xor(v, o);
    return v;
}
DI float sigmoid_f(float x) { return __builtin_amdgcn_rcpf(1.0f + __expf(-x)); }
DI float silu_f(float x) { return x * sigmoid_f(x); }
DI float gelu_tanh(float x) { const float u = 0.7978845608028654f * (x + 0.044715f * x * x * x); return x * sigmoid_f(2.0f * u); }
DI void unpack8(const u32x4 w, float* f) { f[0] = bflo(w.x); f[1] = bfhi(w.x); f[2] = bflo(w.y); f[3] = bfhi(w.y); f[4] = bflo(w.z); f[5] = bfhi(w.z); f[6] = bflo(w.w); f[7] = bfhi(w.w); }
DI u32x4 pack8(const float* f) { u32x4 w; w.x = pk2(f[0], f[1]); w.y = pk2(f[2], f[3]); w.z = pk2(f[4], f[5]); w.w = pk2(f[6], f[7]); return w; }
DI u32x2 pack4(const f32x4 v) { u32x2 w; w.x = pk2(v[0], v[1]); w.y = pk2(v[2], v[3]); return w; }

DI void transpose_item(const float* W, int K, int Nsrc, int src_col0, bf16* WT, int dst_row0, int k0, LAS float* scr, int lane) {
#pragma unroll 8
    for (int i = 0; i < 32; ++i) { const int kk = 2 * i + (lane >> 5); scr[kk * 33 + (lane & 31)] = W[(size_t)(k0 + kk) * Nsrc + src_col0 + (lane & 31)]; }
    asm volatile("s_waitcnt lgkmcnt(0)" ::: "memory");
    const int c = lane & 7;
#pragma unroll
    for (int j = 0; j < 4; ++j) { const int n = (lane >> 3) + 8 * j; const LAS float* s = scr + (8 * c) * 33 + n;
        u32x4 o; o.x = pk2(s[0 * 33], s[1 * 33]); o.y = pk2(s[2 * 33], s[3 * 33]); o.z = pk2(s[4 * 33], s[5 * 33]); o.w = pk2(s[6 * 33], s[7 * 33]);
        *(u32x4*)(WT + (size_t)(dst_row0 + n) * K + k0 + 8 * c) = o; }
    asm volatile("s_waitcnt lgkmcnt(0)" ::: "memory");
}
DI void weight_prep(const float* const* in, unsigned char* ws, LAS unsigned char* lds, int gw, int ngw, int wave, int lane) {
    LAS float* scr = (LAS float*)(lds + wave * 16384);
    constexpr int I_IN = (DM / 64) * (NPROJ / 32), I_OUT = (DM / 64) * (DM / 32), I_GU = (DM / 64) * (2 * FF / 32), I_DN = (FF / 64) * (DM / 32);
    constexpr int PER_L = I_IN + I_OUT + I_GU + I_DN;
    for (int it = gw; it < DEPTH * PER_L; it += ngw) {
        const int l = it / PER_L; int r = it % PER_L;
        unsigned char* wl = ws + WS_W + (size_t)l * SZ_WL;
        if (r < I_IN) { const int nblk = NPROJ / 32, kb = r / nblk, nb = r % nblk, n0 = nb * 32;
            transpose_item(in[I_WIN] + (size_t)l * DM * IN_TOTAL, DM, IN_TOTAL, n0 < 4096 ? n0 : n0 + 12, (bf16*)wl, n0, kb * 64, scr, lane); continue; }
        r -= I_IN;
        if (r < I_OUT) { const int nblk = DM / 32, kb = r / nblk, nb = r % nblk, n0 = nb * 32;
            transpose_item(in[I_WOUT] + (size_t)l * DM * DM, DM, DM, n0, (bf16*)(wl + SZ_WIN), n0, kb * 64, scr, lane); continue; }
        r -= I_OUT;
        if (r < I_GU) { const int nblk = 2 * FF / 32, kb = r / nblk, nb = r % nblk, n0 = nb * 32, pn = n0 >> 8, j = n0 & 255;
            transpose_item(in[I_WGU] + (size_t)l * DM * 2 * FF, DM, 2 * FF, j < 128 ? 128 * pn + j : FF + 128 * pn + (j - 128), (bf16*)(wl + SZ_WIN + SZ_WOUT), n0, kb * 64, scr, lane); continue; }
        r -= I_GU;
        { const int nblk = DM / 32, kb = r / nblk, nb = r % nblk, n0 = nb * 32;
            transpose_item(in[I_WDN] + (size_t)l * FF * DM, FF, DM, n0, (bf16*)(wl + SZ_WIN + SZ_WOUT + SZ_WGU), n0, kb * 64, scr, lane); }
    }
}

DI void norm_phase(const float* x, const float* g, bf16* h, const float* w_in_l, float* bd, LAS unsigned char* lds, int gw, int ngw, int tid0, int lane0) {
    const int tid = opaque(tid0), lane = tid & 63; (void)lane0;
    LAS f32x4* wl = (LAS f32x4*)lds;
    if (w_in_l) {
        for (int k = tid; k < DM; k += NTHR) {
            const f32x4* src = (const f32x4*)(w_in_l + (size_t)k * IN_TOTAL + 4096);
            const f32x4 a = src[0], b = src[1], c = src[2];
            const int j = k >> 8, l = (k >> 2) & 63, e = k & 3;
            LAS float* dst = (LAS float*)lds + ((size_t)(j * 12) * 64 + l) * 4 + e;
            dst[0 * 256] = a[0]; dst[1 * 256] = a[1]; dst[2 * 256] = a[2]; dst[3 * 256] = a[3];
            dst[4 * 256] = b[0]; dst[5 * 256] = b[1]; dst[6 * 256] = b[2]; dst[7 * 256] = b[3];
            dst[8 * 256] = c[0]; dst[9 * 256] = c[1]; dst[10 * 256] = c[2]; dst[11 * 256] = c[3];
        }
        __syncthreads();
    }
    f32x4 gv[8];
#pragma unroll
    for (int j = 0; j < 8; ++j) gv[j] = ((const f32x4*)g)[64 * j + lane];
    for (int row = gw; row < M; row += ngw) {
        const f32x4* xr = (const f32x4*)(x + (size_t)row * DM) + lane;
        f32x4 v[8]; float s = 0.f;
#pragma unroll
        for (int j = 0; j < 8; ++j) { v[j] = xr[64 * j]; s += (v[j][0] * v[j][0] + v[j][1] * v[j][1]) + (v[j][2] * v[j][2] + v[j][3] * v[j][3]); }
        const float rs = 1.0f / sqrtf(wave_sum(s) * (1.0f / DM) + EPS);
        u32x2* o8 = (u32x2*)(h + (size_t)row * DM) + lane;
#pragma unroll
        for (int j = 0; j < 8; ++j) { v[j] = v[j] * rs * gv[j]; u32x2 w; w.x = pk2(v[j][0], v[j][1]); w.y = pk2(v[j][2], v[j][3]); o8[64 * j] = w; }
        if (w_in_l) {
            float outv = 0.f;
            asm volatile("" ::: "memory");
#pragma unroll 1
            for (int c = 0; c < 12; ++c) {
                float acc = 0.f;
#pragma unroll
                for (int j = 0; j < 8; ++j) { const f32x4 w = wl[(j * 12 + c) * 64 + lane]; acc += (v[j][0] * w[0] + v[j][1] * w[1]) + (v[j][2] * w[2] + v[j][3] * w[3]); }
                acc = wave_sum(acc);
                if (lane == c) outv = acc;
            }
            if (lane < 12) bd[(size_t)row * 12 + lane] = outv;
        }
    }
    if (w_in_l) __syncthreads();
}
#define XB_TMO      128
#define XB_XCNT(j)  (256  + 64 * (j))
#define XB_XSUB(j)  (1280 + 64 * (j))
#define XB_XGEN(j)  (2304 + 64 * (j))
#define XB_TOP      3328
#define XB_TOPGEN   3392
#define XCD_BAR_WORDS 3456
#define XB_SPIN_CAP (1u << 18)

__device__ __forceinline__ unsigned xb_ld(unsigned* p)              { return __hip_atomic_load(p, __ATOMIC_RELAXED, __HIP_MEMORY_SCOPE_AGENT); }
__device__ __forceinline__ unsigned xb_add(unsigned* p, unsigned v) { return __hip_atomic_fetch_add(p, v, __ATOMIC_RELAXED, __HIP_MEMORY_SCOPE_AGENT); }
__device__ __forceinline__ unsigned xb_xcc_id() { return (unsigned)__builtin_amdgcn_s_getreg((3 << 11) | 20) & 0xFu; }
#define XB_SPIN(cond, bar) do { unsigned _sp = 0; while (cond) { __builtin_amdgcn_s_sleep(1); \
    if ((++_sp & 255u) == 0u) { if (xb_ld(&(bar)[XB_TMO])) break; if (_sp > XB_SPIN_CAP) { atomicAdd(&(bar)[XB_TMO], 1u); break; } } } } while (0)

struct XcdBarrier {
    unsigned* bar; unsigned x;
    volatile LAS unsigned* st;
};

__device__ __forceinline__ XcdBarrier xcd_barrier_post(unsigned* bar, volatile LAS unsigned* st) {
    XcdBarrier b; b.bar = bar; b.x = xb_xcc_id(); b.st = st;
    if (threadIdx.x == 0) (void)xb_add(&bar[XB_XCNT(b.x)], 1u);
    return b;
}
__device__ __forceinline__ void xcd_barrier_complete(unsigned* bar, unsigned x, unsigned& nloc, unsigned& nx) {
    const unsigned G = gridDim.x * gridDim.y * gridDim.z;
    unsigned sum, cnt, mine, sp = 0u;
    for (;;) {
        sum = 0u; cnt = 0u; mine = 0u;
#pragma unroll
        for (unsigned j = 0; j < 16; ++j) { const unsigned c = xb_ld(&bar[XB_XCNT(j)]); sum += c; cnt += (c > 0u) ? 1u : 0u; mine = (j == x) ? c : mine; }
        if (sum == G) break;
        __builtin_amdgcn_s_sleep(1);
        if ((++sp & 255u) == 0u) { if (xb_ld(&bar[XB_TMO])) break; if (sp > XB_SPIN_CAP) { atomicAdd(&bar[XB_TMO], 1u); break; } }
    }
    nloc = mine > 0u ? mine : 1u; nx = cnt > 0u ? cnt : 1u;
}

__device__ __forceinline__ void xcd_barrier(const XcdBarrier& b) {
    asm volatile("s_waitcnt vmcnt(0)" ::: "memory");
    __syncthreads();
    if (threadIdx.x == 0) {
        unsigned* bar = b.bar;
        __builtin_amdgcn_s_waitcnt(0);
        unsigned nloc = b.st[0], nx = b.st[1];
        if (nloc == 0u) { xcd_barrier_complete(bar, b.x, nloc, nx); b.st[0] = nloc; b.st[1] = nx; }
        const unsigned old = xb_add(&bar[XB_XSUB(b.x)], 1u);
        const unsigned gen = old / nloc;
        if (old + 1u == (gen + 1u) * nloc) {
            __builtin_amdgcn_fence(__ATOMIC_RELEASE, "agent");
            asm volatile("s_waitcnt vmcnt(0)" ::: "memory");
            const unsigned og = xb_add(&bar[XB_TOP], 1u);
            const unsigned tg = og / nx;
            if (og + 1u == (tg + 1u) * nx) xb_add(&bar[XB_TOPGEN], 1u);
            else XB_SPIN(xb_ld(&bar[XB_TOPGEN]) == tg, bar);
            __builtin_amdgcn_fence(__ATOMIC_ACQUIRE, "agent");
            xb_add(&bar[XB_XGEN(b.x)], 1u);
            asm volatile("s_waitcnt vmcnt(0)" ::: "memory");
        } else {
            XB_SPIN(xb_ld(&bar[XB_XGEN(b.x)]) == gen, bar);
            __builtin_amdgcn_fence(__ATOMIC_ACQUIRE, "agent");
            asm volatile("s_waitcnt vmcnt(0)" ::: "memory");
        }
    }
    __syncthreads();
}
DI void sgu_item(int item, const bf16* proj, const float* sgu_g, const float* w_s, const float* b_s, bf16* mix, LAS unsigned char* lds, int tid0) {
    const int tid = opaque(tid0);
    const int g = item & 3, c = (item >> 2) & 15, b = item >> 6;
    const size_t row0 = (size_t)b * SEQ + c * 128;
    LAS unsigned char* Vimg = lds; LAS unsigned char* Wimg = lds + 128 * 272;
    {
        const int i = tid >> 2, p = tid & 3;
        const bf16* src = proj + (row0 + i) * NPROJ + C_AV + g * 128 + p * 32;
        float y[32]; float ss = 0.f;
#pragma unroll
        for (int e = 0; e < 4; ++e) { const u32x4 raw = *(const u32x4*)(src + 8 * e); unpack8(raw, y + 8 * e); }
#pragma unroll
        for (int e = 0; e < 32; ++e) { y[e] = gelu_tanh(y[e]); ss += y[e] * y[e]; }
        ss += __shfl_xor(ss, 1); ss += __shfl_xor(ss, 2);
        const float rs = 1.0f / sqrtf(ss * (1.0f / 128.0f) + EPS);
        const float* gg = sgu_g + g * 128 + p * 32;
#pragma unroll
        for (int e = 0; e < 4; ++e) { float t[8];
#pragma unroll
            for (int k = 0; k < 8; ++k) t[k] = y[8 * e + k] * rs * gg[8 * e + k];
            *(LAS u32x4*)(Vimg + i * 272 + p * 64 + e * 16) = pack8(t); }
        const float* wsrc = w_s + ((size_t)g * 128 + i) * 128 + p * 32;
#pragma unroll
        for (int e = 0; e < 4; ++e) { const f32x4 a = *(const f32x4*)(wsrc + 8 * e), bb = *(const f32x4*)(wsrc + 8 * e + 4); float t[8];
#pragma unroll
            for (int k = 0; k < 4; ++k) { t[k] = (p * 32 + 8 * e + k <= i) ? a[k] : 0.f; t[4 + k] = (p * 32 + 8 * e + 4 + k <= i) ? bb[k] : 0.f; }
            *(LAS u32x4*)(Wimg + i * 272 + p * 64 + e * 16) = pack8(t); }
    }
    __syncthreads();
    const int w = tid >> 6, lane = tid & 63, r = lane & 15, q = lane >> 4;
    f32x4 acc[8];
#pragma unroll
    for (int dt = 0; dt < 8; ++dt) acc[dt] = (f32x4){0.f, 0.f, 0.f, 0.f};
    const int nks = (16 * (w + 1) + 31) >> 5;
    for (int ks = 0; ks < nks; ++ks) {
        const bf16x8 bfr = ld_frag(Wimg + (16 * w + r) * 272 + (32 * ks + 8 * q) * 2);
#pragma unroll
        for (int dt = 0; dt < 8; ++dt) { const LAS unsigned char* p0 = Vimg + (32 * ks + 8 * q + (r >> 2)) * 272 + (16 * dt + 4 * (r & 3)) * 2;
            acc[dt] = mfma16(tr_frag(p0, p0 + 4 * 272), bfr, acc[dt]); }
    }
    const int i = 16 * w + r; const float bsv = b_s[g * 128 + i];
    const bf16* up = proj + (row0 + i) * NPROJ + C_AU + g * 128 + 4 * q;
    bf16* op = mix + (row0 + i) * DM + g * 128 + 4 * q;
#pragma unroll
    for (int dt = 0; dt < 8; ++dt) { const u32x2 uu = *(const u32x2*)(up + 16 * dt);
        f32x4 o; o[0] = gelu_tanh(bflo(uu.x)) * (acc[dt][0] + bsv); o[1] = gelu_tanh(bfhi(uu.x)) * (acc[dt][1] + bsv); o[2] = gelu_tanh(bflo(uu.y)) * (acc[dt][2] + bsv); o[3] = gelu_tanh(bfhi(uu.y)) * (acc[dt][3] + bsv);
        *(u32x2*)(op + 16 * dt) = pack4(o); }
    __syncthreads();
}

DI void attn_item(int item, const bf16* proj, const float* qg, const float* kg, bf16* obr, float* lse, LAS unsigned char* lds, int tid0) {
    const int tid = opaque(tid0);
    const int sub = item % 48, bh = item / 48, h = bh % NH, b = bh / NH;
    int br, rr, n;
    if (sub < 16) { br = 0; rr = 0; n = sub; } else if (sub < 32) { br = 1; rr = (sub - 16) >> 2; n = (sub - 16) & 3; } else { br = 2; rr = sub - 32; n = 0; }
    const int dil = 1 << (2 * br);
    LAS unsigned char* Kimg = lds; LAS unsigned char* Vimg = lds + 256 * 272;
    const bf16* base = proj + (size_t)b * SEQ * NPROJ + h * 128;
    {
        const int piece = tid & 15;
        float kgv[8];
#pragma unroll
        for (int e = 0; e < 8; ++e) kgv[e] = kg[piece * 8 + e];
#pragma unroll 2
        for (int i = 0; i < 8; ++i) {
            const int row = (tid >> 4) + 32 * i, L = (n - 1) * 128 + row;
            u32x4 kv = {0u, 0u, 0u, 0u}, vv = {0u, 0u, 0u, 0u};
            if (L >= 0) { const bf16* p = base + (size_t)(L * dil + rr) * NPROJ + piece * 8; kv = *(const u32x4*)(p + C_CK); vv = *(const u32x4*)(p + C_CV); }
            float kf[8]; unpack8(kv, kf); float ss = 0.f;
#pragma unroll
            for (int e = 0; e < 8; ++e) ss += kf[e] * kf[e];
            ss += __shfl_xor(ss, 1); ss += __shfl_xor(ss, 2); ss += __shfl_xor(ss, 4); ss += __shfl_xor(ss, 8);
            const float rs = 1.0f / sqrtf(ss * (1.0f / 128.0f) + EPS);
#pragma unroll
            for (int e = 0; e < 8; ++e) kf[e] = kf[e] * rs * kgv[e];
            *(LAS u32x4*)(Kimg + row * 272 + piece * 16) = pack8(kf);
            *(LAS u32x4*)(Vimg + row * 272 + piece * 16) = vv;
        }
    }
    const int w = tid >> 6, lane = tid & 63, r = lane & 15, q = lane >> 4;
    const int qi = 16 * w + r, tokq = (n * 128 + qi) * dil + rr;
    bf16x8 qf[4];
    {
        const bf16* qp = base + (size_t)tokq * NPROJ + C_CQ + 8 * q;
        float qv[32]; float ss = 0.f;
#pragma unroll
        for (int s = 0; s < 4; ++s) { const u32x4 raw = *(const u32x4*)(qp + 32 * s); unpack8(raw, qv + 8 * s); }
#pragma unroll
        for (int e = 0; e < 32; ++e) ss += qv[e] * qv[e];
        ss += __shfl_xor(ss, 16); ss += __shfl_xor(ss, 32);
        const float rs = (1.0f / sqrtf(ss * (1.0f / 128.0f) + EPS)) * (0.08838834764831845f * LOG2E);
#pragma unroll
        for (int s = 0; s < 4; ++s) { float t[8];
#pragma unroll
            for (int e = 0; e < 8; ++e) t[e] = qv[8 * s + e] * rs * qg[32 * s + 8 * q + e];
            qf[s] = __builtin_bit_cast(bf16x8, pack8(t)); }
    }
    __syncthreads();
    const int kt0 = 2 * (w >> 1);
    f32x4 sc[10];
#pragma unroll
    for (int t = 0; t < 10; ++t) { f32x4 a4 = {0.f, 0.f, 0.f, 0.f};
#pragma unroll
        for (int s = 0; s < 4; ++s) a4 = mfma16(ld_frag(Kimg + (16 * (kt0 + t) + r) * 272 + (32 * s + 8 * q) * 2), qf[s], a4);
        sc[t] = a4; }
    const float sl2 = exp2f(-8.0f * (float)(h + 1) / 6.0f) * (float)dil * LOG2E;
    float mx = -INFINITY;
#pragma unroll
    for (int t = 0; t < 10; ++t)
#pragma unroll
        for (int jj = 0; jj < 4; ++jj) { const int kj = 16 * (kt0 + t) + 4 * q + jj, delta = 128 + qi - kj;
            const bool valid = (delta >= 0) && (delta <= 128) && (n > 0 || kj >= 128);
            const float v = valid ? sc[t][jj] - sl2 * (float)delta : -INFINITY; sc[t][jj] = v; mx = fmaxf(mx, v); }
    mx = fmaxf(mx, __shfl_xor(mx, 16)); mx = fmaxf(mx, __shfl_xor(mx, 32));
    float l = 0.f;
#pragma unroll
    for (int t = 0; t < 10; ++t)
#pragma unroll
        for (int jj = 0; jj < 4; ++jj) { const float p = __builtin_amdgcn_exp2f(sc[t][jj] - mx); sc[t][jj] = p; l += p; }
    l += __shfl_xor(l, 16); l += __shfl_xor(l, 32);
    bf16x8 pf[5];
#pragma unroll
    for (int pp = 0; pp < 5; ++pp) { u32x4 wv; wv.x = pk2(sc[2 * pp][0], sc[2 * pp][1]); wv.y = pk2(sc[2 * pp][2], sc[2 * pp][3]); wv.z = pk2(sc[2 * pp + 1][0], sc[2 * pp + 1][1]); wv.w = pk2(sc[2 * pp + 1][2], sc[2 * pp + 1][3]);
        pf[pp] = __builtin_bit_cast(bf16x8, wv); }
    f32x4 o[8];
#pragma unroll
    for (int dt = 0; dt < 8; ++dt) o[dt] = (f32x4){0.f, 0.f, 0.f, 0.f};
#pragma unroll
    for (int pp = 0; pp < 5; ++pp)
#pragma unroll
        for (int dt = 0; dt < 8; ++dt) { const LAS unsigned char* p0 = Vimg + (16 * (kt0 + 2 * pp) + 4 * q + (r >> 2)) * 272 + (16 * dt + 4 * (r & 3)) * 2;
            o[dt] = mfma16(tr_frag(p0, p0 + 16 * 272), pf[pp], o[dt]); }
    const float inv = 1.0f / l;
    const size_t orow = (size_t)br * M + (size_t)b * SEQ + tokq;
    bf16* op = obr + orow * 768 + h * 128 + 4 * q;
#pragma unroll
    for (int dt = 0; dt < 8; ++dt) *(u32x2*)(op + 16 * dt) = pack4(o[dt] * inv);
    if (q == 0) lse[orow * 6 + h] = (mx + __builtin_amdgcn_logf(l)) * LN2;
    __syncthreads();
}
DI void attn_combine(const bf16* obr, const float* lse, bf16* mix, int gi0, int nthreads) {
    const int gi = opaque(gi0);
    constexpr int UN = 4;
    for (int idx0 = gi; idx0 < M * 96; idx0 += nthreads * UN) {
        float l[UN][3]; u32x4 raw[UN][3]; int row[UN], c8[UN];
#pragma unroll
        for (int u = 0; u < UN; ++u) { int idx = idx0 + u * nthreads; if (idx >= M * 96) idx = M * 96 - 1; row[u] = idx / 96; c8[u] = idx % 96; const int h = c8[u] >> 4;
#pragma unroll
            for (int br = 0; br < 3; ++br) { l[u][br] = lse[((size_t)br * M + row[u]) * 6 + h]; raw[u][br] = *(const u32x4*)(obr + ((size_t)br * M + row[u]) * 768 + c8[u] * 8); } }
#pragma unroll
        for (int u = 0; u < UN; ++u) {
            const float mx = fmaxf(l[u][0], fmaxf(l[u][1], l[u][2]));
            float w0 = __expf(l[u][0] - mx), w1 = __expf(l[u][1] - mx), w2 = __expf(l[u][2] - mx); const float inv = 1.0f / (w0 + w1 + w2); w0 *= inv; w1 *= inv; w2 *= inv;
            float a[8], bq[8], cc[8]; unpack8(raw[u][0], a); unpack8(raw[u][1], bq); unpack8(raw[u][2], cc);
#pragma unroll
            for (int e = 0; e < 8; ++e) a[e] = w0 * a[e] + w1 * bq[e] + w2 * cc[e];
            if (idx0 + u * nthreads < M * 96) *(u32x4*)(mix + (size_t)row[u] * DM + 1280 + c8[u] * 8) = pack8(a);
        }
    }
}
DI void dn_conv16(const bf16* proj, int b, int tpos, int col, const float* cw, float* y) {
    float acc[16];
#pragma unroll
    for (int e = 0; e < 16; ++e) acc[e] = 0.f;
#pragma unroll
    for (int j = 0; j < 4; ++j) { const int tt = tpos - 3 + j;
        u32x4 x0 = {0u, 0u, 0u, 0u}, x1 = {0u, 0u, 0u, 0u};
        if (tt >= 0) { const bf16* p = proj + ((size_t)b * SEQ + tt) * NPROJ + col; x0 = *(const u32x4*)p; x1 = *(const u32x4*)(p + 8); }
        float xf[16]; unpack8(x0, xf); unpack8(x1, xf + 8);
        const f32x4* wp = (const f32x4*)(cw + (size_t)j * 2304);
#pragma unroll
        for (int e4 = 0; e4 < 4; ++e4) { const f32x4 wv = wp[e4];
#pragma unroll
            for (int k = 0; k < 4; ++k) acc[4 * e4 + k] += wv[k] * xf[4 * e4 + k]; } }
#pragma unroll
    for (int e = 0; e < 16; ++e) y[e] = silu_f(acc[e]);
}
DI void dn_prep_item(int item, const bf16* proj, const float* bd, const float* conv_w, const float* a_log, const float* dt_bias, unsigned char* dnall, float* gl_out, LAS unsigned char* lds, int tid0) {
    const int tid = opaque(tid0);
    const int n = item & 31, bh = item >> 5, h = bh % NH, b = bh / NH, t0 = 64 * n;
    unsigned char* dn = dnall + (size_t)item * DN_STRIDE;
    LAS unsigned char* Kimg = lds; LAS unsigned char* Qimg = lds + 17408; LAS unsigned char* KBG = lds + 34816; LAS unsigned char* VB = lds + 52224;
    LAS unsigned char* Amat = lds + 69632; LAS unsigned char* Timg = lds + 87040; LAS float* G = (LAS float*)(lds + 96256); LAS float* BETA = (LAS float*)(lds + 96512);
    const int w = tid >> 6, lane = tid & 63, r = lane & 15, q = lane >> 4;
    if (w == 0) {
        const size_t row = (size_t)b * SEQ + t0 + lane;
        const float bl = bd[row * 12 + h], av = bd[row * 12 + 6 + h];
        const float xx = av + dt_bias[h];
        const float sp = xx > 20.f ? xx : log1pf(expf(xx));
        float gs = -expf(a_log[h]) * sp;
#pragma unroll
        for (int o = 1; o < 64; o <<= 1) { const float t = __shfl_up(gs, o); if (lane >= o) gs += t; }
        G[lane] = gs; BETA[lane] = 1.0f / (1.0f + expf(-bl));
    }
    __syncthreads();
    {
        const int i = tid >> 3, p = tid & 7;
        const float gi = G[i], bi = BETA[i], eg = expf(gi);
        float y[16];
        dn_conv16(proj, b, t0 + i, C_BQ + h * 128 + 16 * p, conv_w + h * 128 + 16 * p, y);
        { float ss = 0.f;
#pragma unroll
            for (int e = 0; e < 16; ++e) ss += y[e] * y[e];
            ss += __shfl_xor(ss, 1); ss += __shfl_xor(ss, 2); ss += __shfl_xor(ss, 4);
            const float rs = (1.0f / sqrtf(ss + EPS)) * 0.08838834764831845f;
            float t[16], tg[16];
#pragma unroll
            for (int e = 0; e < 16; ++e) { t[e] = y[e] * rs; tg[e] = t[e] * eg; }
            *(LAS u32x4*)(Qimg + i * 272 + p * 32) = pack8(t); *(LAS u32x4*)(Qimg + i * 272 + p * 32 + 16) = pack8(t + 8);
            *(u32x4*)(dn + DN_QG + (i * 128 + 16 * p) * 2) = pack8(tg); *(u32x4*)(dn + DN_QG + (i * 128 + 16 * p + 8) * 2) = pack8(tg + 8); }
        dn_conv16(proj, b, t0 + i, C_BK + h * 128 + 16 * p, conv_w + 768 + h * 128 + 16 * p, y);
        { float ss = 0.f;
#pragma unroll
            for (int e = 0; e < 16; ++e) ss += y[e] * y[e];
            ss += __shfl_xor(ss, 1); ss += __shfl_xor(ss, 2); ss += __shfl_xor(ss, 4);
            const float rs = 1.0f / sqrtf(ss + EPS);
            float t[16], tg[16];
#pragma unroll
            for (int e = 0; e < 16; ++e) { t[e] = y[e] * rs; tg[e] = t[e] * (bi * eg); }
            *(LAS u32x4*)(Kimg + i * 272 + p * 32) = pack8(t); *(LAS u32x4*)(Kimg + i * 272 + p * 32 + 16) = pack8(t + 8);
            *(LAS u32x4*)(KBG + i * 272 + p * 32) = pack8(tg); *(LAS u32x4*)(KBG + i * 272 + p * 32 + 16) = pack8(tg + 8); }
        dn_conv16(proj, b, t0 + i, C_BV + h * 128 + 16 * p, conv_w + 1536 + h * 128 + 16 * p, y);
        { float t[16];
#pragma unroll
            for (int e = 0; e < 16; ++e) t[e] = y[e] * bi;
            *(LAS u32x4*)(VB + i * 272 + p * 32) = pack8(t); *(LAS u32x4*)(VB + i * 272 + p * 32 + 16) = pack8(t + 8); }
    }
    __syncthreads();
    {
        const int it = w & 3;
        const int i = 16 * it + r; const float gi = G[i], bi = BETA[i];
#pragma unroll
        for (int e = 0; e < 2; ++e) { const int jt = 2 * (w >> 2) + e;
            f32x4 kk = {0.f, 0.f, 0.f, 0.f}, qk = {0.f, 0.f, 0.f, 0.f};
#pragma unroll
            for (int s = 0; s < 4; ++s) { const bf16x8 a = ld_frag(Kimg + (16 * jt + r) * 272 + (32 * s + 8 * q) * 2);
                kk = mfma16(a, ld_frag(Kimg + (16 * it + r) * 272 + (32 * s + 8 * q) * 2), kk);
                qk = mfma16(a, ld_frag(Qimg + (16 * it + r) * 272 + (32 * s + 8 * q) * 2), qk); }
            f32x4 av, at;
#pragma unroll
            for (int jj = 0; jj < 4; ++jj) { const int j = 16 * jt + 4 * q + jj; const float dec = (j <= i) ? expf(gi - G[j]) : 0.f;
                av[jj] = (j < i) ? bi * kk[jj] * dec : 0.f; at[jj] = qk[jj] * dec; }
            *(LAS f32x4*)(Amat + i * 272 + (16 * jt + 4 * q) * 4) = av;
            *(u32x2*)(dn + DN_ATT + (i * 64 + 16 * jt + 4 * q) * 2) = pack4(at); }
    }
    __syncthreads();
    LAS unsigned char* A21img = lds + 96768; LAS unsigned char* Ximg = lds + 99328;
    if (w == 0) {
        const int hb = lane >> 5, c = lane & 31;
        unsigned abv = (unsigned)(size_t)(Amat + hb * (32 * 272 + 32 * 4));
        float N[32];
#pragma unroll
        for (int i = 0; i < 32; ++i) {
            const LAS unsigned char* ab = (const LAS unsigned char*)(size_t)abv;
            float s0 = *(const LAS float*)(ab + i * 272 + c * 4), s1 = 0.f, s2 = 0.f, s3 = 0.f;
#pragma unroll
            for (int j4 = 0; j4 < (i + 3) / 4; ++j4) { const f32x4 a4 = *(const LAS f32x4*)(ab + i * 272 + j4 * 16);
                if (4 * j4 + 0 < i) s0 += a4[0] * N[4 * j4 + 0];
                if (4 * j4 + 1 < i) s1 += a4[1] * N[4 * j4 + 1];
                if (4 * j4 + 2 < i) s2 += a4[2] * N[4 * j4 + 2];
                if (4 * j4 + 3 < i) s3 += a4[3] * N[4 * j4 + 3]; }
            N[i] = -((s0 + s1) + (s2 + s3));
            if (i & 1) asm volatile("" : "+v"(abv) : "v"(N[i]));
        }
        LAS unsigned char* tb = Timg + (32 * hb) * 144 + (32 * hb + c) * 2;
#pragma unroll
        for (int i = 0; i < 32; i += 2) { const unsigned pr = pk2(N[i], N[i + 1]);
            *(LAS unsigned short*)(tb + i * 144) = (unsigned short)(pr & 0xffffu);
            *(LAS unsigned short*)(tb + (i + 1) * 144) = (unsigned short)(pr >> 16); }
        asm volatile("s_waitcnt lgkmcnt(0)" ::: "memory");
        *(LAS unsigned short*)(tb + c * 144) = (unsigned short)0x3F80u;
    } else if (w == 1) {
        const int i = lane >> 1, hf = lane & 1;
        *(LAS u32x4*)(Timg + i * 144 + 64 + hf * 32) = (u32x4){0u, 0u, 0u, 0u}; *(LAS u32x4*)(Timg + i * 144 + 64 + hf * 32 + 16) = (u32x4){0u, 0u, 0u, 0u};
    } else if (w < 4) {
        const int t = (w - 2) * 64 + lane, i = t >> 2, j0 = (t & 3) * 8;
        const f32x4 a = *(const LAS f32x4*)(Amat + (32 + i) * 272 + j0 * 4), bb = *(const LAS f32x4*)(Amat + (32 + i) * 272 + j0 * 4 + 16);
        u32x4 o; o.x = pk2(a[0], a[1]); o.y = pk2(a[2], a[3]); o.z = pk2(bb[0], bb[1]); o.w = pk2(bb[2], bb[3]);
        *(LAS u32x4*)(A21img + i * 80 + j0 * 2) = o;
    }
    __syncthreads();
    if (w < 4) {
        const int it = w >> 1, ctile = w & 1;
        const LAS unsigned char* p0 = Timg + (8 * q + (r >> 2)) * 144 + (16 * ctile + 4 * (r & 3)) * 2;
        const f32x4 x = mfma16(tr_frag(p0, p0 + 4 * 144), ld_frag(A21img + (16 * it + r) * 80 + 16 * q), (f32x4){0.f, 0.f, 0.f, 0.f});
        *(LAS u32x2*)(Ximg + (16 * it + r) * 80 + (16 * ctile + 4 * q) * 2) = pack4(x);
    }
    __syncthreads();
    if (w < 4) {
        const int it = w >> 1, ctile = w & 1;
        const LAS unsigned char* p0 = Ximg + (8 * q + (r >> 2)) * 80 + (16 * ctile + 4 * (r & 3)) * 2;
        const f32x4 y = mfma16(tr_frag(p0, p0 + 4 * 80), ld_frag(Timg + (32 + 16 * it + r) * 144 + (32 + 8 * q) * 2), (f32x4){0.f, 0.f, 0.f, 0.f});
        *(LAS u32x2*)(Timg + (32 + 16 * it + r) * 144 + (16 * ctile + 4 * q) * 2) = pack4(-y);
    }
    __syncthreads();
    {
        const int ct = w & 3; const float glast = G[63];
        bf16x8 tf[2];
#pragma unroll
        for (int ks = 0; ks < 2; ++ks) tf[ks] = ld_frag(Timg + (16 * ct + r) * 144 + (32 * ks + 8 * q) * 2);
        float dk4[4];
#pragma unroll
        for (int jj = 0; jj < 4; ++jj) dk4[jj] = expf(glast - G[16 * ct + 4 * q + jj]);
#pragma unroll
        for (int e = 0; e < 4; ++e) { const int dt = 4 * (w >> 2) + e;
            f32x4 au = {0.f, 0.f, 0.f, 0.f}, aw = {0.f, 0.f, 0.f, 0.f};
#pragma unroll
            for (int ks = 0; ks < 2; ++ks) { const int ro = (32 * ks + 8 * q + (r >> 2)) * 272 + (16 * dt + 4 * (r & 3)) * 2;
                au = mfma16(tf[ks], tr_frag(VB + ro, VB + ro + 4 * 272), au);
                aw = mfma16(tr_frag(KBG + ro, KBG + ro + 4 * 272), tf[ks], aw); }
            *(u32x2*)(dn + DN_UT + ((16 * dt + r) * 64 + 16 * ct + 4 * q) * 2) = pack4(au);
            *(u32x2*)(dn + DN_WK + ((16 * ct + r) * 128 + 16 * dt + 4 * q) * 2) = pack4(aw);
            const s16x4 kv = tr4(Kimg + (16 * ct + 4 * q + (r >> 2)) * 272 + (16 * dt + 4 * (r & 3)) * 2);
            f32x4 kd;
#pragma unroll
            for (int jj = 0; jj < 4; ++jj) kd[jj] = __uint_as_float(((unsigned)(unsigned short)kv[jj]) << 16) * dk4[jj];
            *(u32x2*)(dn + DN_KDT + ((16 * dt + r) * 64 + 16 * ct + 4 * q) * 2) = pack4(kd); }
        if (tid == 0) gl_out[item] = expf(glast);
    }
    __syncthreads();
}
struct ScanOps { bf16x8 wf[4], qf[4], af[2]; u32x2 uu[2]; float g; };
DI void scan_load(ScanOps& o, const unsigned char* dn, const float* gl, int ci, int ct, int dvs, int dvt0, int nt0, int r, int q) {
#pragma unroll
    for (int ks = 0; ks < 4; ++ks) { o.wf[ks] = *(const bf16x8*)(dn + DN_WK + ((16 * ct + r) * 128 + 32 * ks + 8 * q) * 2); o.qf[ks] = *(const bf16x8*)(dn + DN_QG + ((16 * ct + r) * 128 + 32 * ks + 8 * q) * 2); }
#pragma unroll
    for (int e = 0; e < 2; ++e) o.uu[e] = *(const u32x2*)(dn + DN_UT + ((dvs * 64 + 16 * (dvt0 + e) + r) * 64 + 16 * ct + 4 * q) * 2);
#pragma unroll
    for (int ks = 0; ks < 2; ++ks) o.af[ks] = *(const bf16x8*)(dn + DN_ATT + ((16 * ct + r) * 64 + 32 * ks + 8 * q) * 2);
    o.g = gl[ci];
}
DI void scan_step(const ScanOps& c, const unsigned char* dn, f32x4 (&Sacc)[4], float* op, LAS unsigned char* Simg, LAS unsigned char* VNT, int ct, int dvt0, int mt, int nt0, int r, int q) {
    f32x4 wsa[2], qsa[2];
    bf16x8 kf[4][2];
#pragma unroll
    for (int e = 0; e < 4; ++e)
#pragma unroll
        for (int ks = 0; ks < 2; ++ks) kf[e][ks] = *(const bf16x8*)(dn + DN_KDT + ((16 * (nt0 + e) + r) * 64 + 32 * ks + 8 * q) * 2);
#pragma unroll
    for (int e = 0; e < 2; ++e) { wsa[e] = (f32x4){0.f, 0.f, 0.f, 0.f}; qsa[e] = (f32x4){0.f, 0.f, 0.f, 0.f}; }
#pragma unroll
    for (int ks = 0; ks < 4; ++ks)
#pragma unroll
        for (int e = 0; e < 2; ++e) { const LAS unsigned char* p0 = Simg + (32 * ks + 8 * q + (r >> 2)) * 144 + (16 * (dvt0 + e) + 4 * (r & 3)) * 2;
            const bf16x8 sf = tr_frag(p0, p0 + 4 * 144);
            wsa[e] = mfma16(c.wf[ks], sf, wsa[e]); qsa[e] = mfma16(c.qf[ks], sf, qsa[e]); }
#pragma unroll
    for (int e = 0; e < 2; ++e) { const int dv = 16 * (dvt0 + e) + r; const u32x2 uu = c.uu[e];
        f32x4 vn; vn[0] = bflo(uu.x) - wsa[e][0]; vn[1] = bfhi(uu.x) - wsa[e][1]; vn[2] = bflo(uu.y) - wsa[e][2]; vn[3] = bfhi(uu.y) - wsa[e][3];
        *(LAS u32x2*)(VNT + dv * 144 + (16 * ct + 4 * q) * 2) = pack4(vn); }
    lds_barrier();
#pragma unroll
    for (int ks = 0; ks < 2; ++ks)
#pragma unroll
        for (int e = 0; e < 2; ++e) qsa[e] = mfma16(c.af[ks], ld_frag(VNT + (16 * (dvt0 + e) + r) * 144 + (32 * ks + 8 * q) * 2), qsa[e]);
#pragma unroll
    for (int e = 0; e < 2; ++e)
#pragma unroll
        for (int jj = 0; jj < 4; ++jj) op[(size_t)jj * 768 + 16 * (dvt0 + e)] = qsa[e][jj];
    bf16x8 af2[2];
#pragma unroll
    for (int ks = 0; ks < 2; ++ks) af2[ks] = ld_frag(VNT + (16 * mt + r) * 144 + (32 * ks + 8 * q) * 2);
#pragma unroll
    for (int e = 0; e < 4; ++e) { Sacc[e] = Sacc[e] * c.g;
#pragma unroll
        for (int ks = 0; ks < 2; ++ks) Sacc[e] = mfma16(af2[ks], kf[e][ks], Sacc[e]);
        *(LAS u32x2*)(Simg + (16 * (nt0 + e) + r) * 144 + (16 * mt + 4 * q) * 2) = pack4(Sacc[e]); }
    lds_barrier();
}
DI void dn_scan_item(int item, const unsigned char* dnall, const float* gl, float* odn, LAS unsigned char* lds, int tid0) {
    const int tid = opaque(tid0);
    const int dvs = item & 1, bh = item >> 1, h = bh % NH, b = bh / NH;
    LAS unsigned char* Simg = lds; LAS unsigned char* VNT = lds + 18432;
    for (int u = tid; u < 18432 / 16; u += NTHR) *(LAS u32x4*)(Simg + u * 16) = (u32x4){0u, 0u, 0u, 0u};
    const int w = tid >> 6, lane = tid & 63, r = lane & 15, q = lane >> 4;
    const int ct = w >> 1, dvt0 = 2 * (w & 1), mt = w & 3, nt0 = 4 * (w >> 2);
    f32x4 Sacc[4];
#pragma unroll
    for (int e = 0; e < 4; ++e) Sacc[e] = (f32x4){0.f, 0.f, 0.f, 0.f};
    const unsigned char* dn0 = dnall + (size_t)(bh * 32) * DN_STRIDE;
    float* op0 = odn + ((size_t)b * SEQ + 16 * ct + 4 * q) * 768 + h * 128 + dvs * 64 + r;
    ScanOps A, B;
    scan_load(A, dn0, gl, bh * 32, ct, dvs, dvt0, nt0, r, q);
    __syncthreads();
#pragma unroll 1
    for (int n = 0; n < 32; n += 2) {
        scan_load(B, dn0 + (size_t)(n + 1) * DN_STRIDE, gl, bh * 32 + n + 1, ct, dvs, dvt0, nt0, r, q);
        scan_step(A, dn0 + (size_t)n * DN_STRIDE, Sacc, op0 + (size_t)(64 * n) * 768, Simg, VNT, ct, dvt0, mt, nt0, r, q);
        const int n2 = (n + 2 < 32) ? n + 2 : 31;
        scan_load(A, dn0 + (size_t)n2 * DN_STRIDE, gl, bh * 32 + n2, ct, dvs, dvt0, nt0, r, q);
        scan_step(B, dn0 + (size_t)(n + 1) * DN_STRIDE, Sacc, op0 + (size_t)(64 * (n + 1)) * 768, Simg, VNT, ct, dvt0, mt, nt0, r, q);
    }
}
DI void dn_gate_phase(const float* odn, const bf16* proj, const float* ong, bf16* mix, int gw, int ngw, int lane0) {
    const int lane = opaque(lane0);
    const int sub = lane >> 4, l16 = lane & 15;
    float gv[8];
#pragma unroll
    for (int e = 0; e < 8; ++e) gv[e] = ong[l16 * 8 + e];
    constexpr int UN = 4, NIT = M * NH / 4;
    for (int it0 = gw; it0 < NIT; it0 += ngw * UN) {
        f32x4 o0[UN], o1[UN]; u32x4 graw[UN]; int row[UN], hh[UN];
#pragma unroll
        for (int u = 0; u < UN; ++u) { int it = it0 + u * ngw; if (it >= NIT) it = NIT - 1; const int idx = it * 4 + sub; row[u] = idx / NH; hh[u] = idx % NH;
            const float* op = odn + (size_t)row[u] * 768 + hh[u] * 128 + l16 * 8; o0[u] = *(const f32x4*)op; o1[u] = *(const f32x4*)(op + 4);
            graw[u] = *(const u32x4*)(proj + (size_t)row[u] * NPROJ + C_BG + hh[u] * 128 + l16 * 8); }
#pragma unroll
        for (int u = 0; u < UN; ++u) {
            float ss = (o0[u][0] * o0[u][0] + o0[u][1] * o0[u][1]) + (o0[u][2] * o0[u][2] + o0[u][3] * o0[u][3]) + (o1[u][0] * o1[u][0] + o1[u][1] * o1[u][1]) + (o1[u][2] * o1[u][2] + o1[u][3] * o1[u][3]);
            ss += __shfl_xor(ss, 1); ss += __shfl_xor(ss, 2); ss += __shfl_xor(ss, 4); ss += __shfl_xor(ss, 8);
            const float rs = 1.0f / sqrtf(ss * (1.0f / 128.0f) + EPS);
            float gt[8]; unpack8(graw[u], gt);
            float y[8];
#pragma unroll
            for (int e = 0; e < 4; ++e) { y[e] = o0[u][e] * rs * gv[e] * silu_f(gt[e]); y[4 + e] = o1[u][e] * rs * gv[4 + e] * silu_f(gt[4 + e]); }
            if (it0 + u * ngw < NIT) *(u32x4*)(mix + (size_t)row[u] * DM + 512 + hh[u] * 128 + l16 * 8) = pack8(y);
        }
    }
}

struct Args { const float* in[16]; float* out; unsigned char* ws; };
#ifndef MK_SKIP_MIX
#define MK_SKIP_MIX 0
#endif
#ifndef REP_M1
#define REP_M1 1
#endif
#ifndef REP_M2
#define REP_M2 1
#endif
#ifndef REP_G13
#define REP_G13 1
#endif
__global__ void __launch_bounds__(NTHR, 2) hybrid_fwd(Args a) {
    extern __shared__ __attribute__((aligned(16))) unsigned char lds_raw[];
    LAS unsigned char* lds = (LAS unsigned char*)lds_raw;
    cg::grid_group grid = cg::this_grid();
    volatile LAS unsigned* bst = (volatile LAS unsigned*)(lds + LDS_BYTES - 64);
    if (threadIdx.x < 2) bst[threadIdx.x] = 0u;
    __syncthreads();
    const XcdBarrier xbar = xcd_barrier_post((unsigned*)(a.ws + WS_CTL), bst);
    const int tid = threadIdx.x, lane = tid & 63, wave = __builtin_amdgcn_readfirstlane(tid >> 6);
    const int G = gridDim.x, bx = blockIdx.x, gw = bx * 8 + wave, ngw = G * 8;
    unsigned char* ws = a.ws;
    bf16* Hb = (bf16*)(ws + WS_H); bf16* PROJ = (bf16*)(ws + WS_PROJ); float* BD = (float*)(ws + WS_BD); unsigned char* DN = ws + WS_DN; float* GL = (float*)(ws + WS_GL);
    float* ODN = (float*)(ws + WS_ODN); bf16* OBR = (bf16*)(ws + WS_OBR); float* LSE = (float*)(ws + WS_LSE);
    bf16* MIX = Hb; bf16* ACT = PROJ;

#ifdef EXTRA_SYNCS
    for (int es = 0; es < EXTRA_SYNCS; ++es) xcd_barrier(xbar);
#endif
    weight_prep(a.in, ws, lds, gw, ngw, wave, lane);
    __syncthreads();
    norm_phase(a.in[I_X], a.in[I_N1G], Hb, a.in[I_WIN], BD, lds, gw, ngw, tid, lane);
    grid.sync();
#ifndef REP_MASK
#define REP_MASK 0
#endif
    bool rep_done = false;
#pragma unroll 1
    for (int s = 1; s < DEPTH * 9; ++s) {
        const int l = s / 9, ph = s - 9 * l;
        const unsigned char* wl = ws + WS_W + (size_t)l * SZ_WL;
        if (ph == 0) {
            norm_phase(a.out, a.in[I_N1G] + (size_t)l * DM, Hb, a.in[I_WIN] + (size_t)l * DM * IN_TOTAL, BD, lds, gw, ngw, tid, lane);
        } else if (ph == 1) {
            pg8::Gemm g{Hb, (const bf16*)wl, M, NPROJ, DM}; pg8::StaticOrder S; S.init(M, NPROJ, G, bx);
            pg8::EpiBf16<0> E{PROJ, NPROJ, nullptr, 0, 0, 1.f};
            pg8::gemm_phase<pg8::EpiBf16<0>, pg8::StaticOrder, true, true>(lds, g, S, E);
        } else if (ph == 2) {
#ifndef M1_REP_TYPE
#define M1_REP_TYPE -1
#endif
            for (int it = bx; it < 2304 + 1536 + 512; it += G)
            for (int rr = 0; rr < (((it < 2304) ? 0 : (it < 3840) ? 1 : 2) == M1_REP_TYPE ? 2 : 1); ++rr) {
                if (it < 2304) attn_item(it, PROJ, a.in[I_QNG] + l * HD, a.in[I_KNG] + l * HD, OBR, LSE, lds, tid);
                else if (it < 2304 + 1536) dn_prep_item(it - 2304, PROJ, BD, a.in[I_CONVW] + (size_t)l * 4 * 2304, a.in[I_ALOG] + l * NH, a.in[I_DTB] + l * NH, DN, GL, lds, tid);
                else sgu_item(it - 3840, PROJ, a.in[I_SGUG] + l * 512, a.in[I_WS] + (size_t)l * 4 * 128 * 128, a.in[I_BS] + l * 512, MIX, lds, tid);
            }
        } else if (ph == 3) {
            if (G > NSCAN) {
                if (bx < NSCAN) dn_scan_item(bx, DN, GL, ODN, lds, tid);
                else attn_combine(OBR, LSE, MIX, (bx - NSCAN) * NTHR + tid, (G - NSCAN) * NTHR);
            } else {
                for (int it = bx; it < NSCAN; it += G) { dn_scan_item(it, DN, GL, ODN, lds, tid); __syncthreads(); }
                attn_combine(OBR, LSE, MIX, bx * NTHR + tid, G * NTHR);
            }
        } else if (ph == 4) {
            dn_gate_phase(ODN, PROJ, a.in[I_ONG] + l * HD, MIX, gw, ngw, lane);
        } else if (ph == 5) {
            pg8::Gemm g{MIX, (const bf16*)(wl + SZ_WIN), M, DM, DM}; pg8::StaticOrder S; S.init(M, DM, G, bx);
            pg8::EpiResF32 E{(l == 0) ? a.in[I_X] : a.out, a.out, DM};
            pg8::gemm_phase<pg8::EpiResF32, pg8::StaticOrder, true, true>(lds, g, S, E);
        } else if (ph == 6) {
            norm_phase(a.out, a.in[I_N2G] + (size_t)l * DM, Hb, nullptr, nullptr, lds, gw, ngw, tid, lane);
        } else if (ph == 7) {
            pg8::Gemm g{Hb, (const bf16*)(wl + SZ_WIN + SZ_WOUT), M, 2 * FF, DM}; pg8::StaticOrder S; S.init(M, 2 * FF, G, bx);
            pg8::EpiSwiGLU E{ACT, FF};
            pg8::gemm_phase<pg8::EpiSwiGLU, pg8::StaticOrder, true, true>(lds, g, S, E);
        } else {
            pg8::Gemm g{ACT, (const bf16*)(wl + SZ_WIN + SZ_WOUT + SZ_WGU), M, DM, FF}; pg8::StaticOrder S; S.init(M, DM, G, bx);
            pg8::EpiResF32 E{a.out, a.out, DM};
            pg8::gemm_phase<pg8::EpiResF32, pg8::StaticOrder, true, true>(lds, g, S, E);
        }
        if (s + 1 < DEPTH * 9) xcd_barrier(xbar);
        if (REP_MASK) { if (((REP_MASK >> ph) & 1) && !rep_done) { --s; rep_done = true; } else rep_done = false; }
    }
}

extern "C" void kernel_launch(void* const* d_in, const int* in_sizes, int n_in, void* d_out, int out_size, void* d_ws, size_t ws_size, hipStream_t stream) {
    static int grid = 0;
    if (grid == 0) {
        if (n_in != 16 || in_sizes[0] != M * DM || out_size != M * DM || ws_size < WS_END) { fprintf(stderr, "kernel_launch: unexpected shapes / workspace (n_in %d, ws %zu, need %zu); nothing launched\n", n_in, ws_size, (size_t)WS_END); grid = -1; return; }
        int dev = 0, cus = 0, per_cu = 0;
        if (hipGetDevice(&dev) != hipSuccess || hipDeviceGetAttribute(&cus, hipDeviceAttributeMultiprocessorCount, dev) != hipSuccess) { grid = -1; return; }
        if (hipFuncSetAttribute((const void*)hybrid_fwd, hipFuncAttributeMaxDynamicSharedMemorySize, LDS_BYTES) != hipSuccess) { fprintf(stderr, "kernel_launch: hipFuncSetAttribute failed\n"); grid = -1; return; }
        if (hipOccupancyMaxActiveBlocksPerMultiprocessor(&per_cu, (const void*)hybrid_fwd, NTHR, LDS_BYTES) != hipSuccess || per_cu < 1) { fprintf(stderr, "kernel_launch: occupancy query says %d blocks per CU\n", per_cu); per_cu = 1; }
        (void)hipGetLastError();
        grid = cus;
    }
    if (grid < 0) return;
    if (hipMemsetAsync((char*)d_ws + WS_CTL, 0, CTL_BYTES, stream) != hipSuccess) { fprintf(stderr, "kernel_launch: memset of the barrier words failed\n"); return; }
    Args a{};
    for (int i = 0; i < 16; ++i) a.in[i] = (const float*)d_in[i];
    a.out = (float*)d_out; a.ws = (unsigned char*)d_ws;
    void* args[] = {&a};
    hipError_t e = hipLaunchCooperativeKernel((const void*)hybrid_fwd, dim3(grid), dim3(NTHR), args, LDS_BYTES, stream);
    if (e != hipSuccess) fprintf(stderr, "kernel_launch: cooperative launch failed: %s (grid %d)\n", hipGetErrorString(e), grid);
}
```

```cpp
#include <hip/hip_runtime.h>
#include <hip/hip_cooperative_groups.h>
#include <cstdio>
#include <cstdint>
namespace cg = cooperative_groups;
namespace pg8 {
#define PG8_LAS __attribute__((address_space(3)))
typedef unsigned short bf16_t;
typedef short bf16x8 __attribute__((ext_vector_type(8)));
typedef float f32x4 __attribute__((ext_vector_type(4)));
typedef unsigned u32x4 __attribute__((ext_vector_type(4)));
constexpr int BM = 256, BK = 64, HALF = 128, HTB = HALF * BK * 2  , STAGE_BYTES = 8 * HTB, NXCD = 8, WGM = 8;

__host__ __device__ __forceinline__ int lds_byte(int r, int c) { const int st = (r >> 4) * 2 + (c >> 5), rr = r & 15, cc = c & 31, ob = rr * 64 + cc * 2; return st * 1024 + (ob ^ (((ob >> 9) & 1) << 5)); }
__host__ __device__ __forceinline__ void stage_rc(int b, int& R, int& C) { const int st = b / 1024, sb = b % 1024, swz = sb ^ (((sb >> 9) & 1) << 5); R = (st >> 1) * 16 + swz / 64; C = (st & 1) * 32 + (swz % 64) / 2; }
__host__ __device__ __forceinline__ int perm32(int rho) { const int n = rho >> 4, i = rho & 15; return 8 * (i >> 2) + 4 * n + (i & 3); }

struct Unit { int pm, pn; };
struct Gemm { const bf16_t* A; const bf16_t* Bt; int M, N, K; };

struct StaticOrder {
    int nM, nN, nwg, G, c;
    __host__ __device__ void init(int M, int N, int G_, int c_) { nM = M / BM; nN = N / BM; nwg = nM * nN; G = G_; c = c_; }
    __host__ __device__ bool next(int i, Unit& u) const {
        const long L = (long)i * G + c; if (L >= nwg) return false;
        int wgid = (int)L; { const int q = nwg / NXCD, r = nwg % NXCD, xcd = wgid % NXCD, off = wgid / NXCD; wgid = (xcd < r ? xcd * (q + 1) : r * (q + 1) + (xcd - r) * q) + off; }
        const int nig = WGM * nN, gid = wgid / nig, fm = gid * WGM, gsz = (nM - fm) < WGM ? (nM - fm) : WGM;
        u.pm = fm + ((wgid % nig) % gsz); u.pn = (wgid % nig) / gsz; return true;
    }
    __device__ __forceinline__ void a_ready(const Unit&) const {}
    __device__ __forceinline__ void done(const Unit&) const {}
};

__device__ __forceinline__ unsigned cvt_pk_bf16(float lo, float hi) { unsigned r; asm volatile("v_cvt_pk_bf16_f32 %0, %1, %2" : "=v"(r) : "v"(lo), "v"(hi)); return r; }
typedef float f32x2 __attribute__((ext_vector_type(2)));
__device__ __forceinline__ f32x2 gelu_pk(f32x2 v) {
    const f32x2 av = __builtin_elementwise_abs(v), d = av * 0.2316418882f + 1.0f;
    f32x2 t; t.x = __builtin_amdgcn_rcpf(d.x); t.y = __builtin_amdgcn_rcpf(d.y);
    f32x2 q = t * 0.5307027145f + (-0.7265760135f); q = q * t + 0.7107068705f; q = q * t + (-0.142248368f); q = q * t + 0.127414796f; q = q * t;
    const f32x2 s = (v * v) * (-0.72134752044f);
    f32x2 e; e.x = __builtin_amdgcn_exp2f(s.x); e.y = __builtin_amdgcn_exp2f(s.y);
    const f32x2 m = v * (q * e), r = v - m;
    f32x2 o; o.x = v.x < 0.f ? m.x : r.x; o.y = v.y < 0.f ? m.y : r.y; return o;
}

template <int ACT  > struct EpiBf16 {
    static constexpr bool PERM = true, AFTER_DRAIN = false; static_assert(ACT == 0 || ACT == 1, "EpiBf16: ACT is 0 (none) or 1 (gelu_pk)");
    bf16_t* O; int ldc; const float* bias; int split_cols; size_t split_stride; float scale0;
    __device__ __forceinline__ void operator()(const f32x4 (&acc)[2][2][4][2], const Unit& u, int wr, int wc, int fr, int fq) const {
        const int row0 = u.pm * BM + wr * 64 + fr; int colt = u.pn * BM; bf16_t* base = O;
        float sc = 1.f; if (split_cols) { const int t = colt / split_cols; base += (size_t)t * split_stride; colt -= t * split_cols; if (t == 0) sc = scale0; }
        const int col0 = colt + wc * 32 + 8 * fq, bcol0 = u.pn * BM + wc * 32 + 8 * fq;
        f32x4 bv[2][2];
#pragma unroll
        for (int bj = 0; bj < 2; ++bj)
#pragma unroll
            for (int n = 0; n < 2; ++n) bv[bj][n] = bias ? *(const f32x4*)(bias + bcol0 + bj * HALF + 4 * n) : (f32x4){0.f, 0.f, 0.f, 0.f};
#pragma unroll
        for (int ai = 0; ai < 2; ++ai)
#pragma unroll
            for (int m = 0; m < 4; ++m) { bf16_t* rowp = base + (size_t)(row0 + ai * HALF + m * 16) * ldc + col0;
#pragma unroll
                for (int bj = 0; bj < 2; ++bj) { f32x4 v0 = acc[ai][bj][m][0] + bv[bj][0], v1 = acc[ai][bj][m][1] + bv[bj][1];
                    if (ACT == 1) { f32x2 a = gelu_pk((f32x2){v0[0], v0[1]}), b = gelu_pk((f32x2){v0[2], v0[3]}), c = gelu_pk((f32x2){v1[0], v1[1]}), d = gelu_pk((f32x2){v1[2], v1[3]});
                        v0 = (f32x4){a.x, a.y, b.x, b.y}; v1 = (f32x4){c.x, c.y, d.x, d.y}; }
                    v0 = v0 * sc; v1 = v1 * sc; u32x4 w; w.x = cvt_pk_bf16(v0[0], v0[1]); w.y = cvt_pk_bf16(v0[2], v0[3]); w.z = cvt_pk_bf16(v1[0], v1[1]); w.w = cvt_pk_bf16(v1[2], v1[3]);
                    *(u32x4*)(rowp + bj * HALF) = w; } }
    }
};
struct EpiResF32 {
    static constexpr bool PERM = false, AFTER_DRAIN = false;
    const float* base; float* out; int ldc;
    __device__ __forceinline__ void operator()(const f32x4 (&acc)[2][2][4][2], const Unit& u, int wr, int wc, int fr, int fq) const {
        const int row0 = u.pm * BM + wr * 64 + fr; const int col0 = u.pn * BM + wc * 32 + 4 * fq;
#pragma unroll
        for (int ai = 0; ai < 2; ++ai)
#pragma unroll
            for (int m = 0; m < 4; ++m) { const size_t off = (size_t)(row0 + ai * HALF + m * 16) * ldc + col0;
#pragma unroll
                for (int bj = 0; bj < 2; ++bj)
#pragma unroll
                    for (int n = 0; n < 2; ++n) { const f32x4 b = *(const f32x4*)(base + off + bj * HALF + n * 16); *(f32x4*)(out + off + bj * HALF + n * 16) = b + acc[ai][bj][m][n]; } }
    }
};
__device__ __forceinline__ float silu_f(float g) { return g * __builtin_amdgcn_rcpf(1.0f + __expf(-g)); }
struct EpiSwiGLU {
    static constexpr bool PERM = true, AFTER_DRAIN = false;
    bf16_t* O; int ldo;
    __device__ __forceinline__ void operator()(const f32x4 (&acc)[2][2][4][2], const Unit& u, int wr, int wc, int fr, int fq) const {
        const int row0 = u.pm * BM + wr * 64 + fr; const int col0 = u.pn * HALF + wc * 32 + 8 * fq;
#pragma unroll
        for (int ai = 0; ai < 2; ++ai)
#pragma unroll
            for (int m = 0; m < 4; ++m) { bf16_t* rowp = O + (size_t)(row0 + ai * HALF + m * 16) * ldo + col0;
                const f32x4 g0 = acc[ai][0][m][0], g1 = acc[ai][0][m][1], u0 = acc[ai][1][m][0], u1 = acc[ai][1][m][1];
                u32x4 w; w.x = cvt_pk_bf16(silu_f(g0[0]) * u0[0], silu_f(g0[1]) * u0[1]); w.y = cvt_pk_bf16(silu_f(g0[2]) * u0[2], silu_f(g0[3]) * u0[3]);
                w.z = cvt_pk_bf16(silu_f(g1[0]) * u1[0], silu_f(g1[1]) * u1[1]); w.w = cvt_pk_bf16(silu_f(g1[2]) * u1[2], silu_f(g1[3]) * u1[3]);
                *(u32x4*)rowp = w; }
    }
};
template <class Epi, class Sched, bool ALIGN_EPI = false, bool SP2 = false>
__device__ __forceinline__ void gemm_phase(PG8_LAS unsigned char* lds, const Gemm g, const Sched& S, const Epi& E) {
    int tid_ = threadIdx.x; asm volatile("" : "+v"(tid_)); const int tid = tid_, wid = __builtin_amdgcn_readfirstlane(tid >> 6), lane = tid & 63, wr = wid >> 2, wc = wid & 3, fr = lane & 15, fq = lane >> 4;
    const int K = g.K, nt = K / BK;
    unsigned voffA[2], voffB[2];
#pragma unroll
    for (int i = 0; i < 2; ++i) { int R, C; stage_rc(tid * 16 + i * 8192, R, C); const int Rb = Epi::PERM ? ((R & ~31) + perm32(R & 31)) : R;
        voffA[i] = (unsigned)(R * K + C) * 2u; voffB[i] = (unsigned)(Rb * K + C) * 2u; }
    const size_t kstep = (size_t)(BK * 2);
    const size_t hstep = (size_t)HALF * K * 2;
    const size_t tstep = 2 * hstep;
    const unsigned ldsw = (unsigned)wid * 1024u;
    const int aoff = lds_byte(wr * 64 + fr, fq * 8), boff = lds_byte(wc * 32 + fr, fq * 8);
#define PG8_SA(b, h) (((b) * 2 + (h)) * HTB)
#define PG8_SB(b, h) ((4 + (b) * 2 + (h)) * HTB)
#define PG8_STAGE(bufoff, gbase, voff) do { _Pragma("unroll") for (int _i = 0; _i < 2; ++_i) \
        __builtin_amdgcn_global_load_lds((const unsigned*)((const char*)(gbase) + (voff)[_i]), (PG8_LAS unsigned*)(lds + (bufoff) + ldsw + _i * 8192), 16, 0, 0); } while (0)
#define PG8_LDA(dst, b, h) do { _Pragma("unroll") for (int m = 0; m < 4; ++m) _Pragma("unroll") for (int k = 0; k < 2; ++k) dst[m][k] = *(const PG8_LAS bf16x8*)(lds + PG8_SA(b, h) + aoff + m * 2048 + k * 1024); } while (0)
#define PG8_LDB(dst, b, h) do { _Pragma("unroll") for (int n = 0; n < 2; ++n) _Pragma("unroll") for (int k = 0; k < 2; ++k) dst[n][k] = *(const PG8_LAS bf16x8*)(lds + PG8_SB(b, h) + boff + n * 2048 + k * 1024); } while (0)
#define PG8_MMA(ai, bj, At, Bt) do { __builtin_amdgcn_s_setprio(1); _Pragma("unroll") for (int m = 0; m < 4; ++m) _Pragma("unroll") for (int n = 0; n < 2; ++n) _Pragma("unroll") for (int k = 0; k < 2; ++k) \
        acc[ai][bj][m][n] = __builtin_amdgcn_mfma_f32_16x16x32_bf16(Bt[n][k], At[m][k], acc[ai][bj][m][n], 0, 0, 0); __builtin_amdgcn_s_setprio(0); } while (0)
#define PG8_WAIT_V(n) asm volatile("s_waitcnt vmcnt(" #n ")" ::: "memory")
#define PG8_WAIT_L(n) asm volatile("s_waitcnt lgkmcnt(" #n ")" ::: "memory")
#define PG8_BAR __builtin_amdgcn_s_barrier()
#define PG8_SCHED __builtin_amdgcn_sched_barrier(0)
    Unit cur, nxt; int ui = 0;
    if (!S.next(0, cur)) return;
    f32x4 acc[2][2][4][2];
#pragma unroll
    for (int a = 0; a < 2; ++a)
#pragma unroll
        for (int b = 0; b < 2; ++b)
#pragma unroll
            for (int m = 0; m < 4; ++m)
#pragma unroll
                for (int n = 0; n < 2; ++n) acc[a][b][m][n] = (f32x4){0.f, 0.f, 0.f, 0.f};
    bf16x8 At[4][2], B0[2][2], B1[2][2];
    const char* cA = (const char*)g.A + (size_t)cur.pm * tstep; const char* cB = (const char*)g.Bt + (size_t)cur.pn * tstep;
    S.a_ready(cur);
    if constexpr (SP2) {
        PG8_STAGE(PG8_SB(0, 0), cB, voffB); PG8_STAGE(PG8_SB(0, 1), cB + hstep, voffB); PG8_STAGE(PG8_SA(0, 0), cA, voffA); PG8_STAGE(PG8_SA(0, 1), cA + hstep, voffA);
        if (wr == 1) PG8_BAR;
        PG8_WAIT_V(2); PG8_BAR;
        PG8_STAGE(PG8_SB(1, 0), cB + kstep, voffB); PG8_STAGE(PG8_SA(1, 0), cA + kstep, voffA); PG8_STAGE(PG8_SB(1, 1), cB + hstep + kstep, voffB);
        PG8_WAIT_V(6); PG8_BAR;
    } else {
        PG8_STAGE(PG8_SB(0, 0), cB, voffB); PG8_STAGE(PG8_SA(0, 0), cA, voffA); PG8_STAGE(PG8_SB(0, 1), cB + hstep, voffB); PG8_STAGE(PG8_SA(0, 1), cA + hstep, voffA);
        if (wr == 1) PG8_BAR;
        PG8_WAIT_V(4); PG8_BAR;
        PG8_STAGE(PG8_SB(1, 0), cB + kstep, voffB); PG8_STAGE(PG8_SA(1, 0), cA + kstep, voffA); PG8_STAGE(PG8_SB(1, 1), cB + hstep + kstep, voffB);
        PG8_WAIT_V(6); PG8_BAR;
    }
    for (;;) {
        const bool has_next = S.next(ui + 1, nxt);
        const char* nA = has_next ? (const char*)g.A + (size_t)nxt.pm * tstep : cA; const char* nB = has_next ? (const char*)g.Bt + (size_t)nxt.pn * tstep : cB;
        for (int t = 0; t < nt; t += 2) {
            const bool last = (t == nt - 2);
            const char* a1 = cA + (size_t)(t + 1) * kstep;
            const char* a2 = last ? nA : cA + (size_t)(t + 2) * kstep; const char* b2 = last ? nB : cB + (size_t)(t + 2) * kstep;
            const char* a3 = a2 + kstep; const char* b3 = b2 + kstep;
            if (last && has_next) S.a_ready(nxt);
            if constexpr (SP2) {
            PG8_LDB(B0, 0, 0); PG8_LDB(B1, 0, 1); PG8_SCHED; PG8_LDA(At, 0, 0); PG8_STAGE(PG8_SA(1, 1), a1 + hstep, voffA);
            PG8_WAIT_V(8); PG8_WAIT_L(0); PG8_BAR; PG8_MMA(0, 0, At, B0); PG8_MMA(0, 1, At, B1); PG8_BAR; PG8_SCHED;
            PG8_LDA(At, 0, 1); PG8_STAGE(PG8_SB(0, 0), b2, voffB); PG8_STAGE(PG8_SB(0, 1), b2 + hstep, voffB); PG8_STAGE(PG8_SA(0, 0), a2, voffA);
            PG8_WAIT_V(8); PG8_WAIT_L(0); PG8_BAR; PG8_MMA(1, 0, At, B0); PG8_MMA(1, 1, At, B1); PG8_BAR; PG8_SCHED;
            PG8_LDB(B0, 1, 0); PG8_LDB(B1, 1, 1); PG8_SCHED; PG8_LDA(At, 1, 0); PG8_STAGE(PG8_SA(0, 1), a2 + hstep, voffA);
            PG8_WAIT_V(8); PG8_WAIT_L(0); PG8_BAR; PG8_MMA(0, 0, At, B0); PG8_MMA(0, 1, At, B1); PG8_BAR; PG8_SCHED;
            PG8_LDA(At, 1, 1); PG8_STAGE(PG8_SB(1, 0), b3, voffB); PG8_STAGE(PG8_SB(1, 1), b3 + hstep, voffB); PG8_STAGE(PG8_SA(1, 0), a3, voffA);
            PG8_WAIT_V(8); PG8_WAIT_L(0); PG8_BAR; PG8_MMA(1, 0, At, B0); PG8_MMA(1, 1, At, B1); PG8_BAR; PG8_SCHED;
            } else {
            PG8_LDB(B0, 0, 0); PG8_SCHED; PG8_LDA(At, 0, 0); PG8_STAGE(PG8_SA(1, 1), a1 + hstep, voffA);
            PG8_WAIT_L(8); PG8_BAR; PG8_WAIT_L(0); PG8_MMA(0, 0, At, B0); PG8_BAR; PG8_SCHED;
            PG8_LDB(B1, 0, 1); PG8_STAGE(PG8_SB(0, 0), b2, voffB);
            PG8_BAR; PG8_WAIT_L(0); PG8_MMA(0, 1, At, B1); PG8_BAR;
            PG8_LDA(At, 0, 1); PG8_STAGE(PG8_SA(0, 0), a2, voffA);
            PG8_BAR; PG8_WAIT_L(0); PG8_MMA(1, 0, At, B0); PG8_BAR; PG8_SCHED;
            PG8_STAGE(PG8_SB(0, 1), b2 + hstep, voffB);
            PG8_WAIT_V(6); PG8_BAR; PG8_MMA(1, 1, At, B1); PG8_BAR;
            PG8_LDB(B0, 1, 0); PG8_SCHED; PG8_LDA(At, 1, 0); PG8_STAGE(PG8_SA(0, 1), a2 + hstep, voffA);
            PG8_WAIT_L(8); PG8_BAR; PG8_WAIT_L(0); PG8_MMA(0, 0, At, B0); PG8_BAR; PG8_SCHED;
            PG8_LDB(B1, 1, 1); PG8_STAGE(PG8_SB(1, 0), b3, voffB);
            PG8_BAR; PG8_WAIT_L(0); PG8_MMA(0, 1, At, B1); PG8_BAR;
            PG8_LDA(At, 1, 1); PG8_STAGE(PG8_SA(1, 0), a3, voffA);
            PG8_BAR; PG8_WAIT_L(0); PG8_MMA(1, 0, At, B0); PG8_BAR; PG8_SCHED;
            PG8_STAGE(PG8_SB(1, 1), b3 + hstep, voffB);
            PG8_WAIT_V(6); PG8_BAR; PG8_MMA(1, 1, At, B1); PG8_BAR;
            }
        }
        if constexpr (ALIGN_EPI) { if (wr == 0) PG8_BAR; }
        if constexpr (!Epi::AFTER_DRAIN) { E(acc, cur, wr, wc, fr, fq); S.done(cur); }
        if (!has_next) break;
#pragma unroll
        for (int a = 0; a < 2; ++a)
#pragma unroll
            for (int b = 0; b < 2; ++b)
#pragma unroll
                for (int m = 0; m < 4; ++m)
#pragma unroll
                    for (int n = 0; n < 2; ++n) acc[a][b][m][n] = (f32x4){0.f, 0.f, 0.f, 0.f};
        cur = nxt; cA = nA; cB = nB; ++ui;
        if constexpr (ALIGN_EPI) { if (wr == 1) PG8_BAR; }
    }
    PG8_WAIT_V(0);
    if constexpr (!ALIGN_EPI) { if (wr == 0) PG8_BAR; }
    PG8_BAR;
    if constexpr (Epi::AFTER_DRAIN) { E.fused(acc, cur, wr, wc, fr, fq, lds, wid, lane); S.done(cur); }
#undef PG8_SA
#undef PG8_SB
#undef PG8_STAGE
#undef PG8_LDA
#undef PG8_LDB
#undef PG8_MMA
#undef PG8_WAIT_V
#undef PG8_WAIT_L
#undef PG8_BAR
#undef PG8_SCHED
}
}
#define DI __device__ __forceinline__
#define LAS __attribute__((address_space(3)))
typedef unsigned short bf16;
typedef short bf16x8 __attribute__((ext_vector_type(8)));
typedef short s16x4 __attribute__((ext_vector_type(4)));
typedef short v4i16_t __attribute__((ext_vector_type(4)));
typedef float f32x4 __attribute__((ext_vector_type(4)));
typedef float f32x2 __attribute__((ext_vector_type(2)));
typedef unsigned u32x4 __attribute__((ext_vector_type(4)));
typedef unsigned u32x2 __attribute__((ext_vector_type(2)));
typedef __bf16 bf16x2_t __attribute__((ext_vector_type(2)));

constexpr int NB = 8, SEQ = 2048, DM = 2048, M = NB * SEQ, DEPTH = 2, HD = 128, NH = 6;
constexpr int NPROJ = 6400, IN_TOTAL = 6412, FF = 5632;
constexpr int C_AU = 0, C_AV = 512, C_BQ = 1024, C_BK = 1792, C_BV = 2560, C_BG = 3328, C_CQ = 4096, C_CK = 4864, C_CV = 5632;
constexpr float EPS = 1e-6f, LOG2E = 1.4426950408889634f, LN2 = 0.6931471805599453f;
enum { I_X = 0, I_N1G, I_WIN, I_SGUG, I_WS, I_BS, I_CONVW, I_ALOG, I_DTB, I_ONG, I_QNG, I_KNG, I_WOUT, I_N2G, I_WGU, I_WDN };

constexpr size_t SZ_WIN = (size_t)NPROJ * DM * 2, SZ_WOUT = (size_t)DM * DM * 2, SZ_WGU = (size_t)2 * FF * DM * 2, SZ_WDN = (size_t)DM * FF * 2;
constexpr size_t SZ_WL = SZ_WIN + SZ_WOUT + SZ_WGU + SZ_WDN;
constexpr size_t WS_W = 0;
constexpr size_t WS_H = WS_W + DEPTH * SZ_WL;
constexpr size_t WS_PROJ = WS_H + (size_t)M * DM * 2;
constexpr size_t WS_BD = WS_PROJ + (size_t)M * NPROJ * 2;
constexpr size_t WS_DN = WS_BD + (size_t)M * 12 * 4;
constexpr int NCHUNK = NB * NH * 32;
constexpr size_t DN_WK = 0, DN_QG = 16384, DN_KDT = 32768, DN_UT = 49152, DN_ATT = 65536, DN_STRIDE = 73728;
constexpr size_t WS_GL = WS_DN + (size_t)NCHUNK * DN_STRIDE;
constexpr size_t WS_ODN = WS_GL + 8192;
constexpr size_t WS_OBR = WS_ODN + (size_t)M * 768 * 4;
constexpr size_t WS_LSE = WS_OBR + (size_t)3 * M * 768 * 2;
constexpr size_t WS_CTL = WS_LSE + (size_t)3 * M * 6 * 4;
constexpr size_t CTL_BYTES = 16384;
constexpr size_t WS_END = WS_CTL + CTL_BYTES;
constexpr int LDS_BYTES = 143360;
constexpr int NTHR = 512;
constexpr int NSCAN = 192;

DI unsigned pk2(float lo, float hi) { f32x2 v = {lo, hi}; bf16x2_t b = __builtin_convertvector(v, bf16x2_t); return __builtin_bit_cast(unsigned, b); }
DI float bflo(unsigned w) { return __uint_as_float(w << 16); }
DI float bfhi(unsigned w) { return __uint_as_float(w & 0xffff0000u); }
DI f32x4 mfma16(bf16x8 a, bf16x8 b, f32x4 c) { return __builtin_amdgcn_mfma_f32_16x16x32_bf16(a, b, c, 0, 0, 0); }
DI s16x4 tr4(const LAS unsigned char* p) { return __builtin_bit_cast(s16x4, __builtin_amdgcn_ds_read_tr16_b64_v4i16((LAS v4i16_t*)p)); }
DI bf16x8 tr_frag(const LAS unsigned char* p0, const LAS unsigned char* p1) { const s16x4 lo = tr4(p0), hi = tr4(p1); return __builtin_shufflevector(lo, hi, 0, 1, 2, 3, 4, 5, 6, 7); }
DI bf16x8 ld_frag(const LAS unsigned char* p) { return *(const LAS bf16x8*)p; }
DI void lds_barrier() { asm volatile("s_waitcnt lgkmcnt(0)" ::: "memory"); __builtin_amdgcn_s_barrier(); asm volatile("" ::: "memory"); }
DI int opaque(int x) { asm volatile("" : "+v"(x)); return x; }
DI float wave_sum(float v) {
#pragma unroll
    for (int o = 1; o < 64; o <<= 1) v += __shfl_xor(v, o);
    return v;
}
DI float sigmoid_f(float x) { return __builtin_amdgcn_rcpf(1.0f + __expf(-x)); }
DI float silu_f(float x) { return x * sigmoid_f(x); }
DI float gelu_tanh(float x) { const float u = 0.7978845608028654f * (x + 0.044715f * x * x * x); return x * sigmoid_f(2.0f * u); }
DI void unpack8(const u32x4 w, float* f) { f[0] = bflo(w.x); f[1] = bfhi(w.x); f[2] = bflo(w.y); f[3] = bfhi(w.y); f[4] = bflo(w.z); f[5] = bfhi(w.z); f[6] = bflo(w.w); f[7] = bfhi(w.w); }
DI u32x4 pack8(const float* f) { u32x4 w; w.x = pk2(f[0], f[1]); w.y = pk2(f[2], f[3]); w.z = pk2(f[4], f[5]); w.w = pk2(f[6], f[7]); return w; }
DI u32x2 pack4(const f32x4 v) { u32x2 w; w.x = pk2(v[0], v[1]); w.y = pk2(v[2], v[3]); return w; }

DI void transpose_item(const float* W, int K, int Nsrc, int src_col0, bf16* WT, int dst_row0, int k0, LAS float* scr, int lane) {
#pragma unroll 8
    for (int i = 0; i < 32; ++i) { const int kk = 2 * i + (lane >> 5); scr[kk * 33 + (lane & 31)] = W[(size_t)(k0 + kk) * Nsrc + src_col0 + (lane & 31)]; }
    asm volatile("s_waitcnt lgkmcnt(0)" ::: "memory");
    const int c = lane & 7;
#pragma unroll
    for (int j = 0; j < 4; ++j) { const int n = (lane >> 3) + 8 * j; const LAS float* s = scr + (8 * c) * 33 + n;
        u32x4 o; o.x = pk2(s[0 * 33], s[1 * 33]); o.y = pk2(s[2 * 33], s[3 * 33]); o.z = pk2(s[4 * 33], s[5 * 33]); o.w = pk2(s[6 * 33], s[7 * 33]);
        *(u32x4*)(WT + (size_t)(dst_row0 + n) * K + k0 + 8 * c) = o; }
    asm volatile("s_waitcnt lgkmcnt(0)" ::: "memory");
}
DI void weight_prep(const float* const* in, unsigned char* ws, LAS unsigned char* lds, int gw, int ngw, int wave, int lane) {
    LAS float* scr = (LAS float*)(lds + wave * 16384);
    constexpr int I_IN = (DM / 64) * (NPROJ / 32), I_OUT = (DM / 64) * (DM / 32), I_GU = (DM / 64) * (2 * FF / 32), I_DN = (FF / 64) * (DM / 32);
    constexpr int PER_L = I_IN + I_OUT + I_GU + I_DN;
    for (int it = gw; it < DEPTH * PER_L; it += ngw) {
        const int l = it / PER_L; int r = it % PER_L;
        unsigned char* wl = ws + WS_W + (size_t)l * SZ_WL;
        if (r < I_IN) { const int nblk = NPROJ / 32, kb = r / nblk, nb = r % nblk, n0 = nb * 32;
            transpose_item(in[I_WIN] + (size_t)l * DM * IN_TOTAL, DM, IN_TOTAL, n0 < 4096 ? n0 : n0 + 12, (bf16*)wl, n0, kb * 64, scr, lane); continue; }
        r -= I_IN;
        if (r < I_OUT) { const int nblk = DM / 32, kb = r / nblk, nb = r % nblk, n0 = nb * 32;
            transpose_item(in[I_WOUT] + (size_t)l * DM * DM, DM, DM, n0, (bf16*)(wl + SZ_WIN), n0, kb * 64, scr, lane); continue; }
        r -= I_OUT;
        if (r < I_GU) { const int nblk = 2 * FF / 32, kb = r / nblk, nb = r % nblk, n0 = nb * 32, pn = n0 >> 8, j = n0 & 255;
            transpose_item(in[I_WGU] + (size_t)l * DM * 2 * FF, DM, 2 * FF, j < 128 ? 128 * pn + j : FF + 128 * pn + (j - 128), (bf16*)(wl + SZ_WIN + SZ_WOUT), n0, kb * 64, scr, lane); continue; }
        r -= I_GU;
        { const int nblk = DM / 32, kb = r / nblk, nb = r % nblk, n0 = nb * 32;
            transpose_item(in[I_WDN] + (size_t)l * FF * DM, FF, DM, n0, (bf16*)(wl + SZ_WIN + SZ_WOUT + SZ_WGU), n0, kb * 64, scr, lane); }
    }
}

DI void norm_phase(const float* x, const float* g, bf16* h, const float* w_in_l, float* bd, LAS unsigned char* lds, int gw, int ngw, int tid0, int lane0) {
    const int tid = opaque(tid0), lane = tid & 63; (void)lane0;
    LAS f32x4* wl = (LAS f32x4*)lds;
    if (w_in_l) {
        for (int k = tid; k < DM; k += NTHR) {
            const f32x4* src = (const f32x4*)(w_in_l + (size_t)k * IN_TOTAL + 4096);
            const f32x4 a = src[0], b = src[1], c = src[2];
            const int j = k >> 8, l = (k >> 2) & 63, e = k & 3;
            LAS float* dst = (LAS float*)lds + ((size_t)(j * 12) * 64 + l) * 4 + e;
            dst[0 * 256] = a[0]; dst[1 * 256] = a[1]; dst[2 * 256] = a[2]; dst[3 * 256] = a[3];
            dst[4 * 256] = b[0]; dst[5 * 256] = b[1]; dst[6 * 256] = b[2]; dst[7 * 256] = b[3];
            dst[8 * 256] = c[0]; dst[9 * 256] = c[1]; dst[10 * 256] = c[2]; dst[11 * 256] = c[3];
        }
        __syncthreads();
    }
    f32x4 gv[8];
#pragma unroll
    for (int j = 0; j < 8; ++j) gv[j] = ((const f32x4*)g)[64 * j + lane];
    for (int row = gw; row < M; row += ngw) {
        const f32x4* xr = (const f32x4*)(x + (size_t)row * DM) + lane;
        f32x4 v[8]; float s = 0.f;
#pragma unroll
        for (int j = 0; j < 8; ++j) { v[j] = xr[64 * j]; s += (v[j][0] * v[j][0] + v[j][1] * v[j][1]) + (v[j][2] * v[j][2] + v[j][3] * v[j][3]); }
        const float rs = 1.0f / sqrtf(wave_sum(s) * (1.0f / DM) + EPS);
        u32x2* o8 = (u32x2*)(h + (size_t)row * DM) + lane;
#pragma unroll
        for (int j = 0; j < 8; ++j) { v[j] = v[j] * rs * gv[j]; u32x2 w; w.x = pk2(v[j][0], v[j][1]); w.y = pk2(v[j][2], v[j][3]); o8[64 * j] = w; }
        if (w_in_l) {
            float outv = 0.f;
            asm volatile("" ::: "memory");
#pragma unroll 1
            for (int c = 0; c < 12; ++c) {
                float acc = 0.f;
#pragma unroll
                for (int j = 0; j < 8; ++j) { const f32x4 w = wl[(j * 12 + c) * 64 + lane]; acc += (v[j][0] * w[0] + v[j][1] * w[1]) + (v[j][2] * w[2] + v[j][3] * w[3]); }
                acc = wave_sum(acc);
                if (lane == c) outv = acc;
            }
            if (lane < 12) bd[(size_t)row * 12 + lane] = outv;
        }
    }
    if (w_in_l) __syncthreads();
}
#define XB_TMO      128
#define XB_XCNT(j)  (256  + 64 * (j))
#define XB_XSUB(j)  (1280 + 64 * (j))
#define XB_XGEN(j)  (2304 + 64 * (j))
#define XB_TOP      3328
#define XB_TOPGEN   3392
#define XCD_BAR_WORDS 3456
#define XB_SPIN_CAP (1u << 18)

__device__ __forceinline__ unsigned xb_ld(unsigned* p)              { return __hip_atomic_load(p, __ATOMIC_RELAXED, __HIP_MEMORY_SCOPE_AGENT); }
__device__ __forceinline__ unsigned xb_add(unsigned* p, unsigned v) { return __hip_atomic_fetch_add(p, v, __ATOMIC_RELAXED, __HIP_MEMORY_SCOPE_AGENT); }
__device__ __forceinline__ unsigned xb_xcc_id() { return (unsigned)__builtin_amdgcn_s_getreg((3 << 11) | 20) & 0xFu; }
#define XB_SPIN(cond, bar) do { unsigned _sp = 0; while (cond) { __builtin_amdgcn_s_sleep(1); \
    if ((++_sp & 255u) == 0u) { if (xb_ld(&(bar)[XB_TMO])) break; if (_sp > XB_SPIN_CAP) { atomicAdd(&(bar)[XB_TMO], 1u); break; } } } } while (0)

struct XcdBarrier {
    unsigned* bar; unsigned x;
    volatile LAS unsigned* st;
};

__device__ __forceinline__ XcdBarrier xcd_barrier_post(unsigned* bar, volatile LAS unsigned* st) {
    XcdBarrier b; b.bar = bar; b.x = xb_xcc_id(); b.st = st;
    if (threadIdx.x == 0) (void)xb_add(&bar[XB_XCNT(b.x)], 1u);
    return b;
}
__device__ __forceinline__ void xcd_barrier_complete(unsigned* bar, unsigned x, unsigned& nloc, unsigned& nx) {
    const unsigned G = gridDim.x * gridDim.y * gridDim.z;
    unsigned sum, cnt, mine, sp = 0u;
    for (;;) {
        sum = 0u; cnt = 0u; mine = 0u;
#pragma unroll
        for (unsigned j = 0; j < 16; ++j) { const unsigned c = xb_ld(&bar[XB_XCNT(j)]); sum += c; cnt += (c > 0u) ? 1u : 0u; mine = (j == x) ? c : mine; }
        if (sum == G) break;
        __builtin_amdgcn_s_sleep(1);
        if ((++sp & 255u) == 0u) { if (xb_ld(&bar[XB_TMO])) break; if (sp > XB_SPIN_CAP) { atomicAdd(&bar[XB_TMO], 1u); break; } }
    }
    nloc = mine > 0u ? mine : 1u; nx = cnt > 0u ? cnt : 1u;
}

__device__ __forceinline__ void xcd_barrier(const XcdBarrier& b) {
    asm volatile("s_waitcnt vmcnt(0)" ::: "memory");
    __syncthreads();
    if (threadIdx.x == 0) {
        unsigned* bar = b.bar;
        __builtin_amdgcn_s_waitcnt(0);
        unsigned nloc = b.st[0], nx = b.st[1];
        if (nloc == 0u) { xcd_barrier_complete(bar, b.x, nloc, nx); b.st[0] = nloc; b.st[1] = nx; }
        const unsigned old = xb_add(&bar[XB_XSUB(b.x)], 1u);
        const unsigned gen = old / nloc;
        if (old + 1u == (gen + 1u) * nloc) {
            __builtin_amdgcn_fence(__ATOMIC_RELEASE, "agent");
            asm volatile("s_waitcnt vmcnt(0)" ::: "memory");
            const unsigned og = xb_add(&bar[XB_TOP], 1u);
            const unsigned tg = og / nx;
            if (og + 1u == (tg + 1u) * nx) xb_add(&bar[XB_TOPGEN], 1u);
            else XB_SPIN(xb_ld(&bar[XB_TOPGEN]) == tg, bar);
            __builtin_amdgcn_fence(__ATOMIC_ACQUIRE, "agent");
            xb_add(&bar[XB_XGEN(b.x)], 1u);
            asm volatile("s_waitcnt vmcnt(0)" ::: "memory");
        } else {
            XB_SPIN(xb_ld(&bar[XB_XGEN(b.x)]) == gen, bar);
            __builtin_amdgcn_fence(__ATOMIC_ACQUIRE, "agent");
            asm volatile("s_waitcnt vmcnt(0)" ::: "memory");
        }
    }
    __syncthreads();
}
DI void sgu_item(int item, const bf16* proj, const float* sgu_g, const float* w_s, const float* b_s, bf16* mix, LAS unsigned char* lds, int tid0) {
    const int tid = opaque(tid0);
    const int g = item & 3, c = (item >> 2) & 15, b = item >> 6;
    const size_t row0 = (size_t)b * SEQ + c * 128;
    LAS unsigned char* Vimg = lds; LAS unsigned char* Wimg = lds + 128 * 272;
    {
        const int i = tid >> 2, p = tid & 3;
        const bf16* src = proj + (row0 + i) * NPROJ + C_AV + g * 128 + p * 32;
        float y[32]; float ss = 0.f;
#pragma unroll
        for (int e = 0; e < 4; ++e) { const u32x4 raw = *(const u32x4*)(src + 8 * e); unpack8(raw, y + 8 * e); }
#pragma unroll
        for (int e = 0; e < 32; ++e) { y[e] = gelu_tanh(y[e]); ss += y[e] * y[e]; }
        ss += __shfl_xor(ss, 1); ss += __shfl_xor(ss, 2);
        const float rs = 1.0f / sqrtf(ss * (1.0f / 128.0f) + EPS);
        const float* gg = sgu_g + g * 128 + p * 32;
#pragma unroll
        for (int e = 0; e < 4; ++e) { float t[8];
#pragma unroll
            for (int k = 0; k < 8; ++k) t[k] = y[8 * e + k] * rs * gg[8 * e + k];
            *(LAS u32x4*)(Vimg + i * 272 + p * 64 + e * 16) = pack8(t); }
        const float* wsrc = w_s + ((size_t)g * 128 + i) * 128 + p * 32;
#pragma unroll
        for (int e = 0; e < 4; ++e) { const f32x4 a = *(const f32x4*)(wsrc + 8 * e), bb = *(const f32x4*)(wsrc + 8 * e + 4); float t[8];
#pragma unroll
            for (int k = 0; k < 4; ++k) { t[k] = (p * 32 + 8 * e + k <= i) ? a[k] : 0.f; t[4 + k] = (p * 32 + 8 * e + 4 + k <= i) ? bb[k] : 0.f; }
            *(LAS u32x4*)(Wimg + i * 272 + p * 64 + e * 16) = pack8(t); }
    }
    __syncthreads();
    const int w = tid >> 6, lane = tid & 63, r = lane & 15, q = lane >> 4;
    f32x4 acc[8];
#pragma unroll
    for (int dt = 0; dt < 8; ++dt) acc[dt] = (f32x4){0.f, 0.f, 0.f, 0.f};
    const int i = 16 * w + r; const float bsv = b_s[g * 128 + i];
    const bf16* up = proj + (row0 + i) * NPROJ + C_AU + g * 128 + 4 * q;
    u32x2 uua[8];
#pragma unroll
    for (int dt = 0; dt < 8; ++dt) uua[dt] = *(const u32x2*)(up + 16 * dt);
    const int nks = (16 * (w + 1) + 31) >> 5;
    for (int ks = 0; ks < nks; ++ks) {
        const bf16x8 bfr = ld_frag(Wimg + (16 * w + r) * 272 + (32 * ks + 8 * q) * 2);
#pragma unroll
        for (int dt = 0; dt < 8; ++dt) { const LAS unsigned char* p0 = Vimg + (32 * ks + 8 * q + (r >> 2)) * 272 + (16 * dt + 4 * (r & 3)) * 2;
            acc[dt] = mfma16(tr_frag(p0, p0 + 4 * 272), bfr, acc[dt]); }
    }
    bf16* op = mix + (row0 + i) * DM + g * 128 + 4 * q;
#pragma unroll
    for (int dt = 0; dt < 8; ++dt) { const u32x2 uu = uua[dt];
        f32x4 o; o[0] = gelu_tanh(bflo(uu.x)) * (acc[dt][0] + bsv); o[1] = gelu_tanh(bfhi(uu.x)) * (acc[dt][1] + bsv); o[2] = gelu_tanh(bflo(uu.y)) * (acc[dt][2] + bsv); o[3] = gelu_tanh(bfhi(uu.y)) * (acc[dt][3] + bsv);
        *(u32x2*)(op + 16 * dt) = pack4(o); }
    __syncthreads();
}

DI void attn_item(int item, const bf16* proj, const float* qg, const float* kg, bf16* obr, float* lse, LAS unsigned char* lds, int tid0) {
    const int tid = opaque(tid0);
    const int sub = item % 48, bh = item / 48, h = bh % NH, b = bh / NH;
    int br, rr, n;
    if (sub < 16) { br = 0; rr = 0; n = sub; } else if (sub < 32) { br = 1; rr = (sub - 16) >> 2; n = (sub - 16) & 3; } else { br = 2; rr = sub - 32; n = 0; }
    const int dil = 1 << (2 * br);
    LAS unsigned char* Kimg = lds; LAS unsigned char* Vimg = lds + 256 * 272;
    const bf16* base = proj + (size_t)b * SEQ * NPROJ + h * 128;
    {
        const int piece = tid & 15;
        float kgv[8];
#pragma unroll
        for (int e = 0; e < 8; ++e) kgv[e] = kg[piece * 8 + e];
        u32x4 kva[8], vva[8];
#pragma unroll
        for (int i = 0; i < 8; ++i) {
            const int row = (tid >> 4) + 32 * i, L = (n - 1) * 128 + row;
            kva[i] = (u32x4){0u, 0u, 0u, 0u}; vva[i] = (u32x4){0u, 0u, 0u, 0u};
            if (L >= 0) { const bf16* p = base + (size_t)(L * dil + rr) * NPROJ + piece * 8; kva[i] = *(const u32x4*)(p + C_CK); vva[i] = *(const u32x4*)(p + C_CV); }
        }
#pragma unroll
        for (int i = 0; i < 8; ++i) {
            const int row = (tid >> 4) + 32 * i;
            const u32x4 kv = kva[i], vv = vva[i];
            float kf[8]; unpack8(kv, kf); float ss = 0.f;
#pragma unroll
            for (int e = 0; e < 8; ++e) ss += kf[e] * kf[e];
            ss += __shfl_xor(ss, 1); ss += __shfl_xor(ss, 2); ss += __shfl_xor(ss, 4); ss += __shfl_xor(ss, 8);
            const float rs = 1.0f / sqrtf(ss * (1.0f / 128.0f) + EPS);
#pragma unroll
            for (int e = 0; e < 8; ++e) kf[e] = kf[e] * rs * kgv[e];
            *(LAS u32x4*)(Kimg + row * 272 + piece * 16) = pack8(kf);
            *(LAS u32x4*)(Vimg + row * 272 + piece * 16) = vv;
        }
    }
    const int w = tid >> 6, lane = tid & 63, r = lane & 15, q = lane >> 4;
    const int qi = 16 * w + r, tokq = (n * 128 + qi) * dil + rr;
    bf16x8 qf[4];
    {
        const bf16* qp = base + (size_t)tokq * NPROJ + C_CQ + 8 * q;
        float qv[32]; float ss = 0.f;
#pragma unroll
        for (int s = 0; s < 4; ++s) { const u32x4 raw = *(const u32x4*)(qp + 32 * s); unpack8(raw, qv + 8 * s); }
#pragma unroll
        for (int e = 0; e < 32; ++e) ss += qv[e] * qv[e];
        ss += __shfl_xor(ss, 16); ss += __shfl_xor(ss, 32);
        const float rs = (1.0f / sqrtf(ss * (1.0f / 128.0f) + EPS)) * (0.08838834764831845f * LOG2E);
#pragma unroll
        for (int s = 0; s < 4; ++s) { float t[8];
#pragma unroll
            for (int e = 0; e < 8; ++e) t[e] = qv[8 * s + e] * rs * qg[32 * s + 8 * q + e];
            qf[s] = __builtin_bit_cast(bf16x8, pack8(t)); }
    }
    __syncthreads();
    const int kt0 = 2 * (w >> 1);
    f32x4 sc[10];
#pragma unroll
    for (int t = 0; t < 10; ++t) { f32x4 a4 = {0.f, 0.f, 0.f, 0.f};
#pragma unroll
        for (int s = 0; s < 4; ++s) a4 = mfma16(ld_frag(Kimg + (16 * (kt0 + t) + r) * 272 + (32 * s + 8 * q) * 2), qf[s], a4);
        sc[t] = a4; }
    const float sl2 = exp2f(-8.0f * (float)(h + 1) / 6.0f) * (float)dil * LOG2E;
    float mx = -INFINITY;
#pragma unroll
    for (int t = 0; t < 10; ++t)
#pragma unroll
        for (int jj = 0; jj < 4; ++jj) { const int kj = 16 * (kt0 + t) + 4 * q + jj, delta = 128 + qi - kj;
            const bool valid = (delta >= 0) && (delta <= 128) && (n > 0 || kj >= 128);
            const float v = valid ? sc[t][jj] - sl2 * (float)delta : -INFINITY; sc[t][jj] = v; mx = fmaxf(mx, v); }
    mx = fmaxf(mx, __shfl_xor(mx, 16)); mx = fmaxf(mx, __shfl_xor(mx, 32));
    float l = 0.f;
#pragma unroll
    for (int t = 0; t < 10; ++t)
#pragma unroll
        for (int jj = 0; jj < 4; ++jj) { const float p = __builtin_amdgcn_exp2f(sc[t][jj] - mx); sc[t][jj] = p; l += p; }
    l += __shfl_xor(l, 16); l += __shfl_xor(l, 32);
    bf16x8 pf[5];
#pragma unroll
    for (int pp = 0; pp < 5; ++pp) { u32x4 wv; wv.x = pk2(sc[2 * pp][0], sc[2 * pp][1]); wv.y = pk2(sc[2 * pp][2], sc[2 * pp][3]); wv.z = pk2(sc[2 * pp + 1][0], sc[2 * pp + 1][1]); wv.w = pk2(sc[2 * pp + 1][2], sc[2 * pp + 1][3]);
        pf[pp] = __builtin_bit_cast(bf16x8, wv); }
    f32x4 o[8];
#pragma unroll
    for (int dt = 0; dt < 8; ++dt) o[dt] = (f32x4){0.f, 0.f, 0.f, 0.f};
#pragma unroll
    for (int pp = 0; pp < 5; ++pp)
#pragma unroll
        for (int dt = 0; dt < 8; ++dt) { const LAS unsigned char* p0 = Vimg + (16 * (kt0 + 2 * pp) + 4 * q + (r >> 2)) * 272 + (16 * dt + 4 * (r & 3)) * 2;
            o[dt] = mfma16(tr_frag(p0, p0 + 16 * 272), pf[pp], o[dt]); }
    const float inv = 1.0f / l;
    const size_t orow = (size_t)br * M + (size_t)b * SEQ + tokq;
    bf16* op = obr + orow * 768 + h * 128 + 4 * q;
#pragma unroll
    for (int dt = 0; dt < 8; ++dt) *(u32x2*)(op + 16 * dt) = pack4(o[dt] * inv);
    if (q == 0) lse[orow * 6 + h] = (mx + __builtin_amdgcn_logf(l)) * LN2;
    __syncthreads();
}
DI void attn_combine(const bf16* obr, const float* lse, bf16* mix, int gi0, int nthreads) {
    const int gi = opaque(gi0);
    constexpr int UN = 4;
    for (int idx0 = gi; idx0 < M * 96; idx0 += nthreads * UN) {
        float l[UN][3]; u32x4 raw[UN][3]; int row[UN], c8[UN];
#pragma unroll
        for (int u = 0; u < UN; ++u) { int idx = idx0 + u * nthreads; if (idx >= M * 96) idx = M * 96 - 1; row[u] = idx / 96; c8[u] = idx % 96; const int h = c8[u] >> 4;
#pragma unroll
            for (int br = 0; br < 3; ++br) { l[u][br] = lse[((size_t)br * M + row[u]) * 6 + h]; raw[u][br] = *(const u32x4*)(obr + ((size_t)br * M + row[u]) * 768 + c8[u] * 8); } }
#pragma unroll
        for (int u = 0; u < UN; ++u) {
            const float mx = fmaxf(l[u][0], fmaxf(l[u][1], l[u][2]));
            float w0 = __expf(l[u][0] - mx), w1 = __expf(l[u][1] - mx), w2 = __expf(l[u][2] - mx); const float inv = 1.0f / (w0 + w1 + w2); w0 *= inv; w1 *= inv; w2 *= inv;
            float a[8], bq[8], cc[8]; unpack8(raw[u][0], a); unpack8(raw[u][1], bq); unpack8(raw[u][2], cc);
#pragma unroll
            for (int e = 0; e < 8; ++e) a[e] = w0 * a[e] + w1 * bq[e] + w2 * cc[e];
            if (idx0 + u * nthreads < M * 96) *(u32x4*)(mix + (size_t)row[u] * DM + 1280 + c8[u] * 8) = pack8(a);
        }
    }
}
DI void dn_conv_load(const bf16* proj, int b, int tpos, int col, u32x4* x) {
#pragma unroll
    for (int j = 0; j < 4; ++j) { const int tt = tpos - 3 + j;
        x[2 * j] = (u32x4){0u, 0u, 0u, 0u}; x[2 * j + 1] = (u32x4){0u, 0u, 0u, 0u};
        if (tt >= 0) { const bf16* p = proj + ((size_t)b * SEQ + tt) * NPROJ + col; x[2 * j] = *(const u32x4*)p; x[2 * j + 1] = *(const u32x4*)(p + 8); } }
}
DI void dn_conv16(const u32x4* x, const LAS float* cw  , float* y) {
    float acc[16];
#pragma unroll
    for (int e = 0; e < 16; ++e) acc[e] = 0.f;
#pragma unroll
    for (int j = 0; j < 4; ++j) {
        float xf[16]; unpack8(x[2 * j], xf); unpack8(x[2 * j + 1], xf + 8);
        const LAS f32x4* wp = (const LAS f32x4*)(cw + j * 128);
#pragma unroll
        for (int e4 = 0; e4 < 4; ++e4) { const f32x4 wv = wp[e4];
#pragma unroll
            for (int k = 0; k < 4; ++k) acc[4 * e4 + k] += wv[k] * xf[4 * e4 + k]; } }
#pragma unroll
    for (int e = 0; e < 16; ++e) y[e] = silu_f(acc[e]);
}
DI void dn_prep_item(int item, const bf16* proj, const float* bd, const float* conv_w, const float* a_log, const float* dt_bias, unsigned char* dnall, float* gl_out, LAS unsigned char* lds, int tid0) {
    const int tid = opaque(tid0);
    const int n = item & 31, bh = item >> 5, h = bh % NH, b = bh / NH, t0 = 64 * n;
    unsigned char* dn = dnall + (size_t)item * DN_STRIDE;
    LAS unsigned char* Kimg = lds; LAS unsigned char* Qimg = lds + 17408; LAS unsigned char* KBG = lds + 34816; LAS unsigned char* VB = lds + 52224;
    LAS unsigned char* Amat = lds + 69632; LAS unsigned char* Timg = lds + 87040; LAS float* G = (LAS float*)(lds + 96256); LAS float* BETA = (LAS float*)(lds + 96512);
    const int w = tid >> 6, lane = tid & 63, r = lane & 15, q = lane >> 4;
    LAS float* CW = (LAS float*)(lds + 101888);
    if (tid < 384) { const int tq = tid >> 7, rem = tid & 127, j = rem >> 5, c4 = (rem & 31) * 4;
        *(LAS f32x4*)(CW + (tq * 4 + j) * 128 + c4) = *(const f32x4*)(conv_w + (size_t)j * 2304 + tq * 768 + h * 128 + c4); }
    u32x4 xq[8], xk[8], xv[8];
    { const int i = tid >> 3, p = tid & 7;
      dn_conv_load(proj, b, t0 + i, C_BQ + h * 128 + 16 * p, xq); dn_conv_load(proj, b, t0 + i, C_BK + h * 128 + 16 * p, xk); dn_conv_load(proj, b, t0 + i, C_BV + h * 128 + 16 * p, xv); }
    if (w == 0) {
        const size_t row = (size_t)b * SEQ + t0 + lane;
        const float bl = bd[row * 12 + h], av = bd[row * 12 + 6 + h];
        const float xx = av + dt_bias[h];
        const float sp = xx > 20.f ? xx : log1pf(expf(xx));
        float gs = -expf(a_log[h]) * sp;
#pragma unroll
        for (int o = 1; o < 64; o <<= 1) { const float t = __shfl_up(gs, o); if (lane >= o) gs += t; }
        G[lane] = gs; BETA[lane] = 1.0f / (1.0f + expf(-bl));
    }
    __syncthreads();
    {
        const int i = tid >> 3, p = tid & 7;
        const float gi = G[i], bi = BETA[i], eg = expf(gi);
        float y[16];
        dn_conv16(xq, CW + 0 * 512 + 16 * p, y);
        { float ss = 0.f;
#pragma unroll
            for (int e = 0; e < 16; ++e) ss += y[e] * y[e];
            ss += __shfl_xor(ss, 1); ss += __shfl_xor(ss, 2); ss += __shfl_xor(ss, 4);
            const float rs = (1.0f / sqrtf(ss + EPS)) * 0.08838834764831845f;
            float t[16], tg[16];
#pragma unroll
            for (int e = 0; e < 16; ++e) { t[e] = y[e] * rs; tg[e] = t[e] * eg; }
            *(LAS u32x4*)(Qimg + i * 272 + p * 32) = pack8(t); *(LAS u32x4*)(Qimg + i * 272 + p * 32 + 16) = pack8(t + 8);
            *(u32x4*)(dn + DN_QG + (i * 128 + 16 * p) * 2) = pack8(tg); *(u32x4*)(dn + DN_QG + (i * 128 + 16 * p + 8) * 2) = pack8(tg + 8); }
        dn_conv16(xk, CW + 1 * 512 + 16 * p, y);
        { float ss = 0.f;
#pragma unroll
            for (int e = 0; e < 16; ++e) ss += y[e] * y[e];
            ss += __shfl_xor(ss, 1); ss += __shfl_xor(ss, 2); ss += __shfl_xor(ss, 4);
            const float rs = 1.0f / sqrtf(ss + EPS);
            float t[16], tg[16];
#pragma unroll
            for (int e = 0; e < 16; ++e) { t[e] = y[e] * rs; tg[e] = t[e] * (bi * eg); }
            *(LAS u32x4*)(Kimg + i * 272 + p * 32) = pack8(t); *(LAS u32x4*)(Kimg + i * 272 + p * 32 + 16) = pack8(t + 8);
            *(LAS u32x4*)(KBG + i * 272 + p * 32) = pack8(tg); *(LAS u32x4*)(KBG + i * 272 + p * 32 + 16) = pack8(tg + 8); }
        dn_conv16(xv, CW + 2 * 512 + 16 * p, y);
        { float t[16];
#pragma unroll
            for (int e = 0; e < 16; ++e) t[e] = y[e] * bi;
            *(LAS u32x4*)(VB + i * 272 + p * 32) = pack8(t); *(LAS u32x4*)(VB + i * 272 + p * 32 + 16) = pack8(t + 8); }
    }
    __syncthreads();
    {
        const int it = w & 3;
        const int i = 16 * it + r; const float gi = G[i], bi = BETA[i];
#pragma unroll
        for (int e = 0; e < 2; ++e) { const int jt = 2 * (w >> 2) + e;
            f32x4 kk = {0.f, 0.f, 0.f, 0.f}, qk = {0.f, 0.f, 0.f, 0.f};
#pragma unroll
            for (int s = 0; s < 4; ++s) { const bf16x8 a = ld_frag(Kimg + (16 * jt + r) * 272 + (32 * s + 8 * q) * 2);
                kk = mfma16(a, ld_frag(Kimg + (16 * it + r) * 272 + (32 * s + 8 * q) * 2), kk);
                qk = mfma16(a, ld_frag(Qimg + (16 * it + r) * 272 + (32 * s + 8 * q) * 2), qk); }
            f32x4 av, at;
#pragma unroll
            for (int jj = 0; jj < 4; ++jj) { const int j = 16 * jt + 4 * q + jj; const float dec = (j <= i) ? expf(gi - G[j]) : 0.f;
                av[jj] = (j < i) ? bi * kk[jj] * dec : 0.f; at[jj] = qk[jj] * dec; }
            *(LAS f32x4*)(Amat + i * 272 + (16 * jt + 4 * q) * 4) = av;
            *(u32x2*)(dn + DN_ATT + (i * 64 + 16 * jt + 4 * q) * 2) = pack4(at); }
    }
    __syncthreads();
    LAS unsigned char* A21img = lds + 96768; LAS unsigned char* Ximg = lds + 99328;
    if (w == 0) {
        const int hb = lane >> 5, c = lane & 31;
        unsigned abv = (unsigned)(size_t)(Amat + hb * (32 * 272 + 32 * 4));
        float N[32];
#pragma unroll
        for (int i = 0; i < 32; ++i) {
            const LAS unsigned char* ab = (const LAS unsigned char*)(size_t)abv;
            float s0 = *(const LAS float*)(ab + i * 272 + c * 4), s1 = 0.f, s2 = 0.f, s3 = 0.f;
#pragma unroll
            for (int j4 = 0; j4 < (i + 3) / 4; ++j4) { const f32x4 a4 = *(const LAS f32x4*)(ab + i * 272 + j4 * 16);
                if (4 * j4 + 0 < i) s0 += a4[0] * N[4 * j4 + 0];
                if (4 * j4 + 1 < i) s1 += a4[1] * N[4 * j4 + 1];
                if (4 * j4 + 2 < i) s2 += a4[2] * N[4 * j4 + 2];
                if (4 * j4 + 3 < i) s3 += a4[3] * N[4 * j4 + 3]; }
            N[i] = -((s0 + s1) + (s2 + s3));
            if (i & 1) asm volatile("" : "+v"(abv) : "v"(N[i]));
        }
        LAS unsigned char* tb = Timg + (32 * hb) * 144 + (32 * hb + c) * 2;
#pragma unroll
        for (int i = 0; i < 32; i += 2) { const unsigned pr = pk2(N[i], N[i + 1]);
            *(LAS unsigned short*)(tb + i * 144) = (unsigned short)(pr & 0xffffu);
            *(LAS unsigned short*)(tb + (i + 1) * 144) = (unsigned short)(pr >> 16); }
        asm volatile("s_waitcnt lgkmcnt(0)" ::: "memory");
        *(LAS unsigned short*)(tb + c * 144) = (unsigned short)0x3F80u;
    } else if (w == 1) {
        const int i = lane >> 1, hf = lane & 1;
        *(LAS u32x4*)(Timg + i * 144 + 64 + hf * 32) = (u32x4){0u, 0u, 0u, 0u}; *(LAS u32x4*)(Timg + i * 144 + 64 + hf * 32 + 16) = (u32x4){0u, 0u, 0u, 0u};
    } else if (w < 4) {
        const int t = (w - 2) * 64 + lane, i = t >> 2, j0 = (t & 3) * 8;
        const f32x4 a = *(const LAS f32x4*)(Amat + (32 + i) * 272 + j0 * 4), bb = *(const LAS f32x4*)(Amat + (32 + i) * 272 + j0 * 4 + 16);
        u32x4 o; o.x = pk2(a[0], a[1]); o.y = pk2(a[2], a[3]); o.z = pk2(bb[0], bb[1]); o.w = pk2(bb[2], bb[3]);
        *(LAS u32x4*)(A21img + i * 80 + j0 * 2) = o;
    }
    __syncthreads();
    if (w < 4) {
        const int it = w >> 1, ctile = w & 1;
        const LAS unsigned char* p0 = Timg + (8 * q + (r >> 2)) * 144 + (16 * ctile + 4 * (r & 3)) * 2;
        const f32x4 x = mfma16(tr_frag(p0, p0 + 4 * 144), ld_frag(A21img + (16 * it + r) * 80 + 16 * q), (f32x4){0.f, 0.f, 0.f, 0.f});
        *(LAS u32x2*)(Ximg + (16 * it + r) * 80 + (16 * ctile + 4 * q) * 2) = pack4(x);
    }
    __syncthreads();
    if (w < 4) {
        const int it = w >> 1, ctile = w & 1;
        const LAS unsigned char* p0 = Ximg + (8 * q + (r >> 2)) * 80 + (16 * ctile + 4 * (r & 3)) * 2;
        const f32x4 y = mfma16(tr_frag(p0, p0 + 4 * 80), ld_frag(Timg + (32 + 16 * it + r) * 144 + (32 + 8 * q) * 2), (f32x4){0.f, 0.f, 0.f, 0.f});
        *(LAS u32x2*)(Timg + (32 + 16 * it + r) * 144 + (16 * ctile + 4 * q) * 2) = pack4(-y);
    }
    __syncthreads();
    {
        const int ct = w & 3; const float glast = G[63];
        bf16x8 tf[2];
#pragma unroll
        for (int ks = 0; ks < 2; ++ks) tf[ks] = ld_frag(Timg + (16 * ct + r) * 144 + (32 * ks + 8 * q) * 2);
        float dk4[4];
#pragma unroll
        for (int jj = 0; jj < 4; ++jj) dk4[jj] = expf(glast - G[16 * ct + 4 * q + jj]);
#pragma unroll
        for (int e = 0; e < 4; ++e) { const int dt = 4 * (w >> 2) + e;
            f32x4 au = {0.f, 0.f, 0.f, 0.f}, aw = {0.f, 0.f, 0.f, 0.f};
#pragma unroll
            for (int ks = 0; ks < 2; ++ks) { const int ro = (32 * ks + 8 * q + (r >> 2)) * 272 + (16 * dt + 4 * (r & 3)) * 2;
                au = mfma16(tf[ks], tr_frag(VB + ro, VB + ro + 4 * 272), au);
                aw = mfma16(tr_frag(KBG + ro, KBG + ro + 4 * 272), tf[ks], aw); }
            *(u32x2*)(dn + DN_UT + ((16 * dt + r) * 64 + 16 * ct + 4 * q) * 2) = pack4(au);
            *(u32x2*)(dn + DN_WK + ((16 * ct + r) * 128 + 16 * dt + 4 * q) * 2) = pack4(aw);
            const s16x4 kv = tr4(Kimg + (16 * ct + 4 * q + (r >> 2)) * 272 + (16 * dt + 4 * (r & 3)) * 2);
            f32x4 kd;
#pragma unroll
            for (int jj = 0; jj < 4; ++jj) kd[jj] = __uint_as_float(((unsigned)(unsigned short)kv[jj]) << 16) * dk4[jj];
            *(u32x2*)(dn + DN_KDT + ((16 * dt + r) * 64 + 16 * ct + 4 * q) * 2) = pack4(kd); }
        if (tid == 0) gl_out[item] = expf(glast);
    }
    __syncthreads();
}
struct ScanOps { bf16x8 wf[4], qf[4], af[2], kf[2][2]; u32x2 uu; float g; };
DI void scan_load(ScanOps& o, const unsigned char* dn, const float* gl, int ci, int ct, int dvq, int dvt, int nt0, int r, int q) {
#pragma unroll
    for (int ks = 0; ks < 4; ++ks) { o.wf[ks] = *(const bf16x8*)(dn + DN_WK + ((16 * ct + r) * 128 + 32 * ks + 8 * q) * 2); o.qf[ks] = *(const bf16x8*)(dn + DN_QG + ((16 * ct + r) * 128 + 32 * ks + 8 * q) * 2); }
    o.uu = *(const u32x2*)(dn + DN_UT + ((dvq * 32 + 16 * dvt + r) * 64 + 16 * ct + 4 * q) * 2);
#pragma unroll
    for (int ks = 0; ks < 2; ++ks) o.af[ks] = *(const bf16x8*)(dn + DN_ATT + ((16 * ct + r) * 64 + 32 * ks + 8 * q) * 2);
#pragma unroll
    for (int e = 0; e < 2; ++e)
#pragma unroll
        for (int ks = 0; ks < 2; ++ks) o.kf[e][ks] = *(const bf16x8*)(dn + DN_KDT + ((16 * (nt0 + e) + r) * 64 + 32 * ks + 8 * q) * 2);
    o.g = gl[ci];
}
DI void scan_step(const ScanOps& c, f32x4 (&Sacc)[2], float* op, LAS unsigned char* Simg, LAS unsigned char* VNT, int ct, int dvt, int mt, int nt0, int r, int q) {
    f32x4 wsa = {0.f, 0.f, 0.f, 0.f}, qsa = {0.f, 0.f, 0.f, 0.f};
#pragma unroll
    for (int ks = 0; ks < 4; ++ks) { const LAS unsigned char* p0 = Simg + (32 * ks + 8 * q + (r >> 2)) * 80 + (16 * dvt + 4 * (r & 3)) * 2;
        const bf16x8 sf = tr_frag(p0, p0 + 4 * 80);
        wsa = mfma16(c.wf[ks], sf, wsa); qsa = mfma16(c.qf[ks], sf, qsa); }
    { const int dv = 16 * dvt + r; const u32x2 uu = c.uu;
      f32x4 vn; vn[0] = bflo(uu.x) - wsa[0]; vn[1] = bfhi(uu.x) - wsa[1]; vn[2] = bflo(uu.y) - wsa[2]; vn[3] = bfhi(uu.y) - wsa[3];
      *(LAS u32x2*)(VNT + dv * 144 + (16 * ct + 4 * q) * 2) = pack4(vn); }
    lds_barrier();
#pragma unroll
    for (int ks = 0; ks < 2; ++ks) qsa = mfma16(c.af[ks], ld_frag(VNT + (16 * dvt + r) * 144 + (32 * ks + 8 * q) * 2), qsa);
#pragma unroll
    for (int jj = 0; jj < 4; ++jj) op[(size_t)jj * 768] = qsa[jj];
    bf16x8 af2[2];
#pragma unroll
    for (int ks = 0; ks < 2; ++ks) af2[ks] = ld_frag(VNT + (16 * mt + r) * 144 + (32 * ks + 8 * q) * 2);
#pragma unroll
    for (int e = 0; e < 2; ++e) { Sacc[e] = Sacc[e] * c.g;
#pragma unroll
        for (int ks = 0; ks < 2; ++ks) Sacc[e] = mfma16(af2[ks], c.kf[e][ks], Sacc[e]);
        *(LAS u32x2*)(Simg + (16 * (nt0 + e) + r) * 80 + (16 * mt + 4 * q) * 2) = pack4(Sacc[e]); }
    lds_barrier();
}
DI void dn_scan_item(int item, const unsigned char* dnall, const float* gl, float* odn, LAS unsigned char* lds, int tid0) {
    const int tid = opaque(tid0);
    const int dvq = item & 3, bh = item >> 2, h = bh % NH, b = bh / NH;
    LAS unsigned char* Simg = lds; LAS unsigned char* VNT = lds + 10240;
    for (int u = tid; u < 10240 / 16; u += NTHR) *(LAS u32x4*)(Simg + u * 16) = (u32x4){0u, 0u, 0u, 0u};
    const int w = tid >> 6, lane = tid & 63, r = lane & 15, q = lane >> 4;
    const int ct = w >> 1, dvt = w & 1, mt = w & 1, nt0 = 2 * (w >> 1);
    f32x4 Sacc[2];
#pragma unroll
    for (int e = 0; e < 2; ++e) Sacc[e] = (f32x4){0.f, 0.f, 0.f, 0.f};
    const unsigned char* dn0 = dnall + (size_t)(bh * 32) * DN_STRIDE;
    float* op0 = odn + ((size_t)b * SEQ + 16 * ct + 4 * q) * 768 + h * 128 + dvq * 32 + 16 * dvt + r;
    ScanOps A, B;
    scan_load(A, dn0, gl, bh * 32, ct, dvq, dvt, nt0, r, q);
    __syncthreads();
#pragma unroll 1
    for (int n = 0; n < 32; n += 2) {
        scan_load(B, dn0 + (size_t)(n + 1) * DN_STRIDE, gl, bh * 32 + n + 1, ct, dvq, dvt, nt0, r, q);
        scan_step(A, Sacc, op0 + (size_t)(64 * n) * 768, Simg, VNT, ct, dvt, mt, nt0, r, q);
        const int n2 = (n + 2 < 32) ? n + 2 : 31;
        scan_load(A, dn0 + (size_t)n2 * DN_STRIDE, gl, bh * 32 + n2, ct, dvq, dvt, nt0, r, q);
        scan_step(B, Sacc, op0 + (size_t)(64 * (n + 1)) * 768, Simg, VNT, ct, dvt, mt, nt0, r, q);
    }
    __syncthreads();
}
DI void dn_gate_phase(const float* odn, const bf16* proj, const float* ong, bf16* mix, int gw, int ngw, int lane0) {
    const int lane = opaque(lane0);
    const int sub = lane >> 4, l16 = lane & 15;
    float gv[8];
#pragma unroll
    for (int e = 0; e < 8; ++e) gv[e] = ong[l16 * 8 + e];
    constexpr int UN = 4, NIT = M * NH / 4;
    for (int it0 = gw; it0 < NIT; it0 += ngw * UN) {
        f32x4 o0[UN], o1[UN]; u32x4 graw[UN]; int row[UN], hh[UN];
#pragma unroll
        for (int u = 0; u < UN; ++u) { int it = it0 + u * ngw; if (it >= NIT) it = NIT - 1; const int idx = it * 4 + sub; row[u] = idx / NH; hh[u] = idx % NH;
            const float* op = odn + (size_t)row[u] * 768 + hh[u] * 128 + l16 * 8; o0[u] = *(const f32x4*)op; o1[u] = *(const f32x4*)(op + 4);
            graw[u] = *(const u32x4*)(proj + (size_t)row[u] * NPROJ + C_BG + hh[u] * 128 + l16 * 8); }
#pragma unroll
        for (int u = 0; u < UN; ++u) {
            float ss = (o0[u][0] * o0[u][0] + o0[u][1] * o0[u][1]) + (o0[u][2] * o0[u][2] + o0[u][3] * o0[u][3]) + (o1[u][0] * o1[u][0] + o1[u][1] * o1[u][1]) + (o1[u][2] * o1[u][2] + o1[u][3] * o1[u][3]);
            ss += __shfl_xor(ss, 1); ss += __shfl_xor(ss, 2); ss += __shfl_xor(ss, 4); ss += __shfl_xor(ss, 8);
            const float rs = 1.0f / sqrtf(ss * (1.0f / 128.0f) + EPS);
            float gt[8]; unpack8(graw[u], gt);
            float y[8];
#pragma unroll
            for (int e = 0; e < 4; ++e) { y[e] = o0[u][e] * rs * gv[e] * silu_f(gt[e]); y[4 + e] = o1[u][e] * rs * gv[4 + e] * silu_f(gt[4 + e]); }
            if (it0 + u * ngw < NIT) *(u32x4*)(mix + (size_t)row[u] * DM + 512 + hh[u] * 128 + l16 * 8) = pack8(y);
        }
    }
}

struct Args { const float* in[16]; float* out; unsigned char* ws; };
#ifndef MK_SKIP_MIX
#define MK_SKIP_MIX 0
#endif
#ifndef REP_M1
#define REP_M1 1
#endif
#ifndef REP_M2
#define REP_M2 1
#endif
#ifndef REP_G13
#define REP_G13 1
#endif
__global__ void __launch_bounds__(NTHR, 2) hybrid_fwd(Args a) {
    extern __shared__ __attribute__((aligned(16))) unsigned char lds_raw[];
    LAS unsigned char* lds = (LAS unsigned char*)lds_raw;
    cg::grid_group grid = cg::this_grid();
    volatile LAS unsigned* bst = (volatile LAS unsigned*)(lds + LDS_BYTES - 64);
    if (threadIdx.x < 2) bst[threadIdx.x] = 0u;
    __syncthreads();
    const XcdBarrier xbar = xcd_barrier_post((unsigned*)(a.ws + WS_CTL), bst);
    const int tid = threadIdx.x, lane = tid & 63, wave = __builtin_amdgcn_readfirstlane(tid >> 6);
    const int G = gridDim.x, bx = blockIdx.x, gw = bx * 8 + wave, ngw = G * 8;
    unsigned char* ws = a.ws;
    bf16* Hb = (bf16*)(ws + WS_H); bf16* PROJ = (bf16*)(ws + WS_PROJ); float* BD = (float*)(ws + WS_BD); unsigned char* DN = ws + WS_DN; float* GL = (float*)(ws + WS_GL);
    float* ODN = (float*)(ws + WS_ODN); bf16* OBR = (bf16*)(ws + WS_OBR); float* LSE = (float*)(ws + WS_LSE);
    bf16* MIX = Hb; bf16* ACT = PROJ;

#ifdef EXTRA_SYNCS
    for (int es = 0; es < EXTRA_SYNCS; ++es) xcd_barrier(xbar);
#endif
    weight_prep(a.in, ws, lds, gw, ngw, wave, lane);
    __syncthreads();
    norm_phase(a.in[I_X], a.in[I_N1G], Hb, a.in[I_WIN], BD, lds, gw, ngw, tid, lane);
    grid.sync();
#ifndef REP_MASK
#define REP_MASK 0
#endif
    bool rep_done = false;
#pragma unroll 1
    for (int s = 1; s < DEPTH * 9; ++s) {
        const int l = s / 9, ph = s - 9 * l;
        const unsigned char* wl = ws + WS_W + (size_t)l * SZ_WL;
        if (ph == 0) {
            norm_phase(a.out, a.in[I_N1G] + (size_t)l * DM, Hb, a.in[I_WIN] + (size_t)l * DM * IN_TOTAL, BD, lds, gw, ngw, tid, lane);
        } else if (ph == 1) {
            pg8::Gemm g{Hb, (const bf16*)wl, M, NPROJ, DM}; pg8::StaticOrder S; S.init(M, NPROJ, G, bx);
            pg8::EpiBf16<0> E{PROJ, NPROJ, nullptr, 0, 0, 1.f};
            pg8::gemm_phase<pg8::EpiBf16<0>, pg8::StaticOrder, true, true>(lds, g, S, E);
        } else if (ph == 2) {
#ifndef M1_REP_TYPE
#define M1_REP_TYPE -1
#endif
            for (int it = bx; it < 2304 + 1536 + 512; it += G)
            for (int rr = 0; rr < (((it < 2304) ? 0 : (it < 3840) ? 1 : 2) == M1_REP_TYPE ? 2 : 1); ++rr) {
                if (it < 2304) attn_item(it, PROJ, a.in[I_QNG] + l * HD, a.in[I_KNG] + l * HD, OBR, LSE, lds, tid);
                else if (it < 2304 + 1536) dn_prep_item(it - 2304, PROJ, BD, a.in[I_CONVW] + (size_t)l * 4 * 2304, a.in[I_ALOG] + l * NH, a.in[I_DTB] + l * NH, DN, GL, lds, tid);
                else sgu_item(it - 3840, PROJ, a.in[I_SGUG] + l * 512, a.in[I_WS] + (size_t)l * 4 * 128 * 128, a.in[I_BS] + l * 512, MIX, lds, tid);
            }
        } else if (ph == 3) {
            if (G > NSCAN) {
                if (bx < NSCAN) { const int xcd = bx & 7, slot = bx >> 3;
                    dn_scan_item(((xcd * 6 + (slot >> 2)) << 2) | (slot & 3), DN, GL, ODN, lds, tid); }
                else attn_combine(OBR, LSE, MIX, (bx - NSCAN) * NTHR + tid, (G - NSCAN) * NTHR);
            } else {
                for (int it = bx; it < NSCAN; it += G) { dn_scan_item(it, DN, GL, ODN, lds, tid); __syncthreads(); }
                attn_combine(OBR, LSE, MIX, bx * NTHR + tid, G * NTHR);
            }
        } else if (ph == 4) {
            dn_gate_phase(ODN, PROJ, a.in[I_ONG] + l * HD, MIX, gw, ngw, lane);
        } else if (ph == 5) {
            pg8::Gemm g{MIX, (const bf16*)(wl + SZ_WIN), M, DM, DM}; pg8::StaticOrder S; S.init(M, DM, G, bx);
            pg8::EpiResF32 E{(l == 0) ? a.in[I_X] : a.out, a.out, DM};
            pg8::gemm_phase<pg8::EpiResF32, pg8::StaticOrder, true, true>(lds, g, S, E);
        } else if (ph == 6) {
            norm_phase(a.out, a.in[I_N2G] + (size_t)l * DM, Hb, nullptr, nullptr, lds, gw, ngw, tid, lane);
        } else if (ph == 7) {
            pg8::Gemm g{Hb, (const bf16*)(wl + SZ_WIN + SZ_WOUT), M, 2 * FF, DM}; pg8::StaticOrder S; S.init(M, 2 * FF, G, bx);
            pg8::EpiSwiGLU E{ACT, FF};
            pg8::gemm_phase<pg8::EpiSwiGLU, pg8::StaticOrder, true, true>(lds, g, S, E);
        } else {
            pg8::Gemm g{ACT, (const bf16*)(wl + SZ_WIN + SZ_WOUT + SZ_WGU), M, DM, FF}; pg8::StaticOrder S; S.init(M, DM, G, bx);
            pg8::EpiResF32 E{a.out, a.out, DM};
            pg8::gemm_phase<pg8::EpiResF32, pg8::StaticOrder, true, true>(lds, g, S, E);
        }
        if (s + 1 < DEPTH * 9) xcd_barrier(xbar);
        if (REP_MASK) { if (((REP_MASK >> ph) & 1) && !rep_done) { --s; rep_done = true; } else rep_done = false; }
    }
}

extern "C" void kernel_launch(void* const* d_in, const int* in_sizes, int n_in, void* d_out, int out_size, void* d_ws, size_t ws_size, hipStream_t stream) {
    static int grid = 0;
    if (grid == 0) {
        if (n_in != 16 || in_sizes[0] != M * DM || out_size != M * DM || ws_size < WS_END) { fprintf(stderr, "kernel_launch: unexpected shapes / workspace (n_in %d, ws %zu, need %zu); nothing launched\n", n_in, ws_size, (size_t)WS_END); grid = -1; return; }
        int dev = 0, cus = 0, per_cu = 0;
        if (hipGetDevice(&dev) != hipSuccess || hipDeviceGetAttribute(&cus, hipDeviceAttributeMultiprocessorCount, dev) != hipSuccess) { grid = -1; return; }
        if (hipFuncSetAttribute((const void*)hybrid_fwd, hipFuncAttributeMaxDynamicSharedMemorySize, LDS_BYTES) != hipSuccess) { fprintf(stderr, "kernel_launch: hipFuncSetAttribute failed\n"); grid = -1; return; }
        if (hipOccupancyMaxActiveBlocksPerMultiprocessor(&per_cu, (const void*)hybrid_fwd, NTHR, LDS_BYTES) != hipSuccess || per_cu < 1) { fprintf(stderr, "kernel_launch: occupancy query says %d blocks per CU\n", per_cu); per_cu = 1; }
        (void)hipGetLastError();
        grid = cus;
    }
    if (grid < 0) return;
    if (hipMemsetAsync((char*)d_ws + WS_CTL, 0, CTL_BYTES, stream) != hipSuccess) { fprintf(stderr, "kernel_launch: memset of the barrier words failed\n"); return; }
    Args a{};
    for (int i = 0; i < 16; ++i) a.in[i] = (const float*)d_in[i];
    a.out = (float*)d_out; a.ws = (unsigned char*)d_ws;
    void* args[] = {&a};
    hipError_t e = hipLaunchCooperativeKernel((const void*)hybrid_fwd, dim3(grid), dim3(NTHR), args, LDS_BYTES, stream);
    if (e != hipSuccess) fprintf(stderr, "kernel_launch: cooperative launch failed: %s (grid %d)\n", hipGetErrorString(e), grid);
}
```

```cpp
#include <hip/hip_runtime.h>
#include <hip/hip_cooperative_groups.h>
#include <cstdio>
#include <cstdint>
namespace cg = cooperative_groups;
namespace pg8 {
#define PG8_LAS __attribute__((address_space(3)))
typedef unsigned short bf16_t;
typedef short bf16x8 __attribute__((ext_vector_type(8)));
typedef float f32x4 __attribute__((ext_vector_type(4)));
typedef unsigned u32x4 __attribute__((ext_vector_type(4)));
constexpr int BM = 256, BK = 64, HALF = 128, HTB = HALF * BK * 2  , STAGE_BYTES = 8 * HTB, NXCD = 8, WGM = 8;

__host__ __device__ __forceinline__ int lds_byte(int r, int c) { const int st = (r >> 4) * 2 + (c >> 5), rr = r & 15, cc = c & 31, ob = rr * 64 + cc * 2; return st * 1024 + (ob ^ (((ob >> 9) & 1) << 5)); }
__host__ __device__ __forceinline__ void stage_rc(int b, int& R, int& C) { const int st = b / 1024, sb = b % 1024, swz = sb ^ (((sb >> 9) & 1) << 5); R = (st >> 1) * 16 + swz / 64; C = (st & 1) * 32 + (swz % 64) / 2; }
__host__ __device__ __forceinline__ int perm32(int rho) { const int n = rho >> 4, i = rho & 15; return 8 * (i >> 2) + 4 * n + (i & 3); }

struct Unit { int pm, pn; };
struct Gemm { const bf16_t* A; const bf16_t* Bt; int M, N, K; };

struct StaticOrder {
    int nM, nN, nwg, G, c;
    __host__ __device__ void init(int M, int N, int G_, int c_) { nM = M / BM; nN = N / BM; nwg = nM * nN; G = G_; c = c_; }
    __host__ __device__ bool next(int i, Unit& u) const {
        const long L = (long)i * G + c; if (L >= nwg) return false;
        int wgid = (int)L; { const int q = nwg / NXCD, r = nwg % NXCD, xcd = wgid % NXCD, off = wgid / NXCD; wgid = (xcd < r ? xcd * (q + 1) : r * (q + 1) + (xcd - r) * q) + off; }
        const int nig = WGM * nN, gid = wgid / nig, fm = gid * WGM, gsz = (nM - fm) < WGM ? (nM - fm) : WGM;
        u.pm = fm + ((wgid % nig) % gsz); u.pn = (wgid % nig) / gsz; return true;
    }
    __device__ __forceinline__ void a_ready(const Unit&) const {}
    __device__ __forceinline__ void done(const Unit&) const {}
};

__device__ __forceinline__ unsigned cvt_pk_bf16(float lo, float hi) { unsigned r; asm volatile("v_cvt_pk_bf16_f32 %0, %1, %2" : "=v"(r) : "v"(lo), "v"(hi)); return r; }
typedef float f32x2 __attribute__((ext_vector_type(2)));
__device__ __forceinline__ f32x2 gelu_pk(f32x2 v) {
    const f32x2 av = __builtin_elementwise_abs(v), d = av * 0.2316418882f + 1.0f;
    f32x2 t; t.x = __builtin_amdgcn_rcpf(d.x); t.y = __builtin_amdgcn_rcpf(d.y);
    f32x2 q = t * 0.5307027145f + (-0.7265760135f); q = q * t + 0.7107068705f; q = q * t + (-0.142248368f); q = q * t + 0.127414796f; q = q * t;
    const f32x2 s = (v * v) * (-0.72134752044f);
    f32x2 e; e.x = __builtin_amdgcn_exp2f(s.x); e.y = __builtin_amdgcn_exp2f(s.y);
    const f32x2 m = v * (q * e), r = v - m;
    f32x2 o; o.x = v.x < 0.f ? m.x : r.x; o.y = v.y < 0.f ? m.y : r.y; return o;
}

template <int ACT  > struct EpiBf16 {
    static constexpr bool PERM = true, AFTER_DRAIN = false; static_assert(ACT == 0 || ACT == 1, "EpiBf16: ACT is 0 (none) or 1 (gelu_pk)");
    bf16_t* O; int ldc; const float* bias; int split_cols; size_t split_stride; float scale0;
    __device__ __forceinline__ void operator()(const f32x4 (&acc)[2][2][4][2], const Unit& u, int wr, int wc, int fr, int fq) const {
        const int row0 = u.pm * BM + wr * 64 + fr; int colt = u.pn * BM; bf16_t* base = O;
        float sc = 1.f; if (split_cols) { const int t = colt / split_cols; base += (size_t)t * split_stride; colt -= t * split_cols; if (t == 0) sc = scale0; }
        const int col0 = colt + wc * 32 + 8 * fq, bcol0 = u.pn * BM + wc * 32 + 8 * fq;
        f32x4 bv[2][2];
#pragma unroll
        for (int bj = 0; bj < 2; ++bj)
#pragma unroll
            for (int n = 0; n < 2; ++n) bv[bj][n] = bias ? *(const f32x4*)(bias + bcol0 + bj * HALF + 4 * n) : (f32x4){0.f, 0.f, 0.f, 0.f};
#pragma unroll
        for (int ai = 0; ai < 2; ++ai)
#pragma unroll
            for (int m = 0; m < 4; ++m) { bf16_t* rowp = base + (size_t)(row0 + ai * HALF + m * 16) * ldc + col0;
#pragma unroll
                for (int bj = 0; bj < 2; ++bj) { f32x4 v0 = acc[ai][bj][m][0] + bv[bj][0], v1 = acc[ai][bj][m][1] + bv[bj][1];
                    if (ACT == 1) { f32x2 a = gelu_pk((f32x2){v0[0], v0[1]}), b = gelu_pk((f32x2){v0[2], v0[3]}), c = gelu_pk((f32x2){v1[0], v1[1]}), d = gelu_pk((f32x2){v1[2], v1[3]});
                        v0 = (f32x4){a.x, a.y, b.x, b.y}; v1 = (f32x4){c.x, c.y, d.x, d.y}; }
                    v0 = v0 * sc; v1 = v1 * sc; u32x4 w; w.x = cvt_pk_bf16(v0[0], v0[1]); w.y = cvt_pk_bf16(v0[2], v0[3]); w.z = cvt_pk_bf16(v1[0], v1[1]); w.w = cvt_pk_bf16(v1[2], v1[3]);
                    *(u32x4*)(rowp + bj * HALF) = w; } }
    }
};
struct EpiResF32 {
    static constexpr bool PERM = false, AFTER_DRAIN = false;
    const float* base; float* out; int ldc;
    __device__ __forceinline__ void operator()(const f32x4 (&acc)[2][2][4][2], const Unit& u, int wr, int wc, int fr, int fq) const {
        const int row0 = u.pm * BM + wr * 64 + fr; const int col0 = u.pn * BM + wc * 32 + 4 * fq;
#pragma unroll
        for (int ai = 0; ai < 2; ++ai)
#pragma unroll
            for (int m = 0; m < 4; ++m) { const size_t off = (size_t)(row0 + ai * HALF + m * 16) * ldc + col0;
#pragma unroll
                for (int bj = 0; bj < 2; ++bj)
#pragma unroll
                    for (int n = 0; n < 2; ++n) { const f32x4 b = *(const f32x4*)(base + off + bj * HALF + n * 16); *(f32x4*)(out + off + bj * HALF + n * 16) = b + acc[ai][bj][m][n]; } }
    }
};
__device__ __forceinline__ float silu_f(float g) { return g * __builtin_amdgcn_rcpf(1.0f + __expf(-g)); }
struct EpiSwiGLU {
    static constexpr bool PERM = true, AFTER_DRAIN = false;
    bf16_t* O; int ldo;
    __device__ __forceinline__ void operator()(const f32x4 (&acc)[2][2][4][2], const Unit& u, int wr, int wc, int fr, int fq) const {
        const int row0 = u.pm * BM + wr * 64 + fr; const int col0 = u.pn * HALF + wc * 32 + 8 * fq;
#pragma unroll
        for (int ai = 0; ai < 2; ++ai)
#pragma unroll
            for (int m = 0; m < 4; ++m) { bf16_t* rowp = O + (size_t)(row0 + ai * HALF + m * 16) * ldo + col0;
                const f32x4 g0 = acc[ai][0][m][0], g1 = acc[ai][0][m][1], u0 = acc[ai][1][m][0], u1 = acc[ai][1][m][1];
                u32x4 w; w.x = cvt_pk_bf16(silu_f(g0[0]) * u0[0], silu_f(g0[1]) * u0[1]); w.y = cvt_pk_bf16(silu_f(g0[2]) * u0[2], silu_f(g0[3]) * u0[3]);
                w.z = cvt_pk_bf16(silu_f(g1[0]) * u1[0], silu_f(g1[1]) * u1[1]); w.w = cvt_pk_bf16(silu_f(g1[2]) * u1[2], silu_f(g1[3]) * u1[3]);
                *(u32x4*)rowp = w; }
    }
};
template <class Epi, class Sched, bool ALIGN_EPI = false, bool SP2 = false>
__device__ __forceinline__ void gemm_phase(PG8_LAS unsigned char* lds, const Gemm g, const Sched& S, const Epi& E) {
    int tid_ = threadIdx.x; asm volatile("" : "+v"(tid_)); const int tid = tid_, wid = __builtin_amdgcn_readfirstlane(tid >> 6), lane = tid & 63, wr = wid >> 2, wc = wid & 3, fr = lane & 15, fq = lane >> 4;
    const int K = g.K, nt = K / BK;
    unsigned voffA[2], voffB[2];
#pragma unroll
    for (int i = 0; i < 2; ++i) { int R, C; stage_rc(tid * 16 + i * 8192, R, C); const int Rb = Epi::PERM ? ((R & ~31) + perm32(R & 31)) : R;
        voffA[i] = (unsigned)(R * K + C) * 2u; voffB[i] = (unsigned)(Rb * K + C) * 2u; }
    const size_t kstep = (size_t)(BK * 2);
    const size_t hstep = (size_t)HALF * K * 2;
    const size_t tstep = 2 * hstep;
    const unsigned ldsw = (unsigned)wid * 1024u;
    const int aoff = lds_byte(wr * 64 + fr, fq * 8), boff = lds_byte(wc * 32 + fr, fq * 8);
#define PG8_SA(b, h) (((b) * 2 + (h)) * HTB)
#define PG8_SB(b, h) ((4 + (b) * 2 + (h)) * HTB)
#define PG8_STAGE(bufoff, gbase, voff) do { _Pragma("unroll") for (int _i = 0; _i < 2; ++_i) \
        __builtin_amdgcn_global_load_lds((const unsigned*)((const char*)(gbase) + (voff)[_i]), (PG8_LAS unsigned*)(lds + (bufoff) + ldsw + _i * 8192), 16, 0, 0); } while (0)
#define PG8_LDA(dst, b, h) do { _Pragma("unroll") for (int m = 0; m < 4; ++m) _Pragma("unroll") for (int k = 0; k < 2; ++k) dst[m][k] = *(const PG8_LAS bf16x8*)(lds + PG8_SA(b, h) + aoff + m * 2048 + k * 1024); } while (0)
#define PG8_LDB(dst, b, h) do { _Pragma("unroll") for (int n = 0; n < 2; ++n) _Pragma("unroll") for (int k = 0; k < 2; ++k) dst[n][k] = *(const PG8_LAS bf16x8*)(lds + PG8_SB(b, h) + boff + n * 2048 + k * 1024); } while (0)
#define PG8_MMA(ai, bj, At, Bt) do { __builtin_amdgcn_s_setprio(1); _Pragma("unroll") for (int m = 0; m < 4; ++m) _Pragma("unroll") for (int n = 0; n < 2; ++n) _Pragma("unroll") for (int k = 0; k < 2; ++k) \
        acc[ai][bj][m][n] = __builtin_amdgcn_mfma_f32_16x16x32_bf16(Bt[n][k], At[m][k], acc[ai][bj][m][n], 0, 0, 0); __builtin_amdgcn_s_setprio(0); } while (0)
#define PG8_WAIT_V(n) asm volatile("s_waitcnt vmcnt(" #n ")" ::: "memory")
#define PG8_WAIT_L(n) asm volatile("s_waitcnt lgkmcnt(" #n ")" ::: "memory")
#define PG8_BAR __builtin_amdgcn_s_barrier()
#define PG8_SCHED __builtin_amdgcn_sched_barrier(0)
    Unit cur, nxt; int ui = 0;
    if (!S.next(0, cur)) return;
    f32x4 acc[2][2][4][2];
#pragma unroll
    for (int a = 0; a < 2; ++a)
#pragma unroll
        for (int b = 0; b < 2; ++b)
#pragma unroll
            for (int m = 0; m < 4; ++m)
#pragma unroll
                for (int n = 0; n < 2; ++n) acc[a][b][m][n] = (f32x4){0.f, 0.f, 0.f, 0.f};
    bf16x8 At[4][2], B0[2][2], B1[2][2];
    const char* cA = (const char*)g.A + (size_t)cur.pm * tstep; const char* cB = (const char*)g.Bt + (size_t)cur.pn * tstep;
    S.a_ready(cur);
    if constexpr (SP2) {
        PG8_STAGE(PG8_SB(0, 0), cB, voffB); PG8_STAGE(PG8_SB(0, 1), cB + hstep, voffB); PG8_STAGE(PG8_SA(0, 0), cA, voffA); PG8_STAGE(PG8_SA(0, 1), cA + hstep, voffA);
        if (wr == 1) PG8_BAR;
        PG8_WAIT_V(2); PG8_BAR;
        PG8_STAGE(PG8_SB(1, 0), cB + kstep, voffB); PG8_STAGE(PG8_SA(1, 0), cA + kstep, voffA); PG8_STAGE(PG8_SB(1, 1), cB + hstep + kstep, voffB);
        PG8_WAIT_V(6); PG8_BAR;
    } else {
        PG8_STAGE(PG8_SB(0, 0), cB, voffB); PG8_STAGE(PG8_SA(0, 0), cA, voffA); PG8_STAGE(PG8_SB(0, 1), cB + hstep, voffB); PG8_STAGE(PG8_SA(0, 1), cA + hstep, voffA);
        if (wr == 1) PG8_BAR;
        PG8_WAIT_V(4); PG8_BAR;
        PG8_STAGE(PG8_SB(1, 0), cB + kstep, voffB); PG8_STAGE(PG8_SA(1, 0), cA + kstep, voffA); PG8_STAGE(PG8_SB(1, 1), cB + hstep + kstep, voffB);
        PG8_WAIT_V(6); PG8_BAR;
    }
    for (;;) {
        const bool has_next = S.next(ui + 1, nxt);
        const char* nA = has_next ? (const char*)g.A + (size_t)nxt.pm * tstep : cA; const char* nB = has_next ? (const char*)g.Bt + (size_t)nxt.pn * tstep : cB;
        for (int t = 0; t < nt; t += 2) {
            const bool last = (t == nt - 2);
            const char* a1 = cA + (size_t)(t + 1) * kstep;
            const char* a2 = last ? nA : cA + (size_t)(t + 2) * kstep; const char* b2 = last ? nB : cB + (size_t)(t + 2) * kstep;
            const char* a3 = a2 + kstep; const char* b3 = b2 + kstep;
            if (last && has_next) S.a_ready(nxt);
            if constexpr (SP2) {
            PG8_LDB(B0, 0, 0); PG8_LDB(B1, 0, 1); PG8_SCHED; PG8_LDA(At, 0, 0); PG8_STAGE(PG8_SA(1, 1), a1 + hstep, voffA);
            PG8_WAIT_V(8); PG8_WAIT_L(0); PG8_BAR; PG8_MMA(0, 0, At, B0); PG8_MMA(0, 1, At, B1); PG8_BAR; PG8_SCHED;
            PG8_LDA(At, 0, 1); PG8_STAGE(PG8_SB(0, 0), b2, voffB); PG8_STAGE(PG8_SB(0, 1), b2 + hstep, voffB); PG8_STAGE(PG8_SA(0, 0), a2, voffA);
            PG8_WAIT_V(8); PG8_WAIT_L(0); PG8_BAR; PG8_MMA(1, 0, At, B0); PG8_MMA(1, 1, At, B1); PG8_BAR; PG8_SCHED;
            PG8_LDB(B0, 1, 0); PG8_LDB(B1, 1, 1); PG8_SCHED; PG8_LDA(At, 1, 0); PG8_STAGE(PG8_SA(0, 1), a2 + hstep, voffA);
            PG8_WAIT_V(8); PG8_WAIT_L(0); PG8_BAR; PG8_MMA(0, 0, At, B0); PG8_MMA(0, 1, At, B1); PG8_BAR; PG8_SCHED;
            PG8_LDA(At, 1, 1); PG8_STAGE(PG8_SB(1, 0), b3, voffB); PG8_STAGE(PG8_SB(1, 1), b3 + hstep, voffB); PG8_STAGE(PG8_SA(1, 0), a3, voffA);
            PG8_WAIT_V(8); PG8_WAIT_L(0); PG8_BAR; PG8_MMA(1, 0, At, B0); PG8_MMA(1, 1, At, B1); PG8_BAR; PG8_SCHED;
            } else {
            PG8_LDB(B0, 0, 0); PG8_SCHED; PG8_LDA(At, 0, 0); PG8_STAGE(PG8_SA(1, 1), a1 + hstep, voffA);
            PG8_WAIT_L(8); PG8_BAR; PG8_WAIT_L(0); PG8_MMA(0, 0, At, B0); PG8_BAR; PG8_SCHED;
            PG8_LDB(B1, 0, 1); PG8_STAGE(PG8_SB(0, 0), b2, voffB);
            PG8_BAR; PG8_WAIT_L(0); PG8_MMA(0, 1, At, B1); PG8_BAR;
            PG8_LDA(At, 0, 1); PG8_STAGE(PG8_SA(0, 0), a2, voffA);
            PG8_BAR; PG8_WAIT_L(0); PG8_MMA(1, 0, At, B0); PG8_BAR; PG8_SCHED;
            PG8_STAGE(PG8_SB(0, 1), b2 + hstep, voffB);
            PG8_WAIT_V(6); PG8_BAR; PG8_MMA(1, 1, At, B1); PG8_BAR;
            PG8_LDB(B0, 1, 0); PG8_SCHED; PG8_LDA(At, 1, 0); PG8_STAGE(PG8_SA(0, 1), a2 + hstep, voffA);
            PG8_WAIT_L(8); PG8_BAR; PG8_WAIT_L(0); PG8_MMA(0, 0, At, B0); PG8_BAR; PG8_SCHED;
            PG8_LDB(B1, 1, 1); PG8_STAGE(PG8_SB(1, 0), b3, voffB);
            PG8_BAR; PG8_WAIT_L(0); PG8_MMA(0, 1, At, B1); PG8_BAR;
            PG8_LDA(At, 1, 1); PG8_STAGE(PG8_SA(1, 0), a3, voffA);
            PG8_BAR; PG8_WAIT_L(0); PG8_MMA(1, 0, At, B0); PG8_BAR; PG8_SCHED;
            PG8_STAGE(PG8_SB(1, 1), b3 + hstep, voffB);
            PG8_WAIT_V(6); PG8_BAR; PG8_MMA(1, 1, At, B1); PG8_BAR;
            }
        }
        if constexpr (ALIGN_EPI) { if (wr == 0) PG8_BAR; }
        if constexpr (!Epi::AFTER_DRAIN) { E(acc, cur, wr, wc, fr, fq); S.done(cur); }
        if (!has_next) break;
#pragma unroll
        for (int a = 0; a < 2; ++a)
#pragma unroll
            for (int b = 0; b < 2; ++b)
#pragma unroll
                for (int m = 0; m < 4; ++m)
#pragma unroll
                    for (int n = 0; n < 2; ++n) acc[a][b][m][n] = (f32x4){0.f, 0.f, 0.f, 0.f};
        cur = nxt; cA = nA; cB = nB; ++ui;
        if constexpr (ALIGN_EPI) { if (wr == 1) PG8_BAR; }
    }
    PG8_WAIT_V(0);
    if constexpr (!ALIGN_EPI) { if (wr == 0) PG8_BAR; }
    PG8_BAR;
    if constexpr (Epi::AFTER_DRAIN) { E.fused(acc, cur, wr, wc, fr, fq, lds, wid, lane); S.done(cur); }
#undef PG8_SA
#undef PG8_SB
#undef PG8_STAGE
#undef PG8_LDA
#undef PG8_LDB
#undef PG8_MMA
#undef PG8_WAIT_V
#undef PG8_WAIT_L
#undef PG8_BAR
#undef PG8_SCHED
}
}
#define DI __device__ __forceinline__
#define LAS __attribute__((address_space(3)))
typedef unsigned short bf16;
typedef short bf16x8 __attribute__((ext_vector_type(8)));
typedef short s16x4 __attribute__((ext_vector_type(4)));
typedef short v4i16_t __attribute__((ext_vector_type(4)));
typedef float f32x4 __attribute__((ext_vector_type(4)));
typedef float f32x2 __attribute__((ext_vector_type(2)));
typedef unsigned u32x4 __attribute__((ext_vector_type(4)));
typedef unsigned u32x2 __attribute__((ext_vector_type(2)));
typedef __bf16 bf16x2_t __attribute__((ext_vector_type(2)));

constexpr int NB = 8, SEQ = 2048, DM = 2048, M = NB * SEQ, DEPTH = 2, HD = 128, NH = 6;
constexpr int NPROJ = 6400, IN_TOTAL = 6412, FF = 5632;
constexpr int C_AU = 0, C_AV = 512, C_BQ = 1024, C_BK = 1792, C_BV = 2560, C_BG = 3328, C_CQ = 4096, C_CK = 4864, C_CV = 5632;
constexpr float EPS = 1e-6f, LOG2E = 1.4426950408889634f, LN2 = 0.6931471805599453f;
enum { I_X = 0, I_N1G, I_WIN, I_SGUG, I_WS, I_BS, I_CONVW, I_ALOG, I_DTB, I_ONG, I_QNG, I_KNG, I_WOUT, I_N2G, I_WGU, I_WDN };

constexpr size_t SZ_WIN = (size_t)NPROJ * DM * 2, SZ_WOUT = (size_t)DM * DM * 2, SZ_WGU = (size_t)2 * FF * DM * 2, SZ_WDN = (size_t)DM * FF * 2;
constexpr size_t SZ_WL = SZ_WIN + SZ_WOUT + SZ_WGU + SZ_WDN;
constexpr size_t WS_W = 0;
constexpr size_t WS_H = WS_W + DEPTH * SZ_WL;
constexpr size_t WS_PROJ = WS_H + (size_t)M * DM * 2;
constexpr size_t WS_BD = WS_PROJ + (size_t)M * NPROJ * 2;
constexpr size_t WS_DN = WS_BD + (size_t)M * 12 * 4;
constexpr int NCHUNK = NB * NH * 32;
constexpr size_t DN_WK = 0, DN_QG = 16384, DN_KDT = 32768, DN_UT = 49152, DN_ATT = 65536, DN_STRIDE = 73728;
constexpr size_t WS_GL = WS_DN + (size_t)NCHUNK * DN_STRIDE;
constexpr size_t WS_ODN = WS_GL + 8192;
constexpr size_t WS_OBR = WS_ODN + (size_t)M * 768 * 4;
constexpr size_t WS_LSE = WS_OBR + (size_t)3 * M * 768 * 2;
constexpr size_t WS_CTL = WS_LSE + (size_t)3 * M * 6 * 4;
constexpr size_t CTL_BYTES = 16384;
constexpr size_t WS_END = WS_CTL + CTL_BYTES;
constexpr int LDS_BYTES = 143360;
constexpr int NTHR = 512;
constexpr int NSCAN = 192;

DI unsigned pk2(float lo, float hi) { f32x2 v = {lo, hi}; bf16x2_t b = __builtin_convertvector(v, bf16x2_t); return __builtin_bit_cast(unsigned, b); }
DI float bflo(unsigned w) { return __uint_as_float(w << 16); }
DI float bfhi(unsigned w) { return __uint_as_float(w & 0xffff0000u); }
DI f32x4 mfma16(bf16x8 a, bf16x8 b, f32x4 c) { return __builtin_amdgcn_mfma_f32_16x16x32_bf16(a, b, c, 0, 0, 0); }
DI s16x4 tr4(const LAS unsigned char* p) { return __builtin_bit_cast(s16x4, __builtin_amdgcn_ds_read_tr16_b64_v4i16((LAS v4i16_t*)p)); }
DI bf16x8 tr_frag(const LAS unsigned char* p0, const LAS unsigned char* p1) { const s16x4 lo = tr4(p0), hi = tr4(p1); return __builtin_shufflevector(lo, hi, 0, 1, 2, 3, 4, 5, 6, 7); }
DI bf16x8 ld_frag(const LAS unsigned char* p) { return *(const LAS bf16x8*)p; }
DI void lds_barrier() { asm volatile("s_waitcnt lgkmcnt(0)" ::: "memory"); __builtin_amdgcn_s_barrier(); asm volatile("" ::: "memory"); }
DI int opaque(int x) { asm volatile("" : "+v"(x)); return x; }
DI float wave_sum(float v) {
#pragma unroll
    for (int o = 1; o < 64; o <<= 1) v += __shfl_xor(v, o);
    return v;
}
DI float sigmoid_f(float x) { return __builtin_amdgcn_rcpf(1.0f + __expf(-x)); }
DI float silu_f(float x) { return x * sigmoid_f(x); }
DI float gelu_tanh(float x) { const float u = 0.7978845608028654f * (x + 0.044715f * x * x * x); return x * sigmoid_f(2.0f * u); }
DI void unpack8(const u32x4 w, float* f) { f[0] = bflo(w.x); f[1] = bfhi(w.x); f[2] = bflo(w.y); f[3] = bfhi(w.y); f[4] = bflo(w.z); f[5] = bfhi(w.z); f[6] = bflo(w.w); f[7] = bfhi(w.w); }
DI u32x4 pack8(const float* f) { u32x4 w; w.x = pk2(f[0], f[1]); w.y = pk2(f[2], f[3]); w.z = pk2(f[4], f[5]); w.w = pk2(f[6], f[7]); return w; }
DI u32x2 pack4(const f32x4 v) { u32x2 w; w.x = pk2(v[0], v[1]); w.y = pk2(v[2], v[3]); return w; }

DI void transpose_item(const float* W, int K, int Nsrc, int src_col0, bf16* WT, int dst_row0, int k0, LAS float* scr, int lane) {
#pragma unroll 8
    for (int i = 0; i < 32; ++i) { const int kk = 2 * i + (lane >> 5); scr[kk * 33 + (lane & 31)] = W[(size_t)(k0 + kk) * Nsrc + src_col0 + (lane & 31)]; }
    asm volatile("s_waitcnt lgkmcnt(0)" ::: "memory");
    const int c = lane & 7;
#pragma unroll
    for (int j = 0; j < 4; ++j) { const int n = (lane >> 3) + 8 * j; const LAS float* s = scr + (8 * c) * 33 + n;
        u32x4 o; o.x = pk2(s[0 * 33], s[1 * 33]); o.y = pk2(s[2 * 33], s[3 * 33]); o.z = pk2(s[4 * 33], s[5 * 33]); o.w = pk2(s[6 * 33], s[7 * 33]);
        *(u32x4*)(WT + (size_t)(dst_row0 + n) * K + k0 + 8 * c) = o; }
    asm volatile("s_waitcnt lgkmcnt(0)" ::: "memory");
}
DI void weight_prep(const float* const* in, unsigned char* ws, LAS unsigned char* lds, int gw, int ngw, int wave, int lane) {
    LAS float* scr = (LAS float*)(lds + wave * 16384);
    constexpr int I_IN = (DM / 64) * (NPROJ / 32), I_OUT = (DM / 64) * (DM / 32), I_GU = (DM / 64) * (2 * FF / 32), I_DN = (FF / 64) * (DM / 32);
    constexpr int PER_L = I_IN + I_OUT + I_GU + I_DN;
    for (int it = gw; it < DEPTH * PER_L; it += ngw) {
        const int l = it / PER_L; int r = it % PER_L;
        unsigned char* wl = ws + WS_W + (size_t)l * SZ_WL;
        if (r < I_IN) { const int nblk = NPROJ / 32, kb = r / nblk, nb = r % nblk, n0 = nb * 32;
            transpose_item(in[I_WIN] + (size_t)l * DM * IN_TOTAL, DM, IN_TOTAL, n0 < 4096 ? n0 : n0 + 12, (bf16*)wl, n0, kb * 64, scr, lane); continue; }
        r -= I_IN;
        if (r < I_OUT) { const int nblk = DM / 32, kb = r / nblk, nb = r % nblk, n0 = nb * 32;
            transpose_item(in[I_WOUT] + (size_t)l * DM * DM, DM, DM, n0, (bf16*)(wl + SZ_WIN), n0, kb * 64, scr, lane); continue; }
        r -= I_OUT;
        if (r < I_GU) { const int nblk = 2 * FF / 32, kb = r / nblk, nb = r % nblk, n0 = nb * 32, pn = n0 >> 8, j = n0 & 255;
            transpose_item(in[I_WGU] + (size_t)l * DM * 2 * FF, DM, 2 * FF, j < 128 ? 128 * pn + j : FF + 128 * pn + (j - 128), (bf16*)(wl + SZ_WIN + SZ_WOUT), n0, kb * 64, scr, lane); continue; }
        r -= I_GU;
        { const int nblk = DM / 32, kb = r / nblk, nb = r % nblk, n0 = nb * 32;
            transpose_item(in[I_WDN] + (size_t)l * FF * DM, FF, DM, n0, (bf16*)(wl + SZ_WIN + SZ_WOUT + SZ_WGU), n0, kb * 64, scr, lane); }
    }
}

DI void norm_phase(const float* x, const float* g, bf16* h, const float* w_in_l, float* bd, LAS unsigned char* lds, int gw, int ngw, int tid0, int lane0) {
    const int tid = opaque(tid0), lane = tid & 63; (void)lane0;
    LAS f32x4* wl = (LAS f32x4*)lds;
    if (w_in_l) {
        for (int k = tid; k < DM; k += NTHR) {
            const f32x4* src = (const f32x4*)(w_in_l + (size_t)k * IN_TOTAL + 4096);
            const f32x4 a = src[0], b = src[1], c = src[2];
            const int j = k >> 8, l = (k >> 2) & 63, e = k & 3;
            LAS float* dst = (LAS float*)lds + ((size_t)(j * 12) * 64 + l) * 4 + e;
            dst[0 * 256] = a[0]; dst[1 * 256] = a[1]; dst[2 * 256] = a[2]; dst[3 * 256] = a[3];
            dst[4 * 256] = b[0]; dst[5 * 256] = b[1]; dst[6 * 256] = b[2]; dst[7 * 256] = b[3];
            dst[8 * 256] = c[0]; dst[9 * 256] = c[1]; dst[10 * 256] = c[2]; dst[11 * 256] = c[3];
        }
        __syncthreads();
    }
    f32x4 gv[8];
#pragma unroll
    for (int j = 0; j < 8; ++j) gv[j] = ((const f32x4*)g)[64 * j + lane];
    for (int row = gw; row < M; row += ngw) {
        const f32x4* xr = (const f32x4*)(x + (size_t)row * DM) + lane;
        f32x4 v[8]; float s = 0.f;
#pragma unroll
        for (int j = 0; j < 8; ++j) { v[j] = xr[64 * j]; s += (v[j][0] * v[j][0] + v[j][1] * v[j][1]) + (v[j][2] * v[j][2] + v[j][3] * v[j][3]); }
        const float rs = __builtin_amdgcn_rsqf(wave_sum(s) * (1.0f / DM) + EPS);
        u32x2* o8 = (u32x2*)(h + (size_t)row * DM) + lane;
#pragma unroll
        for (int j = 0; j < 8; ++j) { v[j] = v[j] * rs * gv[j]; u32x2 w; w.x = pk2(v[j][0], v[j][1]); w.y = pk2(v[j][2], v[j][3]); o8[64 * j] = w; }
        if (w_in_l) {
            float outv = 0.f;
            asm volatile("" ::: "memory");
#pragma unroll 1
            for (int c = 0; c < 12; ++c) {
                float acc = 0.f;
#pragma unroll
                for (int j = 0; j < 8; ++j) { const f32x4 w = wl[(j * 12 + c) * 64 + lane]; acc += (v[j][0] * w[0] + v[j][1] * w[1]) + (v[j][2] * w[2] + v[j][3] * w[3]); }
                acc = wave_sum(acc);
                if (lane == c) outv = acc;
            }
            if (lane < 12) bd[(size_t)row * 12 + lane] = outv;
        }
    }
    if (w_in_l) __syncthreads();
}
#define XB_TMO      128
#define XB_XCNT(j)  (256  + 64 * (j))
#define XB_XSUB(j)  (1280 + 64 * (j))
#define XB_XGEN(j)  (2304 + 64 * (j))
#define XB_TOP      3328
#define XB_TOPGEN   3392
#define XCD_BAR_WORDS 3456
#define XB_SPIN_CAP (1u << 18)

__device__ __forceinline__ unsigned xb_ld(unsigned* p)              { return __hip_atomic_load(p, __ATOMIC_RELAXED, __HIP_MEMORY_SCOPE_AGENT); }
__device__ __forceinline__ unsigned xb_add(unsigned* p, unsigned v) { return __hip_atomic_fetch_add(p, v, __ATOMIC_RELAXED, __HIP_MEMORY_SCOPE_AGENT); }
__device__ __forceinline__ unsigned xb_xcc_id() { return (unsigned)__builtin_amdgcn_s_getreg((3 << 11) | 20) & 0xFu; }
#define XB_SPIN(cond, bar) do { unsigned _sp = 0; while (cond) { __builtin_amdgcn_s_sleep(1); \
    if ((++_sp & 255u) == 0u) { if (xb_ld(&(bar)[XB_TMO])) break; if (_sp > XB_SPIN_CAP) { atomicAdd(&(bar)[XB_TMO], 1u); break; } } } } while (0)

struct XcdBarrier {
    unsigned* bar; unsigned x;
    volatile LAS unsigned* st;
};

__device__ __forceinline__ XcdBarrier xcd_barrier_post(unsigned* bar, volatile LAS unsigned* st) {
    XcdBarrier b; b.bar = bar; b.x = xb_xcc_id(); b.st = st;
    if (threadIdx.x == 0) (void)xb_add(&bar[XB_XCNT(b.x)], 1u);
    return b;
}
__device__ __forceinline__ void xcd_barrier_complete(unsigned* bar, unsigned x, unsigned& nloc, unsigned& nx) {
    const unsigned G = gridDim.x * gridDim.y * gridDim.z;
    unsigned sum, cnt, mine, sp = 0u;
    for (;;) {
        sum = 0u; cnt = 0u; mine = 0u;
#pragma unroll
        for (unsigned j = 0; j < 16; ++j) { const unsigned c = xb_ld(&bar[XB_XCNT(j)]); sum += c; cnt += (c > 0u) ? 1u : 0u; mine = (j == x) ? c : mine; }
        if (sum == G) break;
        __builtin_amdgcn_s_sleep(1);
        if ((++sp & 255u) == 0u) { if (xb_ld(&bar[XB_TMO])) break; if (sp > XB_SPIN_CAP) { atomicAdd(&bar[XB_TMO], 1u); break; } }
    }
    nloc = mine > 0u ? mine : 1u; nx = cnt > 0u ? cnt : 1u;
}

__device__ __forceinline__ void xcd_barrier(const XcdBarrier& b) {
    asm volatile("s_waitcnt vmcnt(0)" ::: "memory");
    __syncthreads();
    if (threadIdx.x == 0) {
        unsigned* bar = b.bar;
        __builtin_amdgcn_s_waitcnt(0);
        unsigned nloc = b.st[0], nx = b.st[1];
        if (nloc == 0u) { xcd_barrier_complete(bar, b.x, nloc, nx); b.st[0] = nloc; b.st[1] = nx; }
        const unsigned old = xb_add(&bar[XB_XSUB(b.x)], 1u);
        const unsigned gen = old / nloc;
        if (old + 1u == (gen + 1u) * nloc) {
            __builtin_amdgcn_fence(__ATOMIC_RELEASE, "agent");
            asm volatile("s_waitcnt vmcnt(0)" ::: "memory");
            const unsigned og = xb_add(&bar[XB_TOP], 1u);
            const unsigned tg = og / nx;
            if (og + 1u == (tg + 1u) * nx) xb_add(&bar[XB_TOPGEN], 1u);
            else XB_SPIN(xb_ld(&bar[XB_TOPGEN]) == tg, bar);
            __builtin_amdgcn_fence(__ATOMIC_ACQUIRE, "agent");
            xb_add(&bar[XB_XGEN(b.x)], 1u);
            asm volatile("s_waitcnt vmcnt(0)" ::: "memory");
        } else {
            XB_SPIN(xb_ld(&bar[XB_XGEN(b.x)]) == gen, bar);
            __builtin_amdgcn_fence(__ATOMIC_ACQUIRE, "agent");
            asm volatile("s_waitcnt vmcnt(0)" ::: "memory");
        }
    }
    __syncthreads();
}
DI void sgu_item(int item, const bf16* proj, const float* sgu_g, const float* w_s, const float* b_s, bf16* mix, LAS unsigned char* lds, int tid0) {
    const int tid = opaque(tid0);
    const int g = item & 3, c = (item >> 2) & 15, b = item >> 6;
    const size_t row0 = (size_t)b * SEQ + c * 128;
    LAS unsigned char* Vimg = lds; LAS unsigned char* Wimg = lds + 128 * 272;
    {
        const int i = tid >> 2, p = tid & 3;
        const bf16* src = proj + (row0 + i) * NPROJ + C_AV + g * 128 + p * 32;
        float y[32]; float ss = 0.f;
#pragma unroll
        for (int e = 0; e < 4; ++e) { const u32x4 raw = *(const u32x4*)(src + 8 * e); unpack8(raw, y + 8 * e); }
#pragma unroll
        for (int e = 0; e < 32; ++e) { y[e] = gelu_tanh(y[e]); ss += y[e] * y[e]; }
        ss += __shfl_xor(ss, 1); ss += __shfl_xor(ss, 2);
        const float rs = __builtin_amdgcn_rsqf(ss * (1.0f / 128.0f) + EPS);
        const float* gg = sgu_g + g * 128 + p * 32;
#pragma unroll
        for (int e = 0; e < 4; ++e) { float t[8];
#pragma unroll
            for (int k = 0; k < 8; ++k) t[k] = y[8 * e + k] * rs * gg[8 * e + k];
            *(LAS u32x4*)(Vimg + i * 272 + p * 64 + e * 16) = pack8(t); }
        const float* wsrc = w_s + ((size_t)g * 128 + i) * 128 + p * 32;
#pragma unroll
        for (int e = 0; e < 4; ++e) { const f32x4 a = *(const f32x4*)(wsrc + 8 * e), bb = *(const f32x4*)(wsrc + 8 * e + 4); float t[8];
#pragma unroll
            for (int k = 0; k < 4; ++k) { t[k] = (p * 32 + 8 * e + k <= i) ? a[k] : 0.f; t[4 + k] = (p * 32 + 8 * e + 4 + k <= i) ? bb[k] : 0.f; }
            *(LAS u32x4*)(Wimg + i * 272 + p * 64 + e * 16) = pack8(t); }
    }
    __syncthreads();
    const int w = tid >> 6, lane = tid & 63, r = lane & 15, q = lane >> 4;
    f32x4 acc[8];
#pragma unroll
    for (int dt = 0; dt < 8; ++dt) acc[dt] = (f32x4){0.f, 0.f, 0.f, 0.f};
    const int i = 16 * w + r; const float bsv = b_s[g * 128 + i];
    const bf16* up = proj + (row0 + i) * NPROJ + C_AU + g * 128 + 4 * q;
    u32x2 uua[8];
#pragma unroll
    for (int dt = 0; dt < 8; ++dt) uua[dt] = *(const u32x2*)(up + 16 * dt);
    const int nks = (16 * (w + 1) + 31) >> 5;
    for (int ks = 0; ks < nks; ++ks) {
        const bf16x8 bfr = ld_frag(Wimg + (16 * w + r) * 272 + (32 * ks + 8 * q) * 2);
#pragma unroll
        for (int dt = 0; dt < 8; ++dt) { const LAS unsigned char* p0 = Vimg + (32 * ks + 8 * q + (r >> 2)) * 272 + (16 * dt + 4 * (r & 3)) * 2;
            acc[dt] = mfma16(tr_frag(p0, p0 + 4 * 272), bfr, acc[dt]); }
    }
    bf16* op = mix + (row0 + i) * DM + g * 128 + 4 * q;
#pragma unroll
    for (int dt = 0; dt < 8; ++dt) { const u32x2 uu = uua[dt];
        f32x4 o; o[0] = gelu_tanh(bflo(uu.x)) * (acc[dt][0] + bsv); o[1] = gelu_tanh(bfhi(uu.x)) * (acc[dt][1] + bsv); o[2] = gelu_tanh(bflo(uu.y)) * (acc[dt][2] + bsv); o[3] = gelu_tanh(bfhi(uu.y)) * (acc[dt][3] + bsv);
        *(u32x2*)(op + 16 * dt) = pack4(o); }
    __syncthreads();
}

DI void attn_item(int item, const bf16* proj, const float* qg, const float* kg, bf16* obr, float* lse, LAS unsigned char* lds, int tid0) {
    const int tid = opaque(tid0);
    const int sub = item % 48, bh = item / 48, h = bh % NH, b = bh / NH;
    int br, rr, n;
    if (sub < 16) { br = 0; rr = 0; n = sub; } else if (sub < 32) { br = 1; rr = (sub - 16) >> 2; n = (sub - 16) & 3; } else { br = 2; rr = sub - 32; n = 0; }
    const int dil = 1 << (2 * br);
    LAS unsigned char* Kimg = lds; LAS unsigned char* Vimg = lds + 256 * 272;
    const bf16* base = proj + (size_t)b * SEQ * NPROJ + h * 128;
    {
        const int piece = tid & 15;
        float kgv[8];
#pragma unroll
        for (int e = 0; e < 8; ++e) kgv[e] = kg[piece * 8 + e];
        u32x4 kva[8], vva[8];
#pragma unroll
        for (int i = 0; i < 8; ++i) {
            const int row = (tid >> 4) + 32 * i, L = (n - 1) * 128 + row;
            kva[i] = (u32x4){0u, 0u, 0u, 0u}; vva[i] = (u32x4){0u, 0u, 0u, 0u};
            if (L >= 0) { const bf16* p = base + (size_t)(L * dil + rr) * NPROJ + piece * 8; kva[i] = *(const u32x4*)(p + C_CK); vva[i] = *(const u32x4*)(p + C_CV); }
        }
#pragma unroll
        for (int i = 0; i < 8; ++i) {
            const int row = (tid >> 4) + 32 * i;
            const u32x4 kv = kva[i], vv = vva[i];
            float kf[8]; unpack8(kv, kf); float ss = 0.f;
#pragma unroll
            for (int e = 0; e < 8; ++e) ss += kf[e] * kf[e];
            ss += __shfl_xor(ss, 1); ss += __shfl_xor(ss, 2); ss += __shfl_xor(ss, 4); ss += __shfl_xor(ss, 8);
            const float rs = __builtin_amdgcn_rsqf(ss * (1.0f / 128.0f) + EPS);
#pragma unroll
            for (int e = 0; e < 8; ++e) kf[e] = kf[e] * rs * kgv[e];
            *(LAS u32x4*)(Kimg + row * 272 + piece * 16) = pack8(kf);
            *(LAS u32x4*)(Vimg + row * 272 + piece * 16) = vv;
        }
    }
    const int w = tid >> 6, lane = tid & 63, r = lane & 15, q = lane >> 4;
    const int qi = 16 * w + r, tokq = (n * 128 + qi) * dil + rr;
    bf16x8 qf[4];
    {
        const bf16* qp = base + (size_t)tokq * NPROJ + C_CQ + 8 * q;
        float qv[32]; float ss = 0.f;
#pragma unroll
        for (int s = 0; s < 4; ++s) { const u32x4 raw = *(const u32x4*)(qp + 32 * s); unpack8(raw, qv + 8 * s); }
#pragma unroll
        for (int e = 0; e < 32; ++e) ss += qv[e] * qv[e];
        ss += __shfl_xor(ss, 16); ss += __shfl_xor(ss, 32);
        const float rs = (__builtin_amdgcn_rsqf(ss * (1.0f / 128.0f) + EPS)) * (0.08838834764831845f * LOG2E);
#pragma unroll
        for (int s = 0; s < 4; ++s) { float t[8];
#pragma unroll
            for (int e = 0; e < 8; ++e) t[e] = qv[8 * s + e] * rs * qg[32 * s + 8 * q + e];
            qf[s] = __builtin_bit_cast(bf16x8, pack8(t)); }
    }
    __syncthreads();
    const int kt0 = 2 * (w >> 1);
    f32x4 sc[10];
#pragma unroll
    for (int t = 0; t < 10; ++t) { f32x4 a4 = {0.f, 0.f, 0.f, 0.f};
#pragma unroll
        for (int s = 0; s < 4; ++s) a4 = mfma16(ld_frag(Kimg + (16 * (kt0 + t) + r) * 272 + (32 * s + 8 * q) * 2), qf[s], a4);
        sc[t] = a4; }
    const float sl2 = exp2f(-8.0f * (float)(h + 1) / 6.0f) * (float)dil * LOG2E;
    float mx = -INFINITY;
    {
        const int lb = 16 * kt0 + 4 * q - qi, lowcut = (n > 0) ? -1 : 127 - 16 * kt0 - 4 * q;
        const float bl = sl2 * (float)(lb - 128);
#pragma unroll
        for (int t = 0; t < 10; ++t)
#pragma unroll
            for (int jj = 0; jj < 4; ++jj) { const int cst = 16 * t + jj;
                const bool valid = ((unsigned)(cst + lb) <= 128u) && (cst > lowcut);
                const float v = valid ? sc[t][jj] + (sl2 * (float)cst + bl) : -INFINITY; sc[t][jj] = v; mx = fmaxf(mx, v); }
    }
    mx = fmaxf(mx, __shfl_xor(mx, 16)); mx = fmaxf(mx, __shfl_xor(mx, 32));
    float l = 0.f;
#pragma unroll
    for (int t = 0; t < 10; ++t)
#pragma unroll
        for (int jj = 0; jj < 4; ++jj) { const float p = __builtin_amdgcn_exp2f(sc[t][jj] - mx); sc[t][jj] = p; l += p; }
    l += __shfl_xor(l, 16); l += __shfl_xor(l, 32);
    bf16x8 pf[5];
#pragma unroll
    for (int pp = 0; pp < 5; ++pp) { u32x4 wv; wv.x = pk2(sc[2 * pp][0], sc[2 * pp][1]); wv.y = pk2(sc[2 * pp][2], sc[2 * pp][3]); wv.z = pk2(sc[2 * pp + 1][0], sc[2 * pp + 1][1]); wv.w = pk2(sc[2 * pp + 1][2], sc[2 * pp + 1][3]);
        pf[pp] = __builtin_bit_cast(bf16x8, wv); }
    f32x4 o[8];
#pragma unroll
    for (int dt = 0; dt < 8; ++dt) o[dt] = (f32x4){0.f, 0.f, 0.f, 0.f};
#pragma unroll
    for (int pp = 0; pp < 5; ++pp)
#pragma unroll
        for (int dt = 0; dt < 8; ++dt) { const LAS unsigned char* p0 = Vimg + (16 * (kt0 + 2 * pp) + 4 * q + (r >> 2)) * 272 + (16 * dt + 4 * (r & 3)) * 2;
            o[dt] = mfma16(tr_frag(p0, p0 + 16 * 272), pf[pp], o[dt]); }
    const float inv = __builtin_amdgcn_rcpf(l);
    const size_t orow = (size_t)br * M + (size_t)b * SEQ + tokq;
    bf16* op = obr + orow * 768 + h * 128 + 4 * q;
#pragma unroll
    for (int dt = 0; dt < 8; ++dt) *(u32x2*)(op + 16 * dt) = pack4(o[dt] * inv);
    if (q == 0) lse[orow * 6 + h] = (mx + __builtin_amdgcn_logf(l)) * LN2;
    __syncthreads();
}
DI void attn_combine(const bf16* obr, const float* lse, bf16* mix, int gi0, int nthreads) {
    const int gi = opaque(gi0);
    constexpr int UN = 4;
    for (int idx0 = gi; idx0 < M * 96; idx0 += nthreads * UN) {
        float l[UN][3]; u32x4 raw[UN][3]; int row[UN], c8[UN];
#pragma unroll
        for (int u = 0; u < UN; ++u) { int idx = idx0 + u * nthreads; if (idx >= M * 96) idx = M * 96 - 1; row[u] = idx / 96; c8[u] = idx % 96; const int h = c8[u] >> 4;
#pragma unroll
            for (int br = 0; br < 3; ++br) { l[u][br] = lse[((size_t)br * M + row[u]) * 6 + h]; raw[u][br] = *(const u32x4*)(obr + ((size_t)br * M + row[u]) * 768 + c8[u] * 8); } }
#pragma unroll
        for (int u = 0; u < UN; ++u) {
            const float mx = fmaxf(l[u][0], fmaxf(l[u][1], l[u][2]));
            float w0 = __expf(l[u][0] - mx), w1 = __expf(l[u][1] - mx), w2 = __expf(l[u][2] - mx); const float inv = 1.0f / (w0 + w1 + w2); w0 *= inv; w1 *= inv; w2 *= inv;
            float a[8], bq[8], cc[8]; unpack8(raw[u][0], a); unpack8(raw[u][1], bq); unpack8(raw[u][2], cc);
#pragma unroll
            for (int e = 0; e < 8; ++e) a[e] = w0 * a[e] + w1 * bq[e] + w2 * cc[e];
            if (idx0 + u * nthreads < M * 96) *(u32x4*)(mix + (size_t)row[u] * DM + 1280 + c8[u] * 8) = pack8(a);
        }
    }
}
DI void dn_conv_load(const bf16* proj, int b, int tpos, int col, u32x4* x) {
#pragma unroll
    for (int j = 0; j < 4; ++j) { const int tt = tpos - 3 + j;
        x[2 * j] = (u32x4){0u, 0u, 0u, 0u}; x[2 * j + 1] = (u32x4){0u, 0u, 0u, 0u};
        if (tt >= 0) { const bf16* p = proj + ((size_t)b * SEQ + tt) * NPROJ + col; x[2 * j] = *(const u32x4*)p; x[2 * j + 1] = *(const u32x4*)(p + 8); } }
}
DI void dn_conv16(const u32x4* x, const LAS float* cw  , float* y) {
    float acc[16];
#pragma unroll
    for (int e = 0; e < 16; ++e) acc[e] = 0.f;
#pragma unroll
    for (int j = 0; j < 4; ++j) {
        float xf[16]; unpack8(x[2 * j], xf); unpack8(x[2 * j + 1], xf + 8);
        const LAS f32x4* wp = (const LAS f32x4*)(cw + j * 128);
#pragma unroll
        for (int e4 = 0; e4 < 4; ++e4) { const f32x4 wv = wp[e4];
#pragma unroll
            for (int k = 0; k < 4; ++k) acc[4 * e4 + k] += wv[k] * xf[4 * e4 + k]; } }
#pragma unroll
    for (int e = 0; e < 16; ++e) y[e] = silu_f(acc[e]);
}
DI void dn_prep_item(int item, const bf16* proj, const float* bd, const float* conv_w, const float* a_log, const float* dt_bias, unsigned char* dnall, float* gl_out, LAS unsigned char* lds, int tid0) {
    const int tid = opaque(tid0);
    const int n = item & 31, bh = item >> 5, h = bh % NH, b = bh / NH, t0 = 64 * n;
    unsigned char* dn = dnall + (size_t)item * DN_STRIDE;
    LAS unsigned char* Kimg = lds; LAS unsigned char* Qimg = lds + 17408; LAS unsigned char* KBG = lds + 34816; LAS unsigned char* VB = lds + 52224;
    LAS unsigned char* Amat = lds + 69632; LAS unsigned char* Timg = lds + 87040; LAS float* G = (LAS float*)(lds + 96256); LAS float* BETA = (LAS float*)(lds + 96512);
    const int w = tid >> 6, lane = tid & 63, r = lane & 15, q = lane >> 4;
    LAS float* CW = (LAS float*)(lds + 101888);
    if (tid < 384) { const int tq = tid >> 7, rem = tid & 127, j = rem >> 5, c4 = (rem & 31) * 4;
        *(LAS f32x4*)(CW + (tq * 4 + j) * 128 + c4) = *(const f32x4*)(conv_w + (size_t)j * 2304 + tq * 768 + h * 128 + c4); }
    u32x4 xq[8], xk[8], xv[8];
    { const int i = tid >> 3, p = tid & 7;
      dn_conv_load(proj, b, t0 + i, C_BQ + h * 128 + 16 * p, xq); dn_conv_load(proj, b, t0 + i, C_BK + h * 128 + 16 * p, xk); dn_conv_load(proj, b, t0 + i, C_BV + h * 128 + 16 * p, xv); }
    if (w == 0) {
        const size_t row = (size_t)b * SEQ + t0 + lane;
        const float bl = bd[row * 12 + h], av = bd[row * 12 + 6 + h];
        const float xx = av + dt_bias[h];
        const float sp = xx > 20.f ? xx : log1pf(expf(xx));
        float gs = -expf(a_log[h]) * sp;
#pragma unroll
        for (int o = 1; o < 64; o <<= 1) { const float t = __shfl_up(gs, o); if (lane >= o) gs += t; }
        G[lane] = gs; BETA[lane] = 1.0f / (1.0f + expf(-bl));
    }
    __syncthreads();
    {
        const int i = tid >> 3, p = tid & 7;
        const float gi = G[i], bi = BETA[i], eg = __expf(gi);
        float y[16];
        dn_conv16(xq, CW + 0 * 512 + 16 * p, y);
        { float ss = 0.f;
#pragma unroll
            for (int e = 0; e < 16; ++e) ss += y[e] * y[e];
            ss += __shfl_xor(ss, 1); ss += __shfl_xor(ss, 2); ss += __shfl_xor(ss, 4);
            const float rs = __builtin_amdgcn_rsqf(ss + EPS) * 0.08838834764831845f;
            float t[16], tg[16];
#pragma unroll
            for (int e = 0; e < 16; ++e) { t[e] = y[e] * rs; tg[e] = t[e] * eg; }
            *(LAS u32x4*)(Qimg + i * 272 + p * 32) = pack8(t); *(LAS u32x4*)(Qimg + i * 272 + p * 32 + 16) = pack8(t + 8);
            *(u32x4*)(dn + DN_QG + (i * 128 + 16 * p) * 2) = pack8(tg); *(u32x4*)(dn + DN_QG + (i * 128 + 16 * p + 8) * 2) = pack8(tg + 8); }
        dn_conv16(xk, CW + 1 * 512 + 16 * p, y);
        { float ss = 0.f;
#pragma unroll
            for (int e = 0; e < 16; ++e) ss += y[e] * y[e];
            ss += __shfl_xor(ss, 1); ss += __shfl_xor(ss, 2); ss += __shfl_xor(ss, 4);
            const float rs = __builtin_amdgcn_rsqf(ss + EPS);
            float t[16], tg[16];
#pragma unroll
            for (int e = 0; e < 16; ++e) { t[e] = y[e] * rs; tg[e] = t[e] * (bi * eg); }
            *(LAS u32x4*)(Kimg + i * 272 + p * 32) = pack8(t); *(LAS u32x4*)(Kimg + i * 272 + p * 32 + 16) = pack8(t + 8);
            *(LAS u32x4*)(KBG + i * 272 + p * 32) = pack8(tg); *(LAS u32x4*)(KBG + i * 272 + p * 32 + 16) = pack8(tg + 8); }
        dn_conv16(xv, CW + 2 * 512 + 16 * p, y);
        { float t[16];
#pragma unroll
            for (int e = 0; e < 16; ++e) t[e] = y[e] * bi;
            *(LAS u32x4*)(VB + i * 272 + p * 32) = pack8(t); *(LAS u32x4*)(VB + i * 272 + p * 32 + 16) = pack8(t + 8); }
    }
    __syncthreads();
    {
        const int it = w & 3;
        const int i = 16 * it + r; const float gi = G[i], bi = BETA[i];
#pragma unroll
        for (int e = 0; e < 2; ++e) { const int jt = 2 * (w >> 2) + e;
            f32x4 kk = {0.f, 0.f, 0.f, 0.f}, qk = {0.f, 0.f, 0.f, 0.f};
#pragma unroll
            for (int s = 0; s < 4; ++s) { const bf16x8 a = ld_frag(Kimg + (16 * jt + r) * 272 + (32 * s + 8 * q) * 2);
                kk = mfma16(a, ld_frag(Kimg + (16 * it + r) * 272 + (32 * s + 8 * q) * 2), kk);
                qk = mfma16(a, ld_frag(Qimg + (16 * it + r) * 272 + (32 * s + 8 * q) * 2), qk); }
            f32x4 av, at;
#pragma unroll
            for (int jj = 0; jj < 4; ++jj) { const int j = 16 * jt + 4 * q + jj; const float dec = (j <= i) ? __expf(gi - G[j]) : 0.f;
                av[jj] = (j < i) ? bi * kk[jj] * dec : 0.f; at[jj] = qk[jj] * dec; }
            *(LAS f32x4*)(Amat + i * 272 + (16 * jt + 4 * q) * 4) = av;
            *(u32x2*)(dn + DN_ATT + (i * 64 + 16 * jt + 4 * q) * 2) = pack4(at); }
    }
    __syncthreads();
    LAS unsigned char* A21img = lds + 96768; LAS unsigned char* Ximg = lds + 99328;
    if (w == 0) {
        const int hb = lane >> 5, c = lane & 31;
        unsigned abv = (unsigned)(size_t)(Amat + hb * (32 * 272 + 32 * 4));
        float N[32];
#pragma unroll
        for (int i = 0; i < 32; ++i) {
            const LAS unsigned char* ab = (const LAS unsigned char*)(size_t)abv;
            float s0 = *(const LAS float*)(ab + i * 272 + c * 4), s1 = 0.f, s2 = 0.f, s3 = 0.f;
#pragma unroll
            for (int j4 = 0; j4 < (i + 3) / 4; ++j4) { const f32x4 a4 = *(const LAS f32x4*)(ab + i * 272 + j4 * 16);
                if (4 * j4 + 0 < i) s0 += a4[0] * N[4 * j4 + 0];
                if (4 * j4 + 1 < i) s1 += a4[1] * N[4 * j4 + 1];
                if (4 * j4 + 2 < i) s2 += a4[2] * N[4 * j4 + 2];
                if (4 * j4 + 3 < i) s3 += a4[3] * N[4 * j4 + 3]; }
            N[i] = -((s0 + s1) + (s2 + s3));
            if (i & 1) asm volatile("" : "+v"(abv) : "v"(N[i]));
        }
        LAS unsigned char* tb = Timg + (32 * hb) * 144 + (32 * hb + c) * 2;
#pragma unroll
        for (int i = 0; i < 32; i += 2) { const unsigned pr = pk2(N[i], N[i + 1]);
            *(LAS unsigned short*)(tb + i * 144) = (unsigned short)(pr & 0xffffu);
            *(LAS unsigned short*)(tb + (i + 1) * 144) = (unsigned short)(pr >> 16); }
        asm volatile("s_waitcnt lgkmcnt(0)" ::: "memory");
        *(LAS unsigned short*)(tb + c * 144) = (unsigned short)0x3F80u;
    } else if (w == 1) {
        const int i = lane >> 1, hf = lane & 1;
        *(LAS u32x4*)(Timg + i * 144 + 64 + hf * 32) = (u32x4){0u, 0u, 0u, 0u}; *(LAS u32x4*)(Timg + i * 144 + 64 + hf * 32 + 16) = (u32x4){0u, 0u, 0u, 0u};
    } else if (w < 4) {
        const int t = (w - 2) * 64 + lane, i = t >> 2, j0 = (t & 3) * 8;
        const f32x4 a = *(const LAS f32x4*)(Amat + (32 + i) * 272 + j0 * 4), bb = *(const LAS f32x4*)(Amat + (32 + i) * 272 + j0 * 4 + 16);
        u32x4 o; o.x = pk2(a[0], a[1]); o.y = pk2(a[2], a[3]); o.z = pk2(bb[0], bb[1]); o.w = pk2(bb[2], bb[3]);
        *(LAS u32x4*)(A21img + i * 80 + j0 * 2) = o;
    }
    __syncthreads();
    if (w < 4) {
        const int it = w >> 1, ctile = w & 1;
        const LAS unsigned char* p0 = Timg + (8 * q + (r >> 2)) * 144 + (16 * ctile + 4 * (r & 3)) * 2;
        const f32x4 x = mfma16(tr_frag(p0, p0 + 4 * 144), ld_frag(A21img + (16 * it + r) * 80 + 16 * q), (f32x4){0.f, 0.f, 0.f, 0.f});
        *(LAS u32x2*)(Ximg + (16 * it + r) * 80 + (16 * ctile + 4 * q) * 2) = pack4(x);
    }
    __syncthreads();
    if (w < 4) {
        const int it = w >> 1, ctile = w & 1;
        const LAS unsigned char* p0 = Ximg + (8 * q + (r >> 2)) * 80 + (16 * ctile + 4 * (r & 3)) * 2;
        const f32x4 y = mfma16(tr_frag(p0, p0 + 4 * 80), ld_frag(Timg + (32 + 16 * it + r) * 144 + (32 + 8 * q) * 2), (f32x4){0.f, 0.f, 0.f, 0.f});
        *(LAS u32x2*)(Timg + (32 + 16 * it + r) * 144 + (16 * ctile + 4 * q) * 2) = pack4(-y);
    }
    __syncthreads();
    {
        const int ct = w & 3; const float glast = G[63];
        bf16x8 tf[2];
#pragma unroll
        for (int ks = 0; ks < 2; ++ks) tf[ks] = ld_frag(Timg + (16 * ct + r) * 144 + (32 * ks + 8 * q) * 2);
        float dk4[4];
#pragma unroll
        for (int jj = 0; jj < 4; ++jj) dk4[jj] = __expf(glast - G[16 * ct + 4 * q + jj]);
#pragma unroll
        for (int e = 0; e < 4; ++e) { const int dt = 4 * (w >> 2) + e;
            f32x4 au = {0.f, 0.f, 0.f, 0.f}, aw = {0.f, 0.f, 0.f, 0.f};
#pragma unroll
            for (int ks = 0; ks < 2; ++ks) { const int ro = (32 * ks + 8 * q + (r >> 2)) * 272 + (16 * dt + 4 * (r & 3)) * 2;
                au = mfma16(tf[ks], tr_frag(VB + ro, VB + ro + 4 * 272), au);
                aw = mfma16(tr_frag(KBG + ro, KBG + ro + 4 * 272), tf[ks], aw); }
            *(u32x2*)(dn + DN_UT + ((16 * dt + r) * 64 + 16 * ct + 4 * q) * 2) = pack4(au);
            *(u32x2*)(dn + DN_WK + ((16 * ct + r) * 128 + 16 * dt + 4 * q) * 2) = pack4(aw);
            const s16x4 kv = tr4(Kimg + (16 * ct + 4 * q + (r >> 2)) * 272 + (16 * dt + 4 * (r & 3)) * 2);
            f32x4 kd;
#pragma unroll
            for (int jj = 0; jj < 4; ++jj) kd[jj] = __uint_as_float(((unsigned)(unsigned short)kv[jj]) << 16) * dk4[jj];
            *(u32x2*)(dn + DN_KDT + ((16 * dt + r) * 64 + 16 * ct + 4 * q) * 2) = pack4(kd); }
        if (tid == 0) gl_out[item] = expf(glast);
    }
    __syncthreads();
}
struct ScanOps { bf16x8 wf[4], qf[4], af[2], kf[2][2]; u32x2 uu; float g; };
DI void scan_load(ScanOps& o, const unsigned char* dn, const float* gl, int ci, int ct, int dvq, int dvt, int nt0, int r, int q) {
#pragma unroll
    for (int ks = 0; ks < 4; ++ks) { o.wf[ks] = *(const bf16x8*)(dn + DN_WK + ((16 * ct + r) * 128 + 32 * ks + 8 * q) * 2); o.qf[ks] = *(const bf16x8*)(dn + DN_QG + ((16 * ct + r) * 128 + 32 * ks + 8 * q) * 2); }
    o.uu = *(const u32x2*)(dn + DN_UT + ((dvq * 32 + 16 * dvt + r) * 64 + 16 * ct + 4 * q) * 2);
#pragma unroll
    for (int ks = 0; ks < 2; ++ks) o.af[ks] = *(const bf16x8*)(dn + DN_ATT + ((16 * ct + r) * 64 + 32 * ks + 8 * q) * 2);
#pragma unroll
    for (int e = 0; e < 2; ++e)
#pragma unroll
        for (int ks = 0; ks < 2; ++ks) o.kf[e][ks] = *(const bf16x8*)(dn + DN_KDT + ((16 * (nt0 + e) + r) * 64 + 32 * ks + 8 * q) * 2);
    o.g = gl[ci];
}
DI void scan_step(const ScanOps& c, f32x4 (&Sacc)[2], float* op, LAS unsigned char* Simg, LAS unsigned char* VNT, int ct, int dvt, int mt, int nt0, int r, int q) {
    f32x4 wsa = {0.f, 0.f, 0.f, 0.f}, qsa = {0.f, 0.f, 0.f, 0.f};
#pragma unroll
    for (int ks = 0; ks < 4; ++ks) { const LAS unsigned char* p0 = Simg + (32 * ks + 8 * q + (r >> 2)) * 80 + (16 * dvt + 4 * (r & 3)) * 2;
        const bf16x8 sf = tr_frag(p0, p0 + 4 * 80);
        wsa = mfma16(c.wf[ks], sf, wsa); qsa = mfma16(c.qf[ks], sf, qsa); }
    { const int dv = 16 * dvt + r; const u32x2 uu = c.uu;
      f32x4 vn; vn[0] = bflo(uu.x) - wsa[0]; vn[1] = bfhi(uu.x) - wsa[1]; vn[2] = bflo(uu.y) - wsa[2]; vn[3] = bfhi(uu.y) - wsa[3];
      *(LAS u32x2*)(VNT + dv * 144 + (16 * ct + 4 * q) * 2) = pack4(vn); }
    lds_barrier();
#pragma unroll
    for (int ks = 0; ks < 2; ++ks) qsa = mfma16(c.af[ks], ld_frag(VNT + (16 * dvt + r) * 144 + (32 * ks + 8 * q) * 2), qsa);
#pragma unroll
    for (int jj = 0; jj < 4; ++jj) op[(size_t)jj * 768] = qsa[jj];
    bf16x8 af2[2];
#pragma unroll
    for (int ks = 0; ks < 2; ++ks) af2[ks] = ld_frag(VNT + (16 * mt + r) * 144 + (32 * ks + 8 * q) * 2);
#pragma unroll
    for (int e = 0; e < 2; ++e) { Sacc[e] = Sacc[e] * c.g;
#pragma unroll
        for (int ks = 0; ks < 2; ++ks) Sacc[e] = mfma16(af2[ks], c.kf[e][ks], Sacc[e]);
        *(LAS u32x2*)(Simg + (16 * (nt0 + e) + r) * 80 + (16 * mt + 4 * q) * 2) = pack4(Sacc[e]); }
    lds_barrier();
}
DI void dn_scan_item(int item, const unsigned char* dnall, const float* gl, float* odn, LAS unsigned char* lds, int tid0) {
    const int tid = opaque(tid0);
    const int dvq = item & 3, bh = item >> 2, h = bh % NH, b = bh / NH;
    LAS unsigned char* Simg = lds; LAS unsigned char* VNT = lds + 10240;
    for (int u = tid; u < 10240 / 16; u += NTHR) *(LAS u32x4*)(Simg + u * 16) = (u32x4){0u, 0u, 0u, 0u};
    const int w = tid >> 6, lane = tid & 63, r = lane & 15, q = lane >> 4;
    const int ct = w >> 1, dvt = w & 1, mt = w & 1, nt0 = 2 * (w >> 1);
    f32x4 Sacc[2];
#pragma unroll
    for (int e = 0; e < 2; ++e) Sacc[e] = (f32x4){0.f, 0.f, 0.f, 0.f};
    const unsigned char* dn0 = dnall + (size_t)(bh * 32) * DN_STRIDE;
    float* op0 = odn + ((size_t)b * SEQ + 16 * ct + 4 * q) * 768 + h * 128 + dvq * 32 + 16 * dvt + r;
    ScanOps A, B;
    scan_load(A, dn0, gl, bh * 32, ct, dvq, dvt, nt0, r, q);
    __syncthreads();
#pragma unroll 1
    for (int n = 0; n < 32; n += 2) {
        scan_load(B, dn0 + (size_t)(n + 1) * DN_STRIDE, gl, bh * 32 + n + 1, ct, dvq, dvt, nt0, r, q);
        scan_step(A, Sacc, op0 + (size_t)(64 * n) * 768, Simg, VNT, ct, dvt, mt, nt0, r, q);
        const int n2 = (n + 2 < 32) ? n + 2 : 31;
        scan_load(A, dn0 + (size_t)n2 * DN_STRIDE, gl, bh * 32 + n2, ct, dvq, dvt, nt0, r, q);
        scan_step(B, Sacc, op0 + (size_t)(64 * (n + 1)) * 768, Simg, VNT, ct, dvt, mt, nt0, r, q);
    }
    __syncthreads();
}
DI void dn_gate_phase(const float* odn, const bf16* proj, const float* ong, bf16* mix, int gw, int ngw, int lane0) {
    const int lane = opaque(lane0);
    const int sub = lane >> 4, l16 = lane & 15;
    float gv[8];
#pragma unroll
    for (int e = 0; e < 8; ++e) gv[e] = ong[l16 * 8 + e];
    constexpr int UN = 4, NIT = M * NH / 4;
    for (int it0 = gw; it0 < NIT; it0 += ngw * UN) {
        f32x4 o0[UN], o1[UN]; u32x4 graw[UN]; int row[UN], hh[UN];
#pragma unroll
        for (int u = 0; u < UN; ++u) { int it = it0 + u * ngw; if (it >= NIT) it = NIT - 1; const int idx = it * 4 + sub; row[u] = idx / NH; hh[u] = idx % NH;
            const float* op = odn + (size_t)row[u] * 768 + hh[u] * 128 + l16 * 8; o0[u] = *(const f32x4*)op; o1[u] = *(const f32x4*)(op + 4);
            graw[u] = *(const u32x4*)(proj + (size_t)row[u] * NPROJ + C_BG + hh[u] * 128 + l16 * 8); }
#pragma unroll
        for (int u = 0; u < UN; ++u) {
            float ss = (o0[u][0] * o0[u][0] + o0[u][1] * o0[u][1]) + (o0[u][2] * o0[u][2] + o0[u][3] * o0[u][3]) + (o1[u][0] * o1[u][0] + o1[u][1] * o1[u][1]) + (o1[u][2] * o1[u][2] + o1[u][3] * o1[u][3]);
            ss += __shfl_xor(ss, 1); ss += __shfl_xor(ss, 2); ss += __shfl_xor(ss, 4); ss += __shfl_xor(ss, 8);
            const float rs = __builtin_amdgcn_rsqf(ss * (1.0f / 128.0f) + EPS);
            float gt[8]; unpack8(graw[u], gt);
            float y[8];
#pragma unroll
            for (int e = 0; e < 4; ++e) { y[e] = o0[u][e] * rs * gv[e] * silu_f(gt[e]); y[4 + e] = o1[u][e] * rs * gv[4 + e] * silu_f(gt[4 + e]); }
            if (it0 + u * ngw < NIT) *(u32x4*)(mix + (size_t)row[u] * DM + 512 + hh[u] * 128 + l16 * 8) = pack8(y);
        }
    }
}

struct Args { const float* in[16]; float* out; unsigned char* ws; };
#ifndef MK_SKIP_MIX
#define MK_SKIP_MIX 0
#endif
#ifndef REP_M1
#define REP_M1 1
#endif
#ifndef REP_M2
#define REP_M2 1
#endif
#ifndef REP_G13
#define REP_G13 1
#endif
__global__ void __launch_bounds__(NTHR, 2) hybrid_fwd(Args a) {
    extern __shared__ __attribute__((aligned(16))) unsigned char lds_raw[];
    LAS unsigned char* lds = (LAS unsigned char*)lds_raw;
    cg::grid_group grid = cg::this_grid();
    volatile LAS unsigned* bst = (volatile LAS unsigned*)(lds + LDS_BYTES - 64);
    if (threadIdx.x < 2) bst[threadIdx.x] = 0u;
    __syncthreads();
    const XcdBarrier xbar = xcd_barrier_post((unsigned*)(a.ws + WS_CTL), bst);
    const int tid = threadIdx.x, lane = tid & 63, wave = __builtin_amdgcn_readfirstlane(tid >> 6);
    const int G = gridDim.x, bx = blockIdx.x, gw = bx * 8 + wave, ngw = G * 8;
    unsigned char* ws = a.ws;
    bf16* Hb = (bf16*)(ws + WS_H); bf16* PROJ = (bf16*)(ws + WS_PROJ); float* BD = (float*)(ws + WS_BD); unsigned char* DN = ws + WS_DN; float* GL = (float*)(ws + WS_GL);
    float* ODN = (float*)(ws + WS_ODN); bf16* OBR = (bf16*)(ws + WS_OBR); float* LSE = (float*)(ws + WS_LSE);
    bf16* MIX = Hb; bf16* ACT = PROJ;

#ifdef EXTRA_SYNCS
    for (int es = 0; es < EXTRA_SYNCS; ++es) xcd_barrier(xbar);
#endif
    weight_prep(a.in, ws, lds, gw, ngw, wave, lane);
#ifdef REP_P0
    __syncthreads(); weight_prep(a.in, ws, lds, gw, ngw, wave, lane);
#endif
    __syncthreads();
    norm_phase(a.in[I_X], a.in[I_N1G], Hb, a.in[I_WIN], BD, lds, gw, ngw, tid, lane);
    grid.sync();
#ifndef REP_MASK
#define REP_MASK 0
#endif
    bool rep_done = false;
#pragma unroll 1
    for (int s = 1; s < DEPTH * 9; ++s) {
        const int l = s / 9, ph = s - 9 * l;
        const unsigned char* wl = ws + WS_W + (size_t)l * SZ_WL;
        if (ph == 0) {
            norm_phase(a.out, a.in[I_N1G] + (size_t)l * DM, Hb, a.in[I_WIN] + (size_t)l * DM * IN_TOTAL, BD, lds, gw, ngw, tid, lane);
        } else if (ph == 1) {
            pg8::Gemm g{Hb, (const bf16*)wl, M, NPROJ, DM}; pg8::StaticOrder S; S.init(M, NPROJ, G, bx);
            pg8::EpiBf16<0> E{PROJ, NPROJ, nullptr, 0, 0, 1.f};
            pg8::gemm_phase<pg8::EpiBf16<0>, pg8::StaticOrder, true, true>(lds, g, S, E);
        } else if (ph == 2) {
#ifndef M1_REP_TYPE
#define M1_REP_TYPE -1
#endif
            for (int it = bx; it < 2304 + 1536 + 512; it += G)
            for (int rr = 0; rr < (((it < 2304) ? 0 : (it < 3840) ? 1 : 2) == M1_REP_TYPE ? 2 : 1); ++rr) {
                if (it < 2304) attn_item(it, PROJ, a.in[I_QNG] + l * HD, a.in[I_KNG] + l * HD, OBR, LSE, lds, tid);
                else if (it < 2304 + 1536) dn_prep_item(it - 2304, PROJ, BD, a.in[I_CONVW] + (size_t)l * 4 * 2304, a.in[I_ALOG] + l * NH, a.in[I_DTB] + l * NH, DN, GL, lds, tid);
                else sgu_item(it - 3840, PROJ, a.in[I_SGUG] + l * 512, a.in[I_WS] + (size_t)l * 4 * 128 * 128, a.in[I_BS] + l * 512, MIX, lds, tid);
            }
        } else if (ph == 3) {
            if (G > NSCAN) {
                if (bx < NSCAN) { const int xcd = bx & 7, slot = bx >> 3;
                    dn_scan_item(((xcd * 6 + (slot >> 2)) << 2) | (slot & 3), DN, GL, ODN, lds, tid); }
                else attn_combine(OBR, LSE, MIX, (bx - NSCAN) * NTHR + tid, (G - NSCAN) * NTHR);
            } else {
                for (int it = bx; it < NSCAN; it += G) { dn_scan_item(it, DN, GL, ODN, lds, tid); __syncthreads(); }
                attn_combine(OBR, LSE, MIX, bx * NTHR + tid, G * NTHR);
            }
        } else if (ph == 4) {
            dn_gate_phase(ODN, PROJ, a.in[I_ONG] + l * HD, MIX, gw, ngw, lane);
        } else if (ph == 5) {
            pg8::Gemm g{MIX, (const bf16*)(wl + SZ_WIN), M, DM, DM}; pg8::StaticOrder S; S.init(M, DM, G, bx);
            pg8::EpiResF32 E{(l == 0) ? a.in[I_X] : a.out, a.out, DM};
            pg8::gemm_phase<pg8::EpiResF32, pg8::StaticOrder, true, true>(lds, g, S, E);
        } else if (ph == 6) {
            norm_phase(a.out, a.in[I_N2G] + (size_t)l * DM, Hb, nullptr, nullptr, lds, gw, ngw, tid, lane);
        } else if (ph == 7) {
            pg8::Gemm g{Hb, (const bf16*)(wl + SZ_WIN + SZ_WOUT), M, 2 * FF, DM}; pg8::StaticOrder S; S.init(M, 2 * FF, G, bx);
            pg8::EpiSwiGLU E{ACT, FF};
            pg8::gemm_phase<pg8::EpiSwiGLU, pg8::StaticOrder, true, true>(lds, g, S, E);
        } else {
            pg8::Gemm g{ACT, (const bf16*)(wl + SZ_WIN + SZ_WOUT + SZ_WGU), M, DM, FF}; pg8::StaticOrder S; S.init(M, DM, G, bx);
            pg8::EpiResF32 E{a.out, a.out, DM};
            pg8::gemm_phase<pg8::EpiResF32, pg8::StaticOrder, true, true>(lds, g, S, E);
        }
        if (s + 1 < DEPTH * 9) xcd_barrier(xbar);
        if (REP_MASK) { if (((REP_MASK >> ph) & 1) && !rep_done) { --s; rep_done = true; } else rep_done = false; }
    }
}

extern "C" void kernel_launch(void* const* d_in, const int* in_sizes, int n_in, void* d_out, int out_size, void* d_ws, size_t ws_size, hipStream_t stream) {
    static int grid = 0;
    if (grid == 0) {
        if (n_in != 16 || in_sizes[0] != M * DM || out_size != M * DM || ws_size < WS_END) { fprintf(stderr, "kernel_launch: unexpected shapes / workspace (n_in %d, ws %zu, need %zu); nothing launched\n", n_in, ws_size, (size_t)WS_END); grid = -1; return; }
        int dev = 0, cus = 0, per_cu = 0;
        if (hipGetDevice(&dev) != hipSuccess || hipDeviceGetAttribute(&cus, hipDeviceAttributeMultiprocessorCount, dev) != hipSuccess) { grid = -1; return; }
        if (hipFuncSetAttribute((const void*)hybrid_fwd, hipFuncAttributeMaxDynamicSharedMemorySize, LDS_BYTES) != hipSuccess) { fprintf(stderr, "kernel_launch: hipFuncSetAttribute failed\n"); grid = -1; return; }
        if (hipOccupancyMaxActiveBlocksPerMultiprocessor(&per_cu, (const void*)hybrid_fwd, NTHR, LDS_BYTES) != hipSuccess || per_cu < 1) { fprintf(stderr, "kernel_launch: occupancy query says %d blocks per CU\n", per_cu); per_cu = 1; }
        (void)hipGetLastError();
        grid = cus;
    }
    if (grid < 0) return;
    if (hipMemsetAsync((char*)d_ws + WS_CTL, 0, CTL_BYTES, stream) != hipSuccess) { fprintf(stderr, "kernel_launch: memset of the barrier words failed\n"); return; }
    Args a{};
    for (int i = 0; i < 16; ++i) a.in[i] = (const float*)d_in[i];
    a.out = (float*)d_out; a.ws = (unsigned char*)d_ws;
    void* args[] = {&a};
    hipError_t e = hipLaunchCooperativeKernel((const void*)hybrid_fwd, dim3(grid), dim3(NTHR), args, LDS_BYTES, stream);
    if (e != hipSuccess) fprintf(stderr, "kernel_launch: cooperative launch failed: %s (grid %d)\n", hipGetErrorString(e), grid);
}
```

```cpp
#include <hip/hip_runtime.h>
#include <hip/hip_cooperative_groups.h>
#include <cstdio>
#include <cstdint>
namespace cg = cooperative_groups;
namespace pg8 {
#define PG8_LAS __attribute__((address_space(3)))
typedef unsigned short bf16_t;
typedef short bf16x8 __attribute__((ext_vector_type(8)));
typedef float f32x4 __attribute__((ext_vector_type(4)));
typedef unsigned u32x4 __attribute__((ext_vector_type(4)));
constexpr int BM = 256, BK = 64, HALF = 128, HTB = HALF * BK * 2  , STAGE_BYTES = 8 * HTB, NXCD = 8, WGM = 8;

__host__ __device__ __forceinline__ int lds_byte(int r, int c) { const int st = (r >> 4) * 2 + (c >> 5), rr = r & 15, cc = c & 31, ob = rr * 64 + cc * 2; return st * 1024 + (ob ^ (((ob >> 9) & 1) << 5)); }
__host__ __device__ __forceinline__ void stage_rc(int b, int& R, int& C) { const int st = b / 1024, sb = b % 1024, swz = sb ^ (((sb >> 9) & 1) << 5); R = (st >> 1) * 16 + swz / 64; C = (st & 1) * 32 + (swz % 64) / 2; }
__host__ __device__ __forceinline__ int perm32(int rho) { const int n = rho >> 4, i = rho & 15; return 8 * (i >> 2) + 4 * n + (i & 3); }

struct Unit { int pm, pn; };
struct Gemm { const bf16_t* A; const bf16_t* Bt; int M, N, K; };

struct StaticOrder {
    int nM, nN, nwg, G, c;
    __host__ __device__ void init(int M, int N, int G_, int c_) { nM = M / BM; nN = N / BM; nwg = nM * nN; G = G_; c = c_; }
    __host__ __device__ bool next(int i, Unit& u) const {
        const long L = (long)i * G + c; if (L >= nwg) return false;
        int wgid = (int)L; { const int q = nwg / NXCD, r = nwg % NXCD, xcd = wgid % NXCD, off = wgid / NXCD; wgid = (xcd < r ? xcd * (q + 1) : r * (q + 1) + (xcd - r) * q) + off; }
        const int nig = WGM * nN, gid = wgid / nig, fm = gid * WGM, gsz = (nM - fm) < WGM ? (nM - fm) : WGM;
        u.pm = fm + ((wgid % nig) % gsz); u.pn = (wgid % nig) / gsz; return true;
    }
    __device__ __forceinline__ void a_ready(const Unit&) const {}
    __device__ __forceinline__ void done(const Unit&) const {}
};

__device__ __forceinline__ unsigned cvt_pk_bf16(float lo, float hi) { unsigned r; asm volatile("v_cvt_pk_bf16_f32 %0, %1, %2" : "=v"(r) : "v"(lo), "v"(hi)); return r; }
typedef float f32x2 __attribute__((ext_vector_type(2)));
__device__ __forceinline__ f32x2 gelu_pk(f32x2 v) {
    const f32x2 av = __builtin_elementwise_abs(v), d = av * 0.2316418882f + 1.0f;
    f32x2 t; t.x = __builtin_amdgcn_rcpf(d.x); t.y = __builtin_amdgcn_rcpf(d.y);
    f32x2 q = t * 0.5307027145f + (-0.7265760135f); q = q * t + 0.7107068705f; q = q * t + (-0.142248368f); q = q * t + 0.127414796f; q = q * t;
    const f32x2 s = (v * v) * (-0.72134752044f);
    f32x2 e; e.x = __builtin_amdgcn_exp2f(s.x); e.y = __builtin_amdgcn_exp2f(s.y);
    const f32x2 m = v * (q * e), r = v - m;
    f32x2 o; o.x = v.x < 0.f ? m.x : r.x; o.y = v.y < 0.f ? m.y : r.y; return o;
}

template <int ACT  > struct EpiBf16 {
    static constexpr bool PERM = true, AFTER_DRAIN = false; static_assert(ACT == 0 || ACT == 1, "EpiBf16: ACT is 0 (none) or 1 (gelu_pk)");
    bf16_t* O; int ldc; const float* bias; int split_cols; size_t split_stride; float scale0;
    __device__ __forceinline__ void operator()(const f32x4 (&acc)[2][2][4][2], const Unit& u, int wr, int wc, int fr, int fq) const {
        const int row0 = u.pm * BM + wr * 64 + fr; int colt = u.pn * BM; bf16_t* base = O;
        float sc = 1.f; if (split_cols) { const int t = colt / split_cols; base += (size_t)t * split_stride; colt -= t * split_cols; if (t == 0) sc = scale0; }
        const int col0 = colt + wc * 32 + 8 * fq, bcol0 = u.pn * BM + wc * 32 + 8 * fq;
        f32x4 bv[2][2];
#pragma unroll
        for (int bj = 0; bj < 2; ++bj)
#pragma unroll
            for (int n = 0; n < 2; ++n) bv[bj][n] = bias ? *(const f32x4*)(bias + bcol0 + bj * HALF + 4 * n) : (f32x4){0.f, 0.f, 0.f, 0.f};
#pragma unroll
        for (int ai = 0; ai < 2; ++ai)
#pragma unroll
            for (int m = 0; m < 4; ++m) { bf16_t* rowp = base + (size_t)(row0 + ai * HALF + m * 16) * ldc + col0;
#pragma unroll
                for (int bj = 0; bj < 2; ++bj) { f32x4 v0 = acc[ai][bj][m][0] + bv[bj][0], v1 = acc[ai][bj][m][1] + bv[bj][1];
                    if (ACT == 1) { f32x2 a = gelu_pk((f32x2){v0[0], v0[1]}), b = gelu_pk((f32x2){v0[2], v0[3]}), c = gelu_pk((f32x2){v1[0], v1[1]}), d = gelu_pk((f32x2){v1[2], v1[3]});
                        v0 = (f32x4){a.x, a.y, b.x, b.y}; v1 = (f32x4){c.x, c.y, d.x, d.y}; }
                    v0 = v0 * sc; v1 = v1 * sc; u32x4 w; w.x = cvt_pk_bf16(v0[0], v0[1]); w.y = cvt_pk_bf16(v0[2], v0[3]); w.z = cvt_pk_bf16(v1[0], v1[1]); w.w = cvt_pk_bf16(v1[2], v1[3]);
                    *(u32x4*)(rowp + bj * HALF) = w; } }
    }
};
struct EpiResF32 {
    static constexpr bool PERM = false, AFTER_DRAIN = false;
    const float* base; float* out; int ldc;
    __device__ __forceinline__ void operator()(const f32x4 (&acc)[2][2][4][2], const Unit& u, int wr, int wc, int fr, int fq) const {
        const int row0 = u.pm * BM + wr * 64 + fr; const int col0 = u.pn * BM + wc * 32 + 4 * fq;
#pragma unroll
        for (int ai = 0; ai < 2; ++ai)
#pragma unroll
            for (int m = 0; m < 4; ++m) { const size_t off = (size_t)(row0 + ai * HALF + m * 16) * ldc + col0;
#pragma unroll
                for (int bj = 0; bj < 2; ++bj)
#pragma unroll
                    for (int n = 0; n < 2; ++n) { const f32x4 b = *(const f32x4*)(base + off + bj * HALF + n * 16); *(f32x4*)(out + off + bj * HALF + n * 16) = b + acc[ai][bj][m][n]; } }
    }
};
__device__ __forceinline__ float silu_f(float g) { return g * __builtin_amdgcn_rcpf(1.0f + __expf(-g)); }
struct EpiSwiGLU {
    static constexpr bool PERM = true, AFTER_DRAIN = false;
    bf16_t* O; int ldo;
    __device__ __forceinline__ void operator()(const f32x4 (&acc)[2][2][4][2], const Unit& u, int wr, int wc, int fr, int fq) const {
        const int row0 = u.pm * BM + wr * 64 + fr; const int col0 = u.pn * HALF + wc * 32 + 8 * fq;
#pragma unroll
        for (int ai = 0; ai < 2; ++ai)
#pragma unroll
            for (int m = 0; m < 4; ++m) { bf16_t* rowp = O + (size_t)(row0 + ai * HALF + m * 16) * ldo + col0;
                const f32x4 g0 = acc[ai][0][m][0], g1 = acc[ai][0][m][1], u0 = acc[ai][1][m][0], u1 = acc[ai][1][m][1];
                u32x4 w; w.x = cvt_pk_bf16(silu_f(g0[0]) * u0[0], silu_f(g0[1]) * u0[1]); w.y = cvt_pk_bf16(silu_f(g0[2]) * u0[2], silu_f(g0[3]) * u0[3]);
                w.z = cvt_pk_bf16(silu_f(g1[0]) * u1[0], silu_f(g1[1]) * u1[1]); w.w = cvt_pk_bf16(silu_f(g1[2]) * u1[2], silu_f(g1[3]) * u1[3]);
                *(u32x4*)rowp = w; }
    }
};

typedef unsigned u32x2 __attribute__((ext_vector_type(2)));
struct EpiResF32N {
    static constexpr bool PERM = false, AFTER_DRAIN = false;
    const float* base; float* out; int ldc; bf16_t* xb; float* ss;
    __device__ __forceinline__ void operator()(const f32x4 (&acc)[2][2][4][2], const Unit& u, int wr, int wc, int fr, int fq) const {
        const int row0 = u.pm * BM + wr * 64 + fr; const int col0 = u.pn * BM + wc * 32 + 4 * fq;
#pragma unroll
        for (int ai = 0; ai < 2; ++ai)
#pragma unroll
            for (int m = 0; m < 4; ++m) { const int row = row0 + ai * HALF + m * 16; const size_t off = (size_t)row * ldc + col0; float q = 0.f;
#pragma unroll
                for (int bj = 0; bj < 2; ++bj)
#pragma unroll
                    for (int n = 0; n < 2; ++n) { const f32x4 b = *(const f32x4*)(base + off + bj * HALF + n * 16); const f32x4 v = b + acc[ai][bj][m][n];
                        *(f32x4*)(out + off + bj * HALF + n * 16) = v; q += (v[0] * v[0] + v[1] * v[1]) + (v[2] * v[2] + v[3] * v[3]);
                        u32x2 w; w.x = cvt_pk_bf16(v[0], v[1]); w.y = cvt_pk_bf16(v[2], v[3]); *(u32x2*)(xb + off + bj * HALF + n * 16) = w; }
                q += __shfl_xor(q, 16); q += __shfl_xor(q, 32);
                if (fq == 0) unsafeAtomicAdd(ss + row, q); }
    }
};
struct EpiSwiGLUN {
    static constexpr bool PERM = true, AFTER_DRAIN = false;
    bf16_t* O; int ldo; const float* ss; float inv_d, eps;
    __device__ __forceinline__ void operator()(const f32x4 (&acc)[2][2][4][2], const Unit& u, int wr, int wc, int fr, int fq) const {
        const int row0 = u.pm * BM + wr * 64 + fr; const int col0 = u.pn * HALF + wc * 32 + 8 * fq;
#pragma unroll
        for (int ai = 0; ai < 2; ++ai)
#pragma unroll
            for (int m = 0; m < 4; ++m) { const int row = row0 + ai * HALF + m * 16; bf16_t* rowp = O + (size_t)row * ldo + col0;
                const float r = __builtin_amdgcn_rsqf(ss[row] * inv_d + eps);
                const f32x4 g0 = acc[ai][0][m][0] * r, g1 = acc[ai][0][m][1] * r, u0 = acc[ai][1][m][0] * r, u1 = acc[ai][1][m][1] * r;
                u32x4 w; w.x = cvt_pk_bf16(silu_f(g0[0]) * u0[0], silu_f(g0[1]) * u0[1]); w.y = cvt_pk_bf16(silu_f(g0[2]) * u0[2], silu_f(g0[3]) * u0[3]);
                w.z = cvt_pk_bf16(silu_f(g1[0]) * u1[0], silu_f(g1[1]) * u1[1]); w.w = cvt_pk_bf16(silu_f(g1[2]) * u1[2], silu_f(g1[3]) * u1[3]);
                *(u32x4*)rowp = w; }
    }
};
template <class Epi, class Sched, bool ALIGN_EPI = false, bool SP2 = false>
__device__ __forceinline__ void gemm_phase(PG8_LAS unsigned char* lds, const Gemm g, const Sched& S, const Epi& E) {
    int tid_ = threadIdx.x; asm volatile("" : "+v"(tid_)); const int tid = tid_, wid = __builtin_amdgcn_readfirstlane(tid >> 6), lane = tid & 63, wr = wid >> 2, wc = wid & 3, fr = lane & 15, fq = lane >> 4;
    const int K = g.K, nt = K / BK;
    unsigned voffA[2], voffB[2];
#pragma unroll
    for (int i = 0; i < 2; ++i) { int R, C; stage_rc(tid * 16 + i * 8192, R, C); const int Rb = Epi::PERM ? ((R & ~31) + perm32(R & 31)) : R;
        voffA[i] = (unsigned)(R * K + C) * 2u; voffB[i] = (unsigned)(Rb * K + C) * 2u; }
    const size_t kstep = (size_t)(BK * 2);
    const size_t hstep = (size_t)HALF * K * 2;
    const size_t tstep = 2 * hstep;
    const unsigned ldsw = (unsigned)wid * 1024u;
    const int aoff = lds_byte(wr * 64 + fr, fq * 8), boff = lds_byte(wc * 32 + fr, fq * 8);
#define PG8_SA(b, h) (((b) * 2 + (h)) * HTB)
#define PG8_SB(b, h) ((4 + (b) * 2 + (h)) * HTB)
#define PG8_STAGE(bufoff, gbase, voff) do { _Pragma("unroll") for (int _i = 0; _i < 2; ++_i) \
        __builtin_amdgcn_global_load_lds((const unsigned*)((const char*)(gbase) + (voff)[_i]), (PG8_LAS unsigned*)(lds + (bufoff) + ldsw + _i * 8192), 16, 0, 0); } while (0)
#define PG8_LDA(dst, b, h) do { _Pragma("unroll") for (int m = 0; m < 4; ++m) _Pragma("unroll") for (int k = 0; k < 2; ++k) dst[m][k] = *(const PG8_LAS bf16x8*)(lds + PG8_SA(b, h) + aoff + m * 2048 + k * 1024); } while (0)
#define PG8_LDB(dst, b, h) do { _Pragma("unroll") for (int n = 0; n < 2; ++n) _Pragma("unroll") for (int k = 0; k < 2; ++k) dst[n][k] = *(const PG8_LAS bf16x8*)(lds + PG8_SB(b, h) + boff + n * 2048 + k * 1024); } while (0)
#define PG8_MMA(ai, bj, At, Bt) do { __builtin_amdgcn_s_setprio(1); _Pragma("unroll") for (int m = 0; m < 4; ++m) _Pragma("unroll") for (int n = 0; n < 2; ++n) _Pragma("unroll") for (int k = 0; k < 2; ++k) \
        acc[ai][bj][m][n] = __builtin_amdgcn_mfma_f32_16x16x32_bf16(Bt[n][k], At[m][k], acc[ai][bj][m][n], 0, 0, 0); __builtin_amdgcn_s_setprio(0); } while (0)
#define PG8_WAIT_V(n) asm volatile("s_waitcnt vmcnt(" #n ")" ::: "memory")
#define PG8_WAIT_L(n) asm volatile("s_waitcnt lgkmcnt(" #n ")" ::: "memory")
#define PG8_BAR __builtin_amdgcn_s_barrier()
#define PG8_SCHED __builtin_amdgcn_sched_barrier(0)
    Unit cur, nxt; int ui = 0;
    if (!S.next(0, cur)) return;
    f32x4 acc[2][2][4][2];
#pragma unroll
    for (int a = 0; a < 2; ++a)
#pragma unroll
        for (int b = 0; b < 2; ++b)
#pragma unroll
            for (int m = 0; m < 4; ++m)
#pragma unroll
                for (int n = 0; n < 2; ++n) acc[a][b][m][n] = (f32x4){0.f, 0.f, 0.f, 0.f};
    bf16x8 At[4][2], B0[2][2], B1[2][2];
    const char* cA = (const char*)g.A + (size_t)cur.pm * tstep; const char* cB = (const char*)g.Bt + (size_t)cur.pn * tstep;
    S.a_ready(cur);
    if constexpr (SP2) {
        PG8_STAGE(PG8_SB(0, 0), cB, voffB); PG8_STAGE(PG8_SB(0, 1), cB + hstep, voffB); PG8_STAGE(PG8_SA(0, 0), cA, voffA); PG8_STAGE(PG8_SA(0, 1), cA + hstep, voffA);
        if (wr == 1) PG8_BAR;
        PG8_WAIT_V(2); PG8_BAR;
        PG8_STAGE(PG8_SB(1, 0), cB + kstep, voffB); PG8_STAGE(PG8_SA(1, 0), cA + kstep, voffA); PG8_STAGE(PG8_SB(1, 1), cB + hstep + kstep, voffB);
        PG8_WAIT_V(6); PG8_BAR;
    } else {
        PG8_STAGE(PG8_SB(0, 0), cB, voffB); PG8_STAGE(PG8_SA(0, 0), cA, voffA); PG8_STAGE(PG8_SB(0, 1), cB + hstep, voffB); PG8_STAGE(PG8_SA(0, 1), cA + hstep, voffA);
        if (wr == 1) PG8_BAR;
        PG8_WAIT_V(4); PG8_BAR;
        PG8_STAGE(PG8_SB(1, 0), cB + kstep, voffB); PG8_STAGE(PG8_SA(1, 0), cA + kstep, voffA); PG8_STAGE(PG8_SB(1, 1), cB + hstep + kstep, voffB);
        PG8_WAIT_V(6); PG8_BAR;
    }
    for (;;) {
        const bool has_next = S.next(ui + 1, nxt);
        const char* nA = has_next ? (const char*)g.A + (size_t)nxt.pm * tstep : cA; const char* nB = has_next ? (const char*)g.Bt + (size_t)nxt.pn * tstep : cB;
        for (int t = 0; t < nt; t += 2) {
            const bool last = (t == nt - 2);
            const char* a1 = cA + (size_t)(t + 1) * kstep;
            const char* a2 = last ? nA : cA + (size_t)(t + 2) * kstep; const char* b2 = last ? nB : cB + (size_t)(t + 2) * kstep;
            const char* a3 = a2 + kstep; const char* b3 = b2 + kstep;
            if (last && has_next) S.a_ready(nxt);
            if constexpr (SP2) {
            PG8_LDB(B0, 0, 0); PG8_LDB(B1, 0, 1); PG8_SCHED; PG8_LDA(At, 0, 0); PG8_STAGE(PG8_SA(1, 1), a1 + hstep, voffA);
            PG8_WAIT_V(8); PG8_WAIT_L(0); PG8_BAR; PG8_MMA(0, 0, At, B0); PG8_MMA(0, 1, At, B1); PG8_BAR; PG8_SCHED;
            PG8_LDA(At, 0, 1); PG8_STAGE(PG8_SB(0, 0), b2, voffB); PG8_STAGE(PG8_SB(0, 1), b2 + hstep, voffB); PG8_STAGE(PG8_SA(0, 0), a2, voffA);
            PG8_WAIT_V(8); PG8_WAIT_L(0); PG8_BAR; PG8_MMA(1, 0, At, B0); PG8_MMA(1, 1, At, B1); PG8_BAR; PG8_SCHED;
            PG8_LDB(B0, 1, 0); PG8_LDB(B1, 1, 1); PG8_SCHED; PG8_LDA(At, 1, 0); PG8_STAGE(PG8_SA(0, 1), a2 + hstep, voffA);
            PG8_WAIT_V(8); PG8_WAIT_L(0); PG8_BAR; PG8_MMA(0, 0, At, B0); PG8_MMA(0, 1, At, B1); PG8_BAR; PG8_SCHED;
            PG8_LDA(At, 1, 1); PG8_STAGE(PG8_SB(1, 0), b3, voffB); PG8_STAGE(PG8_SB(1, 1), b3 + hstep, voffB); PG8_STAGE(PG8_SA(1, 0), a3, voffA);
            PG8_WAIT_V(8); PG8_WAIT_L(0); PG8_BAR; PG8_MMA(1, 0, At, B0); PG8_MMA(1, 1, At, B1); PG8_BAR; PG8_SCHED;
            } else {
            PG8_LDB(B0, 0, 0); PG8_SCHED; PG8_LDA(At, 0, 0); PG8_STAGE(PG8_SA(1, 1), a1 + hstep, voffA);
            PG8_WAIT_L(8); PG8_BAR; PG8_WAIT_L(0); PG8_MMA(0, 0, At, B0); PG8_BAR; PG8_SCHED;
            PG8_LDB(B1, 0, 1); PG8_STAGE(PG8_SB(0, 0), b2, voffB);
            PG8_BAR; PG8_WAIT_L(0); PG8_MMA(0, 1, At, B1); PG8_BAR;
            PG8_LDA(At, 0, 1); PG8_STAGE(PG8_SA(0, 0), a2, voffA);
            PG8_BAR; PG8_WAIT_L(0); PG8_MMA(1, 0, At, B0); PG8_BAR; PG8_SCHED;
            PG8_STAGE(PG8_SB(0, 1), b2 + hstep, voffB);
            PG8_WAIT_V(6); PG8_BAR; PG8_MMA(1, 1, At, B1); PG8_BAR;
            PG8_LDB(B0, 1, 0); PG8_SCHED; PG8_LDA(At, 1, 0); PG8_STAGE(PG8_SA(0, 1), a2 + hstep, voffA);
            PG8_WAIT_L(8); PG8_BAR; PG8_WAIT_L(0); PG8_MMA(0, 0, At, B0); PG8_BAR; PG8_SCHED;
            PG8_LDB(B1, 1, 1); PG8_STAGE(PG8_SB(1, 0), b3, voffB);
            PG8_BAR; PG8_WAIT_L(0); PG8_MMA(0, 1, At, B1); PG8_BAR;
            PG8_LDA(At, 1, 1); PG8_STAGE(PG8_SA(1, 0), a3, voffA);
            PG8_BAR; PG8_WAIT_L(0); PG8_MMA(1, 0, At, B0); PG8_BAR; PG8_SCHED;
            PG8_STAGE(PG8_SB(1, 1), b3 + hstep, voffB);
            PG8_WAIT_V(6); PG8_BAR; PG8_MMA(1, 1, At, B1); PG8_BAR;
            }
        }
        if constexpr (ALIGN_EPI) { if (wr == 0) PG8_BAR; }
        if constexpr (!Epi::AFTER_DRAIN) { E(acc, cur, wr, wc, fr, fq); S.done(cur); }
        if (!has_next) break;
#pragma unroll
        for (int a = 0; a < 2; ++a)
#pragma unroll
            for (int b = 0; b < 2; ++b)
#pragma unroll
                for (int m = 0; m < 4; ++m)
#pragma unroll
                    for (int n = 0; n < 2; ++n) acc[a][b][m][n] = (f32x4){0.f, 0.f, 0.f, 0.f};
        cur = nxt; cA = nA; cB = nB; ++ui;
        if constexpr (ALIGN_EPI) { if (wr == 1) PG8_BAR; }
    }
    PG8_WAIT_V(0);
    if constexpr (!ALIGN_EPI) { if (wr == 0) PG8_BAR; }
    PG8_BAR;
    if constexpr (Epi::AFTER_DRAIN) { E.fused(acc, cur, wr, wc, fr, fq, lds, wid, lane); S.done(cur); }
#undef PG8_SA
#undef PG8_SB
#undef PG8_STAGE
#undef PG8_LDA
#undef PG8_LDB
#undef PG8_MMA
#undef PG8_WAIT_V
#undef PG8_WAIT_L
#undef PG8_BAR
#undef PG8_SCHED
}
}
#define DI __device__ __forceinline__
#define LAS __attribute__((address_space(3)))
typedef unsigned short bf16;
typedef short bf16x8 __attribute__((ext_vector_type(8)));
typedef short s16x4 __attribute__((ext_vector_type(4)));
typedef short v4i16_t __attribute__((ext_vector_type(4)));
typedef float f32x4 __attribute__((ext_vector_type(4)));
typedef float f32x2 __attribute__((ext_vector_type(2)));
typedef unsigned u32x4 __attribute__((ext_vector_type(4)));
typedef unsigned u32x2 __attribute__((ext_vector_type(2)));
typedef __bf16 bf16x2_t __attribute__((ext_vector_type(2)));

constexpr int NB = 8, SEQ = 2048, DM = 2048, M = NB * SEQ, DEPTH = 2, HD = 128, NH = 6;
constexpr int NPROJ = 6400, IN_TOTAL = 6412, FF = 5632;
constexpr int C_AU = 0, C_AV = 512, C_BQ = 1024, C_BK = 1792, C_BV = 2560, C_BG = 3328, C_CQ = 4096, C_CK = 4864, C_CV = 5632;
constexpr float EPS = 1e-6f, LOG2E = 1.4426950408889634f, LN2 = 0.6931471805599453f;
enum { I_X = 0, I_N1G, I_WIN, I_SGUG, I_WS, I_BS, I_CONVW, I_ALOG, I_DTB, I_ONG, I_QNG, I_KNG, I_WOUT, I_N2G, I_WGU, I_WDN };

constexpr size_t SZ_WIN = (size_t)NPROJ * DM * 2, SZ_WOUT = (size_t)DM * DM * 2, SZ_WGU = (size_t)2 * FF * DM * 2, SZ_WDN = (size_t)DM * FF * 2;
constexpr size_t SZ_WL = SZ_WIN + SZ_WOUT + SZ_WGU + SZ_WDN;
constexpr size_t WS_W = 0;
constexpr size_t WS_H = WS_W + DEPTH * SZ_WL;
constexpr size_t WS_PROJ = WS_H + (size_t)M * DM * 2;
constexpr size_t WS_BD = WS_PROJ + (size_t)M * NPROJ * 2;
constexpr size_t WS_DN = WS_BD + (size_t)M * 12 * 4;
constexpr int NCHUNK = NB * NH * 32;
constexpr size_t DN_WK = 0, DN_QG = 16384, DN_KDT = 32768, DN_UT = 49152, DN_ATT = 65536, DN_STRIDE = 73728;
constexpr size_t WS_GL = WS_DN + (size_t)NCHUNK * DN_STRIDE;
constexpr size_t WS_ODN = WS_GL + 8192;
constexpr size_t WS_OBR = WS_ODN + (size_t)M * 768 * 4;
constexpr size_t WS_LSE = WS_OBR + (size_t)3 * M * 768 * 2;
constexpr size_t WS_CTL = WS_LSE + (size_t)3 * M * 6 * 4;
constexpr size_t CTL_BYTES = 16384 + (size_t)DEPTH * M * 4;
constexpr size_t WS_SS = WS_CTL + 16384;
constexpr size_t WS_END = WS_CTL + CTL_BYTES;
constexpr int LDS_BYTES = 143360;
constexpr int NTHR = 512;
constexpr int NSCAN = 192;

DI unsigned pk2(float lo, float hi) { f32x2 v = {lo, hi}; bf16x2_t b = __builtin_convertvector(v, bf16x2_t); return __builtin_bit_cast(unsigned, b); }
DI float bflo(unsigned w) { return __uint_as_float(w << 16); }
DI float bfhi(unsigned w) { return __uint_as_float(w & 0xffff0000u); }
DI f32x4 mfma16(bf16x8 a, bf16x8 b, f32x4 c) { return __builtin_amdgcn_mfma_f32_16x16x32_bf16(a, b, c, 0, 0, 0); }
DI s16x4 tr4(const LAS unsigned char* p) { return __builtin_bit_cast(s16x4, __builtin_amdgcn_ds_read_tr16_b64_v4i16((LAS v4i16_t*)p)); }
DI bf16x8 tr_frag(const LAS unsigned char* p0, const LAS unsigned char* p1) { const s16x4 lo = tr4(p0), hi = tr4(p1); return __builtin_shufflevector(lo, hi, 0, 1, 2, 3, 4, 5, 6, 7); }
DI bf16x8 ld_frag(const LAS unsigned char* p) { return *(const LAS bf16x8*)p; }
DI void lds_barrier() { asm volatile("s_waitcnt lgkmcnt(0)" ::: "memory"); __builtin_amdgcn_s_barrier(); asm volatile("" ::: "memory"); }
DI int opaque(int x) { asm volatile("" : "+v"(x)); return x; }
DI float wave_sum(float v) {
#pragma unroll
    for (int o = 1; o < 64; o <<= 1) v += __shfl_xor(v, o);
    return v;
}
template <int CTRL> DI float dpp_f(float v) { return __builtin_bit_cast(float, __builtin_amdgcn_update_dpp(0, __builtin_bit_cast(int, v), CTRL, 0xf, 0xf, true)); }
DI float sum4(float v) { v += dpp_f<0xB1>(v); v += dpp_f<0x4E>(v); return v; }
DI float sum8(float v) { v = sum4(v); v += dpp_f<0x141>(v); return v; }
DI float sum16(float v) { v = sum8(v); v += dpp_f<0x140>(v); return v; }
DI float sigmoid_f(float x) { return __builtin_amdgcn_rcpf(1.0f + __expf(-x)); }
DI float silu_f(float x) { return x * sigmoid_f(x); }
DI float gelu_tanh(float x) { const float u = 0.7978845608028654f * (x + 0.044715f * x * x * x); return x * sigmoid_f(2.0f * u); }
DI void unpack8(const u32x4 w, float* f) { f[0] = bflo(w.x); f[1] = bfhi(w.x); f[2] = bflo(w.y); f[3] = bfhi(w.y); f[4] = bflo(w.z); f[5] = bfhi(w.z); f[6] = bflo(w.w); f[7] = bfhi(w.w); }
DI u32x4 pack8(const float* f) { u32x4 w; w.x = pk2(f[0], f[1]); w.y = pk2(f[2], f[3]); w.z = pk2(f[4], f[5]); w.w = pk2(f[6], f[7]); return w; }
DI u32x2 pack4(const f32x4 v) { u32x2 w; w.x = pk2(v[0], v[1]); w.y = pk2(v[2], v[3]); return w; }

DI void transpose_item(const float* W, int K, int Nsrc, int src_col0, bf16* WT, int dst_row0, int k0, LAS float* scr, int lane, const float* gk = nullptr) {
#pragma unroll 8
    for (int i = 0; i < 32; ++i) { const int kk = 2 * i + (lane >> 5); float v = W[(size_t)(k0 + kk) * Nsrc + src_col0 + (lane & 31)]; if (gk) v *= gk[k0 + kk]; scr[kk * 33 + (lane & 31)] = v; }
    asm volatile("s_waitcnt lgkmcnt(0)" ::: "memory");
    const int c = lane & 7;
#pragma unroll
    for (int j = 0; j < 4; ++j) { const int n = (lane >> 3) + 8 * j; const LAS float* s = scr + (8 * c) * 33 + n;
        u32x4 o; o.x = pk2(s[0 * 33], s[1 * 33]); o.y = pk2(s[2 * 33], s[3 * 33]); o.z = pk2(s[4 * 33], s[5 * 33]); o.w = pk2(s[6 * 33], s[7 * 33]);
        *(u32x4*)(WT + (size_t)(dst_row0 + n) * K + k0 + 8 * c) = o; }
    asm volatile("s_waitcnt lgkmcnt(0)" ::: "memory");
}
DI void weight_prep(const float* const* in, unsigned char* ws, LAS unsigned char* lds, int gw, int ngw, int wave, int lane) {
    LAS float* scr = (LAS float*)(lds + wave * 16384);
    constexpr int I_IN = (DM / 64) * (NPROJ / 32), I_OUT = (DM / 64) * (DM / 32), I_GU = (DM / 64) * (2 * FF / 32), I_DN = (FF / 64) * (DM / 32);
    constexpr int PER_L = I_IN + I_OUT + I_GU + I_DN;
    for (int it = gw; it < DEPTH * PER_L; it += ngw) {
        const int l = it / PER_L; int r = it % PER_L;
        unsigned char* wl = ws + WS_W + (size_t)l * SZ_WL;
        if (r < I_IN) { const int nblk = NPROJ / 32, kb = r / nblk, nb = r % nblk, n0 = nb * 32;
            transpose_item(in[I_WIN] + (size_t)l * DM * IN_TOTAL, DM, IN_TOTAL, n0 < 4096 ? n0 : n0 + 12, (bf16*)wl, n0, kb * 64, scr, lane); continue; }
        r -= I_IN;
        if (r < I_OUT) { const int nblk = DM / 32, kb = r / nblk, nb = r % nblk, n0 = nb * 32;
            transpose_item(in[I_WOUT] + (size_t)l * DM * DM, DM, DM, n0, (bf16*)(wl + SZ_WIN), n0, kb * 64, scr, lane); continue; }
        r -= I_OUT;
        if (r < I_GU) { const int nblk = 2 * FF / 32, kb = r / nblk, nb = r % nblk, n0 = nb * 32, pn = n0 >> 8, j = n0 & 255;
            transpose_item(in[I_WGU] + (size_t)l * DM * 2 * FF, DM, 2 * FF, j < 128 ? 128 * pn + j : FF + 128 * pn + (j - 128), (bf16*)(wl + SZ_WIN + SZ_WOUT), n0, kb * 64, scr, lane); continue; }
        r -= I_GU;
        { const int nblk = DM / 32, kb = r / nblk, nb = r % nblk, n0 = nb * 32;
            transpose_item(in[I_WDN] + (size_t)l * FF * DM, FF, DM, n0, (bf16*)(wl + SZ_WIN + SZ_WOUT + SZ_WGU), n0, kb * 64, scr, lane); }
    }
}

DI void norm_phase(const float* x, const float* g, bf16* h, const float* w_in_l, float* bd, LAS unsigned char* lds, int gw, int ngw, int tid0, int lane0) {
    const int tid = opaque(tid0), lane = tid & 63; (void)lane0;
    LAS f32x4* wl = (LAS f32x4*)lds;
    if (w_in_l) {
        for (int k = tid; k < DM; k += NTHR) {
            const f32x4* src = (const f32x4*)(w_in_l + (size_t)k * IN_TOTAL + 4096);
            const f32x4 a = src[0], b = src[1], c = src[2];
            const int j = k >> 8, l = (k >> 2) & 63, e = k & 3;
            LAS float* dst = (LAS float*)lds + ((size_t)(j * 12) * 64 + l) * 4 + e;
            dst[0 * 256] = a[0]; dst[1 * 256] = a[1]; dst[2 * 256] = a[2]; dst[3 * 256] = a[3];
            dst[4 * 256] = b[0]; dst[5 * 256] = b[1]; dst[6 * 256] = b[2]; dst[7 * 256] = b[3];
            dst[8 * 256] = c[0]; dst[9 * 256] = c[1]; dst[10 * 256] = c[2]; dst[11 * 256] = c[3];
        }
        __syncthreads();
    }
    f32x4 gv[8];
#pragma unroll
    for (int j = 0; j < 8; ++j) gv[j] = ((const f32x4*)g)[64 * j + lane];
    for (int row = gw; row < M; row += ngw) {
        const f32x4* xr = (const f32x4*)(x + (size_t)row * DM) + lane;
        f32x4 v[8]; float s = 0.f;
#pragma unroll
        for (int j = 0; j < 8; ++j) { v[j] = xr[64 * j]; s += (v[j][0] * v[j][0] + v[j][1] * v[j][1]) + (v[j][2] * v[j][2] + v[j][3] * v[j][3]); }
        const float rs = __builtin_amdgcn_rsqf(wave_sum(s) * (1.0f / DM) + EPS);
        u32x2* o8 = (u32x2*)(h + (size_t)row * DM) + lane;
#pragma unroll
        for (int j = 0; j < 8; ++j) { v[j] = v[j] * rs * gv[j]; u32x2 w; w.x = pk2(v[j][0], v[j][1]); w.y = pk2(v[j][2], v[j][3]); o8[64 * j] = w; }
        if (w_in_l) {
            float outv = 0.f;
            asm volatile("" ::: "memory");
#pragma unroll 1
            for (int c = 0; c < 12; ++c) {
                float acc = 0.f;
#pragma unroll
                for (int j = 0; j < 8; ++j) { const f32x4 w = wl[(j * 12 + c) * 64 + lane]; acc += (v[j][0] * w[0] + v[j][1] * w[1]) + (v[j][2] * w[2] + v[j][3] * w[3]); }
                acc = wave_sum(acc);
                if (lane == c) outv = acc;
            }
            if (lane < 12) bd[(size_t)row * 12 + lane] = outv;
        }
    }
    if (w_in_l) __syncthreads();
}
#define XB_TMO      128
#define XB_XCNT(j)  (256  + 64 * (j))
#define XB_XSUB(j)  (1280 + 64 * (j))
#define XB_XGEN(j)  (2304 + 64 * (j))
#define XB_TOP      3328
#define XB_TOPGEN   3392
#define XCD_BAR_WORDS 3456
#define XB_SPIN_CAP (1u << 18)

__device__ __forceinline__ unsigned xb_ld(unsigned* p)              { return __hip_atomic_load(p, __ATOMIC_RELAXED, __HIP_MEMORY_SCOPE_AGENT); }
__device__ __forceinline__ unsigned xb_add(unsigned* p, unsigned v) { return __hip_atomic_fetch_add(p, v, __ATOMIC_RELAXED, __HIP_MEMORY_SCOPE_AGENT); }
__device__ __forceinline__ unsigned xb_xcc_id() { return (unsigned)__builtin_amdgcn_s_getreg((3 << 11) | 20) & 0xFu; }
#define XB_SPIN(cond, bar) do { unsigned _sp = 0; while (cond) { __builtin_amdgcn_s_sleep(1); \
    if ((++_sp & 255u) == 0u) { if (xb_ld(&(bar)[XB_TMO])) break; if (_sp > XB_SPIN_CAP) { atomicAdd(&(bar)[XB_TMO], 1u); break; } } } } while (0)

struct XcdBarrier {
    unsigned* bar; unsigned x;
    volatile LAS unsigned* st;
};

__device__ __forceinline__ XcdBarrier xcd_barrier_post(unsigned* bar, volatile LAS unsigned* st) {
    XcdBarrier b; b.bar = bar; b.x = xb_xcc_id(); b.st = st;
    if (threadIdx.x == 0) (void)xb_add(&bar[XB_XCNT(b.x)], 1u);
    return b;
}
__device__ __forceinline__ void xcd_barrier_complete(unsigned* bar, unsigned x, unsigned& nloc, unsigned& nx) {
    const unsigned G = gridDim.x * gridDim.y * gridDim.z;
    unsigned sum, cnt, mine, sp = 0u;
    for (;;) {
        sum = 0u; cnt = 0u; mine = 0u;
#pragma unroll
        for (unsigned j = 0; j < 16; ++j) { const unsigned c = xb_ld(&bar[XB_XCNT(j)]); sum += c; cnt += (c > 0u) ? 1u : 0u; mine = (j == x) ? c : mine; }
        if (sum == G) break;
        __builtin_amdgcn_s_sleep(1);
        if ((++sp & 255u) == 0u) { if (xb_ld(&bar[XB_TMO])) break; if (sp > XB_SPIN_CAP) { atomicAdd(&bar[XB_TMO], 1u); break; } }
    }
    nloc = mine > 0u ? mine : 1u; nx = cnt > 0u ? cnt : 1u;
}

__device__ __forceinline__ void xcd_barrier(const XcdBarrier& b) {
    asm volatile("s_waitcnt vmcnt(0)" ::: "memory");
    __syncthreads();
    if (threadIdx.x == 0) {
        unsigned* bar = b.bar;
        __builtin_amdgcn_s_waitcnt(0);
        unsigned nloc = b.st[0], nx = b.st[1];
        if (nloc == 0u) { xcd_barrier_complete(bar, b.x, nloc, nx); b.st[0] = nloc; b.st[1] = nx; }
        const unsigned old = xb_add(&bar[XB_XSUB(b.x)], 1u);
        const unsigned gen = old / nloc;
        if (old + 1u == (gen + 1u) * nloc) {
            __builtin_amdgcn_fence(__ATOMIC_RELEASE, "agent");
            asm volatile("s_waitcnt vmcnt(0)" ::: "memory");
            const unsigned og = xb_add(&bar[XB_TOP], 1u);
            const unsigned tg = og / nx;
            if (og + 1u == (tg + 1u) * nx) xb_add(&bar[XB_TOPGEN], 1u);
            else XB_SPIN(xb_ld(&bar[XB_TOPGEN]) == tg, bar);
            __builtin_amdgcn_fence(__ATOMIC_ACQUIRE, "agent");
            xb_add(&bar[XB_XGEN(b.x)], 1u);
            asm volatile("s_waitcnt vmcnt(0)" ::: "memory");
        } else {
            XB_SPIN(xb_ld(&bar[XB_XGEN(b.x)]) == gen, bar);
            __builtin_amdgcn_fence(__ATOMIC_ACQUIRE, "agent");
            asm volatile("s_waitcnt vmcnt(0)" ::: "memory");
        }
    }
    __syncthreads();
}
DI void sgu_item(int item, const bf16* proj, const float* sgu_g, const float* w_s, const float* b_s, bf16* mix, LAS unsigned char* lds, int tid0) {
    const int tid = opaque(tid0);
    const int g = item & 3, c = (item >> 2) & 15, b = item >> 6;
    const size_t row0 = (size_t)b * SEQ + c * 128;
    LAS unsigned char* Vimg = lds; LAS unsigned char* Wimg = lds + 128 * 272;
    {
        const int i = tid >> 2, p = tid & 3;
        const bf16* src = proj + (row0 + i) * NPROJ + C_AV + g * 128 + p * 32;
        float y[32]; float ss = 0.f;
#pragma unroll
        for (int e = 0; e < 4; ++e) { const u32x4 raw = *(const u32x4*)(src + 8 * e); unpack8(raw, y + 8 * e); }
#pragma unroll
        for (int e = 0; e < 32; ++e) { y[e] = gelu_tanh(y[e]); ss += y[e] * y[e]; }
        ss = sum4(ss);
        const float rs = __builtin_amdgcn_rsqf(ss * (1.0f / 128.0f) + EPS);
        const float* gg = sgu_g + g * 128 + p * 32;
#pragma unroll
        for (int e = 0; e < 4; ++e) { float t[8];
#pragma unroll
            for (int k = 0; k < 8; ++k) t[k] = y[8 * e + k] * rs * gg[8 * e + k];
            *(LAS u32x4*)(Vimg + i * 272 + p * 64 + e * 16) = pack8(t); }
        const float* wsrc = w_s + ((size_t)g * 128 + i) * 128 + p * 32;
#pragma unroll
        for (int e = 0; e < 4; ++e) { const f32x4 a = *(const f32x4*)(wsrc + 8 * e), bb = *(const f32x4*)(wsrc + 8 * e + 4); float t[8];
#pragma unroll
            for (int k = 0; k < 4; ++k) { t[k] = (p * 32 + 8 * e + k <= i) ? a[k] : 0.f; t[4 + k] = (p * 32 + 8 * e + 4 + k <= i) ? bb[k] : 0.f; }
            *(LAS u32x4*)(Wimg + i * 272 + p * 64 + e * 16) = pack8(t); }
    }
    __syncthreads();
    const int w = tid >> 6, lane = tid & 63, r = lane & 15, q = lane >> 4;
    f32x4 acc[8];
#pragma unroll
    for (int dt = 0; dt < 8; ++dt) acc[dt] = (f32x4){0.f, 0.f, 0.f, 0.f};
    const int i = 16 * w + r; const float bsv = b_s[g * 128 + i];
    const bf16* up = proj + (row0 + i) * NPROJ + C_AU + g * 128 + 4 * q;
    u32x2 uua[8];
#pragma unroll
    for (int dt = 0; dt < 8; ++dt) uua[dt] = *(const u32x2*)(up + 16 * dt);
    const int nks = (16 * (w + 1) + 31) >> 5;
    for (int ks = 0; ks < nks; ++ks) {
        const bf16x8 bfr = ld_frag(Wimg + (16 * w + r) * 272 + (32 * ks + 8 * q) * 2);
#pragma unroll
        for (int dt = 0; dt < 8; ++dt) { const LAS unsigned char* p0 = Vimg + (32 * ks + 8 * q + (r >> 2)) * 272 + (16 * dt + 4 * (r & 3)) * 2;
            acc[dt] = mfma16(tr_frag(p0, p0 + 4 * 272), bfr, acc[dt]); }
    }
    bf16* op = mix + (row0 + i) * DM + g * 128 + 4 * q;
#pragma unroll
    for (int dt = 0; dt < 8; ++dt) { const u32x2 uu = uua[dt];
        f32x4 o; o[0] = gelu_tanh(bflo(uu.x)) * (acc[dt][0] + bsv); o[1] = gelu_tanh(bfhi(uu.x)) * (acc[dt][1] + bsv); o[2] = gelu_tanh(bflo(uu.y)) * (acc[dt][2] + bsv); o[3] = gelu_tanh(bfhi(uu.y)) * (acc[dt][3] + bsv);
        *(u32x2*)(op + 16 * dt) = pack4(o); }
    __syncthreads();
}

DI void attn_item(int item, const bf16* proj, const float* qg, const float* kg, bf16* obr, float* lse, LAS unsigned char* lds, int tid0) {
    const int tid = opaque(tid0);
    const int sub = item % 48, bh = item / 48, h = bh % NH, b = bh / NH;
    int br, rr, n;
    if (sub < 16) { br = 0; rr = 0; n = sub; } else if (sub < 32) { br = 1; rr = (sub - 16) >> 2; n = (sub - 16) & 3; } else { br = 2; rr = sub - 32; n = 0; }
    const int dil = 1 << (2 * br);
    LAS unsigned char* Kimg = lds; LAS unsigned char* Vimg = lds + 256 * 272;
    const bf16* base = proj + (size_t)b * SEQ * NPROJ + h * 128;
    {
        const int piece = tid & 15;
        float kgv[8];
#pragma unroll
        for (int e = 0; e < 8; ++e) kgv[e] = kg[piece * 8 + e];
        u32x4 kva[8], vva[8];
#pragma unroll
        for (int i = 0; i < 8; ++i) {
            const int row = (tid >> 4) + 32 * i, L = (n - 1) * 128 + row;
            kva[i] = (u32x4){0u, 0u, 0u, 0u}; vva[i] = (u32x4){0u, 0u, 0u, 0u};
            if (L >= 0) { const bf16* p = base + (size_t)(L * dil + rr) * NPROJ + piece * 8; kva[i] = *(const u32x4*)(p + C_CK); vva[i] = *(const u32x4*)(p + C_CV); }
        }
#pragma unroll
        for (int i = 0; i < 8; ++i) {
            const int row = (tid >> 4) + 32 * i;
            const u32x4 kv = kva[i], vv = vva[i];
            float kf[8]; unpack8(kv, kf); float ss = 0.f;
#pragma unroll
            for (int e = 0; e < 8; ++e) ss += kf[e] * kf[e];
            ss = sum16(ss);
            const float rs = __builtin_amdgcn_rsqf(ss * (1.0f / 128.0f) + EPS);
#pragma unroll
            for (int e = 0; e < 8; ++e) kf[e] = kf[e] * rs * kgv[e];
            *(LAS u32x4*)(Kimg + row * 272 + piece * 16) = pack8(kf);
            *(LAS u32x4*)(Vimg + row * 272 + piece * 16) = vv;
        }
    }
    const int w = tid >> 6, lane = tid & 63, r = lane & 15, q = lane >> 4;
    const int qi = 16 * w + r, tokq = (n * 128 + qi) * dil + rr;
    bf16x8 qf[4];
    {
        const bf16* qp = base + (size_t)tokq * NPROJ + C_CQ + 8 * q;
        float qv[32]; float ss = 0.f;
#pragma unroll
        for (int s = 0; s < 4; ++s) { const u32x4 raw = *(const u32x4*)(qp + 32 * s); unpack8(raw, qv + 8 * s); }
#pragma unroll
        for (int e = 0; e < 32; ++e) ss += qv[e] * qv[e];
        ss += __shfl_xor(ss, 16); ss += __shfl_xor(ss, 32);
        const float rs = (__builtin_amdgcn_rsqf(ss * (1.0f / 128.0f) + EPS)) * (0.08838834764831845f * LOG2E);
#pragma unroll
        for (int s = 0; s < 4; ++s) { float t[8];
#pragma unroll
            for (int e = 0; e < 8; ++e) t[e] = qv[8 * s + e] * rs * qg[32 * s + 8 * q + e];
            qf[s] = __builtin_bit_cast(bf16x8, pack8(t)); }
    }
    __syncthreads();
    const int kt0 = 2 * (w >> 1);
    f32x4 sc[10];
#pragma unroll
    for (int t = 0; t < 10; ++t) { f32x4 a4 = {0.f, 0.f, 0.f, 0.f};
#pragma unroll
        for (int s = 0; s < 4; ++s) a4 = mfma16(ld_frag(Kimg + (16 * (kt0 + t) + r) * 272 + (32 * s + 8 * q) * 2), qf[s], a4);
        sc[t] = a4; }
    const float sl2 = exp2f(-8.0f * (float)(h + 1) / 6.0f) * (float)dil * LOG2E;
    float mx = -INFINITY;
    {
        const int lb = 16 * kt0 + 4 * q - qi, lowcut = (n > 0) ? -1 : 127 - 16 * kt0 - 4 * q;
        const float bl = sl2 * (float)(lb - 128);
#pragma unroll
        for (int t = 0; t < 10; ++t)
#pragma unroll
            for (int jj = 0; jj < 4; ++jj) { const int cst = 16 * t + jj;
                const bool valid = ((unsigned)(cst + lb) <= 128u) && (cst > lowcut);
                const float v = valid ? sc[t][jj] + (sl2 * (float)cst + bl) : -INFINITY; sc[t][jj] = v; mx = fmaxf(mx, v); }
    }
    mx = fmaxf(mx, __shfl_xor(mx, 16)); mx = fmaxf(mx, __shfl_xor(mx, 32));
    float l = 0.f;
#pragma unroll
    for (int t = 0; t < 10; ++t)
#pragma unroll
        for (int jj = 0; jj < 4; ++jj) { const float p = __builtin_amdgcn_exp2f(sc[t][jj] - mx); sc[t][jj] = p; l += p; }
    l += __shfl_xor(l, 16); l += __shfl_xor(l, 32);
    bf16x8 pf[5];
#pragma unroll
    for (int pp = 0; pp < 5; ++pp) { u32x4 wv; wv.x = pk2(sc[2 * pp][0], sc[2 * pp][1]); wv.y = pk2(sc[2 * pp][2], sc[2 * pp][3]); wv.z = pk2(sc[2 * pp + 1][0], sc[2 * pp + 1][1]); wv.w = pk2(sc[2 * pp + 1][2], sc[2 * pp + 1][3]);
        pf[pp] = __builtin_bit_cast(bf16x8, wv); }
    f32x4 o[8];
#pragma unroll
    for (int dt = 0; dt < 8; ++dt) o[dt] = (f32x4){0.f, 0.f, 0.f, 0.f};
#pragma unroll
    for (int pp = 0; pp < 5; ++pp)
#pragma unroll
        for (int dt = 0; dt < 8; ++dt) { const LAS unsigned char* p0 = Vimg + (16 * (kt0 + 2 * pp) + 4 * q + (r >> 2)) * 272 + (16 * dt + 4 * (r & 3)) * 2;
            o[dt] = mfma16(tr_frag(p0, p0 + 16 * 272), pf[pp], o[dt]); }
    const float inv = __builtin_amdgcn_rcpf(l);
    const size_t orow = (size_t)br * M + (size_t)b * SEQ + tokq;
    bf16* op = obr + orow * 768 + h * 128 + 4 * q;
#pragma unroll
    for (int dt = 0; dt < 8; ++dt) *(u32x2*)(op + 16 * dt) = pack4(o[dt] * inv);
    if (q == 0) lse[orow * 6 + h] = (mx + __builtin_amdgcn_logf(l)) * LN2;
    __syncthreads();
}
DI void attn_combine(const bf16* obr, const float* lse, bf16* mix, int gi0, int nthreads) {
    const int gi = opaque(gi0);
    constexpr int UN = 4;
    for (int idx0 = gi; idx0 < M * 96; idx0 += nthreads * UN) {
        float l[UN][3]; u32x4 raw[UN][3]; int row[UN], c8[UN];
#pragma unroll
        for (int u = 0; u < UN; ++u) { int idx = idx0 + u * nthreads; if (idx >= M * 96) idx = M * 96 - 1; row[u] = idx / 96; c8[u] = idx % 96; const int h = c8[u] >> 4;
#pragma unroll
            for (int br = 0; br < 3; ++br) { l[u][br] = lse[((size_t)br * M + row[u]) * 6 + h]; raw[u][br] = *(const u32x4*)(obr + ((size_t)br * M + row[u]) * 768 + c8[u] * 8); } }
#pragma unroll
        for (int u = 0; u < UN; ++u) {
            const float mx = fmaxf(l[u][0], fmaxf(l[u][1], l[u][2]));
            float w0 = __expf(l[u][0] - mx), w1 = __expf(l[u][1] - mx), w2 = __expf(l[u][2] - mx); const float inv = 1.0f / (w0 + w1 + w2); w0 *= inv; w1 *= inv; w2 *= inv;
            float a[8], bq[8], cc[8]; unpack8(raw[u][0], a); unpack8(raw[u][1], bq); unpack8(raw[u][2], cc);
#pragma unroll
            for (int e = 0; e < 8; ++e) a[e] = w0 * a[e] + w1 * bq[e] + w2 * cc[e];
            if (idx0 + u * nthreads < M * 96) *(u32x4*)(mix + (size_t)row[u] * DM + 1280 + c8[u] * 8) = pack8(a);
        }
    }
}
DI void dn_conv_load(const bf16* proj, int b, int tpos, int col, u32x4* x) {
#pragma unroll
    for (int j = 0; j < 4; ++j) { const int tt = tpos - 3 + j;
        x[2 * j] = (u32x4){0u, 0u, 0u, 0u}; x[2 * j + 1] = (u32x4){0u, 0u, 0u, 0u};
        if (tt >= 0) { const bf16* p = proj + ((size_t)b * SEQ + tt) * NPROJ + col; x[2 * j] = *(const u32x4*)p; x[2 * j + 1] = *(const u32x4*)(p + 8); } }
}
DI void dn_conv16(const u32x4* x, const LAS float* cw  , float* y) {
    float acc[16];
#pragma unroll
    for (int e = 0; e < 16; ++e) acc[e] = 0.f;
#pragma unroll
    for (int j = 0; j < 4; ++j) {
        float xf[16]; unpack8(x[2 * j], xf); unpack8(x[2 * j + 1], xf + 8);
        const LAS f32x4* wp = (const LAS f32x4*)(cw + j * 128);
#pragma unroll
        for (int e4 = 0; e4 < 4; ++e4) { const f32x4 wv = wp[e4];
#pragma unroll
            for (int k = 0; k < 4; ++k) acc[4 * e4 + k] += wv[k] * xf[4 * e4 + k]; } }
#pragma unroll
    for (int e = 0; e < 16; ++e) y[e] = silu_f(acc[e]);
}
DI void dn_prep_item(int item, const bf16* proj, const float* bd, const float* conv_w, const float* a_log, const float* dt_bias, unsigned char* dnall, float* gl_out, LAS unsigned char* lds, int tid0) {
    const int tid = opaque(tid0);
    const int n = item & 31, bh = item >> 5, h = bh % NH, b = bh / NH, t0 = 64 * n;
    unsigned char* dn = dnall + (size_t)item * DN_STRIDE;
    LAS unsigned char* Kimg = lds; LAS unsigned char* Qimg = lds + 17408; LAS unsigned char* KBG = lds + 34816; LAS unsigned char* VB = lds + 52224;
    LAS unsigned char* Amat = lds + 69632; LAS unsigned char* Timg = lds + 87040; LAS float* G = (LAS float*)(lds + 96256); LAS float* BETA = (LAS float*)(lds + 96512);
    const int w = tid >> 6, lane = tid & 63, r = lane & 15, q = lane >> 4;
    LAS float* CW = (LAS float*)(lds + 101888);
    if (tid < 384) { const int tq = tid >> 7, rem = tid & 127, j = rem >> 5, c4 = (rem & 31) * 4;
        *(LAS f32x4*)(CW + (tq * 4 + j) * 128 + c4) = *(const f32x4*)(conv_w + (size_t)j * 2304 + tq * 768 + h * 128 + c4); }
    u32x4 xq[8], xk[8], xv[8];
    { const int i = tid >> 3, p = tid & 7;
      dn_conv_load(proj, b, t0 + i, C_BQ + h * 128 + 16 * p, xq); dn_conv_load(proj, b, t0 + i, C_BK + h * 128 + 16 * p, xk); dn_conv_load(proj, b, t0 + i, C_BV + h * 128 + 16 * p, xv); }
    if (w == 0) {
        const size_t row = (size_t)b * SEQ + t0 + lane;
        const float bl = bd[row * 12 + h], av = bd[row * 12 + 6 + h];
        const float xx = av + dt_bias[h];
        const float sp = xx > 20.f ? xx : log1pf(expf(xx));
        float gs = -expf(a_log[h]) * sp;
#pragma unroll
        for (int o = 1; o < 64; o <<= 1) { const float t = __shfl_up(gs, o); if (lane >= o) gs += t; }
        G[lane] = gs; BETA[lane] = 1.0f / (1.0f + expf(-bl));
    }
    __syncthreads();
    {
        const int i = tid >> 3, p = tid & 7;
        const float gi = G[i], bi = BETA[i], eg = __expf(gi);
        float y[16];
        dn_conv16(xq, CW + 0 * 512 + 16 * p, y);
        { float ss = 0.f;
#pragma unroll
            for (int e = 0; e < 16; ++e) ss += y[e] * y[e];
            ss = sum8(ss);
            const float rs = __builtin_amdgcn_rsqf(ss + EPS) * 0.08838834764831845f;
            float t[16], tg[16];
#pragma unroll
            for (int e = 0; e < 16; ++e) { t[e] = y[e] * rs; tg[e] = t[e] * eg; }
            *(LAS u32x4*)(Qimg + i * 272 + p * 32) = pack8(t); *(LAS u32x4*)(Qimg + i * 272 + p * 32 + 16) = pack8(t + 8);
            *(u32x4*)(dn + DN_QG + (i * 128 + 16 * p) * 2) = pack8(tg); *(u32x4*)(dn + DN_QG + (i * 128 + 16 * p + 8) * 2) = pack8(tg + 8); }
        dn_conv16(xk, CW + 1 * 512 + 16 * p, y);
        { float ss = 0.f;
#pragma unroll
            for (int e = 0; e < 16; ++e) ss += y[e] * y[e];
            ss = sum8(ss);
            const float rs = __builtin_amdgcn_rsqf(ss + EPS);
            float t[16], tg[16];
#pragma unroll
            for (int e = 0; e < 16; ++e) { t[e] = y[e] * rs; tg[e] = t[e] * (bi * eg); }
            *(LAS u32x4*)(Kimg + i * 272 + p * 32) = pack8(t); *(LAS u32x4*)(Kimg + i * 272 + p * 32 + 16) = pack8(t + 8);
            *(LAS u32x4*)(KBG + i * 272 + p * 32) = pack8(tg); *(LAS u32x4*)(KBG + i * 272 + p * 32 + 16) = pack8(tg + 8); }
        dn_conv16(xv, CW + 2 * 512 + 16 * p, y);
        { float t[16];
#pragma unroll
            for (int e = 0; e < 16; ++e) t[e] = y[e] * bi;
            *(LAS u32x4*)(VB + i * 272 + p * 32) = pack8(t); *(LAS u32x4*)(VB + i * 272 + p * 32 + 16) = pack8(t + 8); }
    }
    __syncthreads();
    {
        const int it = w & 3;
        const int i = 16 * it + r; const float gi = G[i], bi = BETA[i];
#pragma unroll
        for (int e = 0; e < 2; ++e) { const int jt = 2 * (w >> 2) + e;
            f32x4 kk = {0.f, 0.f, 0.f, 0.f}, qk = {0.f, 0.f, 0.f, 0.f};
#pragma unroll
            for (int s = 0; s < 4; ++s) { const bf16x8 a = ld_frag(Kimg + (16 * jt + r) * 272 + (32 * s + 8 * q) * 2);
                kk = mfma16(a, ld_frag(Kimg + (16 * it + r) * 272 + (32 * s + 8 * q) * 2), kk);
                qk = mfma16(a, ld_frag(Qimg + (16 * it + r) * 272 + (32 * s + 8 * q) * 2), qk); }
            f32x4 av, at;
#pragma unroll
            for (int jj = 0; jj < 4; ++jj) { const int j = 16 * jt + 4 * q + jj; const float dec = (j <= i) ? __expf(gi - G[j]) : 0.f;
                av[jj] = (j < i) ? bi * kk[jj] * dec : 0.f; at[jj] = qk[jj] * dec; }
            *(LAS f32x4*)(Amat + i * 272 + (16 * jt + 4 * q) * 4) = av;
            *(u32x2*)(dn + DN_ATT + (i * 64 + 16 * jt + 4 * q) * 2) = pack4(at); }
    }
    __syncthreads();
    LAS unsigned char* A21img = lds + 96768; LAS unsigned char* Ximg = lds + 99328;
    if (w == 0) {
        const int hb = lane >> 5, c = lane & 31;
        unsigned abv = (unsigned)(size_t)(Amat + hb * (32 * 272 + 32 * 4));
        float N[32];
#pragma unroll
        for (int i = 0; i < 32; ++i) {
            const LAS unsigned char* ab = (const LAS unsigned char*)(size_t)abv;
            float s0 = *(const LAS float*)(ab + i * 272 + c * 4), s1 = 0.f, s2 = 0.f, s3 = 0.f;
#pragma unroll
            for (int j4 = 0; j4 < (i + 3) / 4; ++j4) { const f32x4 a4 = *(const LAS f32x4*)(ab + i * 272 + j4 * 16);
                if (4 * j4 + 0 < i) s0 += a4[0] * N[4 * j4 + 0];
                if (4 * j4 + 1 < i) s1 += a4[1] * N[4 * j4 + 1];
                if (4 * j4 + 2 < i) s2 += a4[2] * N[4 * j4 + 2];
                if (4 * j4 + 3 < i) s3 += a4[3] * N[4 * j4 + 3]; }
            N[i] = -((s0 + s1) + (s2 + s3));
            if (i & 1) asm volatile("" : "+v"(abv) : "v"(N[i]));
        }
        LAS unsigned char* tb = Timg + (32 * hb) * 144 + (32 * hb + c) * 2;
#pragma unroll
        for (int i = 0; i < 32; i += 2) { const unsigned pr = pk2(N[i], N[i + 1]);
            *(LAS unsigned short*)(tb + i * 144) = (unsigned short)(pr & 0xffffu);
            *(LAS unsigned short*)(tb + (i + 1) * 144) = (unsigned short)(pr >> 16); }
        asm volatile("s_waitcnt lgkmcnt(0)" ::: "memory");
        *(LAS unsigned short*)(tb + c * 144) = (unsigned short)0x3F80u;
    } else if (w == 1) {
        const int i = lane >> 1, hf = lane & 1;
        *(LAS u32x4*)(Timg + i * 144 + 64 + hf * 32) = (u32x4){0u, 0u, 0u, 0u}; *(LAS u32x4*)(Timg + i * 144 + 64 + hf * 32 + 16) = (u32x4){0u, 0u, 0u, 0u};
    } else if (w < 4) {
        const int t = (w - 2) * 64 + lane, i = t >> 2, j0 = (t & 3) * 8;
        const f32x4 a = *(const LAS f32x4*)(Amat + (32 + i) * 272 + j0 * 4), bb = *(const LAS f32x4*)(Amat + (32 + i) * 272 + j0 * 4 + 16);
        u32x4 o; o.x = pk2(a[0], a[1]); o.y = pk2(a[2], a[3]); o.z = pk2(bb[0], bb[1]); o.w = pk2(bb[2], bb[3]);
        *(LAS u32x4*)(A21img + i * 80 + j0 * 2) = o;
    }
    __syncthreads();
    if (w < 4) {
        const int it = w >> 1, ctile = w & 1;
        const LAS unsigned char* p0 = Timg + (8 * q + (r >> 2)) * 144 + (16 * ctile + 4 * (r & 3)) * 2;
        const f32x4 x = mfma16(tr_frag(p0, p0 + 4 * 144), ld_frag(A21img + (16 * it + r) * 80 + 16 * q), (f32x4){0.f, 0.f, 0.f, 0.f});
        *(LAS u32x2*)(Ximg + (16 * it + r) * 80 + (16 * ctile + 4 * q) * 2) = pack4(x);
    }
    __syncthreads();
    if (w < 4) {
        const int it = w >> 1, ctile = w & 1;
        const LAS unsigned char* p0 = Ximg + (8 * q + (r >> 2)) * 80 + (16 * ctile + 4 * (r & 3)) * 2;
        const f32x4 y = mfma16(tr_frag(p0, p0 + 4 * 80), ld_frag(Timg + (32 + 16 * it + r) * 144 + (32 + 8 * q) * 2), (f32x4){0.f, 0.f, 0.f, 0.f});
        *(LAS u32x2*)(Timg + (32 + 16 * it + r) * 144 + (16 * ctile + 4 * q) * 2) = pack4(-y);
    }
    __syncthreads();
    {
        const int ct = w & 3; const float glast = G[63];
        bf16x8 tf[2];
#pragma unroll
        for (int ks = 0; ks < 2; ++ks) tf[ks] = ld_frag(Timg + (16 * ct + r) * 144 + (32 * ks + 8 * q) * 2);
        float dk4[4];
#pragma unroll
        for (int jj = 0; jj < 4; ++jj) dk4[jj] = __expf(glast - G[16 * ct + 4 * q + jj]);
#pragma unroll
        for (int e = 0; e < 4; ++e) { const int dt = 4 * (w >> 2) + e;
            f32x4 au = {0.f, 0.f, 0.f, 0.f}, aw = {0.f, 0.f, 0.f, 0.f};
#pragma unroll
            for (int ks = 0; ks < 2; ++ks) { const int ro = (32 * ks + 8 * q + (r >> 2)) * 272 + (16 * dt + 4 * (r & 3)) * 2;
                au = mfma16(tf[ks], tr_frag(VB + ro, VB + ro + 4 * 272), au);
                aw = mfma16(tr_frag(KBG + ro, KBG + ro + 4 * 272), tf[ks], aw); }
            *(u32x2*)(dn + DN_UT + ((16 * dt + r) * 64 + 16 * ct + 4 * q) * 2) = pack4(au);
            *(u32x2*)(dn + DN_WK + ((16 * ct + r) * 128 + 16 * dt + 4 * q) * 2) = pack4(aw);
            const s16x4 kv = tr4(Kimg + (16 * ct + 4 * q + (r >> 2)) * 272 + (16 * dt + 4 * (r & 3)) * 2);
            f32x4 kd;
#pragma unroll
            for (int jj = 0; jj < 4; ++jj) kd[jj] = __uint_as_float(((unsigned)(unsigned short)kv[jj]) << 16) * dk4[jj];
            *(u32x2*)(dn + DN_KDT + ((16 * dt + r) * 64 + 16 * ct + 4 * q) * 2) = pack4(kd); }
        if (tid == 0) gl_out[item] = expf(glast);
    }
    __syncthreads();
}
constexpr int SC_W = 0, SC_Q = 16384, SC_K = 32768, SC_A = 49152, SC_U = 57344, SC_SLOT = 61440, SC_RING = 16384;
DI void glds16(const void* gsrc, unsigned lds_dst) { unsigned keep;
    asm volatile("s_mov_b32 %0, m0\n\ts_mov_b32 m0, %2\n\ts_nop 0\n\tglobal_load_lds_dwordx4 %1, off\n\ts_mov_b32 m0, %0" : "=&s"(keep) : "v"(gsrc), "s"(lds_dst) : "memory"); }
DI void scan_dma(const unsigned char* dn, const unsigned (&goff)[8], LAS unsigned char* slot, int w) {
#pragma unroll
    for (int j = 0; j < 8; ++j) { const int k = w + 8 * j;
        if (k < 60) glds16(dn + goff[j], (unsigned)(size_t)(slot + k * 1024)); }
}
DI void scan_step(const LAS unsigned char* sl, float g, f32x4 (&Sacc)[2], float* op, LAS unsigned char* Simg, LAS unsigned char* VNT, int ct, int dvt, int mt, int nt0, int r, int q) {
    f32x4 wsa = {0.f, 0.f, 0.f, 0.f}, qsa = {0.f, 0.f, 0.f, 0.f};
    const int rowc = 16 * ct + r;
#pragma unroll
    for (int ks = 0; ks < 4; ++ks) { const LAS unsigned char* p0 = Simg + (32 * ks + 8 * q + (r >> 2)) * 80 + (16 * dvt + 4 * (r & 3)) * 2;
        const bf16x8 sf = tr_frag(p0, p0 + 4 * 80);
        const int ph = ((4 * ks + q) ^ r) * 16;
        wsa = mfma16(ld_frag(sl + SC_W + rowc * 256 + ph), sf, wsa); qsa = mfma16(ld_frag(sl + SC_Q + rowc * 256 + ph), sf, qsa); }
    { const int dv = 16 * dvt + r;
      const u32x2 uu = *(const LAS u32x2*)(sl + SC_U + dv * 128 + (((2 * ct + (q >> 1)) ^ (r & 7)) * 16) + (q & 1) * 8);
      f32x4 vn; vn[0] = bflo(uu.x) - wsa[0]; vn[1] = bfhi(uu.x) - wsa[1]; vn[2] = bflo(uu.y) - wsa[2]; vn[3] = bfhi(uu.y) - wsa[3];
      *(LAS u32x2*)(VNT + dv * 144 + (16 * ct + 4 * q) * 2) = pack4(vn); }
    lds_barrier();
#pragma unroll
    for (int ks = 0; ks < 2; ++ks) qsa = mfma16(ld_frag(sl + SC_A + rowc * 128 + (((4 * ks + q) ^ (r & 7)) * 16)), ld_frag(VNT + (16 * dvt + r) * 144 + (32 * ks + 8 * q) * 2), qsa);
#pragma unroll
    for (int jj = 0; jj < 4; ++jj) op[(size_t)jj * 768] = qsa[jj];
    bf16x8 af2[2];
#pragma unroll
    for (int ks = 0; ks < 2; ++ks) af2[ks] = ld_frag(VNT + (16 * mt + r) * 144 + (32 * ks + 8 * q) * 2);
#pragma unroll
    for (int e = 0; e < 2; ++e) { Sacc[e] = Sacc[e] * g;
#pragma unroll
        for (int ks = 0; ks < 2; ++ks) Sacc[e] = mfma16(af2[ks], ld_frag(sl + SC_K + (16 * (nt0 + e) + r) * 128 + (((4 * ks + q) ^ (r & 7)) * 16)), Sacc[e]);
        *(LAS u32x2*)(Simg + (16 * (nt0 + e) + r) * 80 + (16 * mt + 4 * q) * 2) = pack4(Sacc[e]); }
    asm volatile("s_waitcnt vmcnt(4)" ::: "memory");
    lds_barrier();
}
DI void dn_scan_item(int item, const unsigned char* dnall, const float* gl, float* odn, LAS unsigned char* lds, int tid0) {
    const int tid = opaque(tid0);
    const int dvq = item & 3, bh = item >> 2, h = bh % NH, b = bh / NH;
    LAS unsigned char* Simg = lds; LAS unsigned char* VNT = lds + 10240; LAS float* Gl = (LAS float*)(lds + 15360);
    LAS unsigned char* ring = lds + SC_RING;
    for (int u = tid; u < 10240 / 16; u += NTHR) *(LAS u32x4*)(Simg + u * 16) = (u32x4){0u, 0u, 0u, 0u};
    if (tid < 32) Gl[tid] = gl[bh * 32 + tid];
    const int w = __builtin_amdgcn_readfirstlane(tid >> 6), lane = tid & 63, r = lane & 15, q = lane >> 4;
    const int ct = w >> 1, dvt = w & 1, mt = w & 1, nt0 = 2 * (w >> 1);
    unsigned goff[8];
#pragma unroll
    for (int j = 0; j < 8; ++j) { const int k = w + 8 * j;
        if (k < 32) { const int row = 4 * (k & 15) + (lane >> 4), pc = (lane & 15) ^ (row & 15); goff[j] = (unsigned)((k < 16 ? DN_WK : DN_QG) + row * 256 + pc * 16); }
        else { const int k0 = k < 48 ? 32 : k < 56 ? 48 : 56; const int row = 8 * (k - k0) + (lane >> 3), pc = (lane & 7) ^ (row & 7);
               goff[j] = (unsigned)((k < 48 ? DN_KDT : k < 56 ? DN_ATT : DN_UT + (size_t)dvq * 4096) + row * 128 + pc * 16); } }
    f32x4 Sacc[2];
#pragma unroll
    for (int e = 0; e < 2; ++e) Sacc[e] = (f32x4){0.f, 0.f, 0.f, 0.f};
    const unsigned char* dn0 = dnall + (size_t)(bh * 32) * DN_STRIDE;
    float* op0 = odn + ((size_t)b * SEQ + 16 * ct + 4 * q) * 768 + h * 128 + dvq * 32 + 16 * dvt + r;
    scan_dma(dn0, goff, ring, w);
    asm volatile("s_waitcnt vmcnt(0)" ::: "memory");
    __syncthreads();
#pragma unroll 1
    for (int n = 0; n < 32; ++n) {
        const int nn = (n + 1 < 32) ? n + 1 : 31;
        scan_dma(dn0 + (size_t)nn * DN_STRIDE, goff, ring + ((n + 1) & 1) * SC_SLOT, w);
        scan_step(ring + (n & 1) * SC_SLOT, Gl[n], Sacc, op0 + (size_t)(64 * n) * 768, Simg, VNT, ct, dvt, mt, nt0, r, q);
    }
    asm volatile("s_waitcnt vmcnt(0)" ::: "memory");
    __syncthreads();
}
DI void dn_gate_phase(const float* odn, const bf16* proj, const float* ong, bf16* mix, int gw, int ngw, int lane0) {
    const int lane = opaque(lane0);
    const int sub = lane >> 4, l16 = lane & 15;
    float gv[8];
#pragma unroll
    for (int e = 0; e < 8; ++e) gv[e] = ong[l16 * 8 + e];
    constexpr int UN = 4, NIT = M * NH / 4;
    for (int it0 = gw; it0 < NIT; it0 += ngw * UN) {
        f32x4 o0[UN], o1[UN]; u32x4 graw[UN]; int row[UN], hh[UN];
#pragma unroll
        for (int u = 0; u < UN; ++u) { int it = it0 + u * ngw; if (it >= NIT) it = NIT - 1; const int idx = it * 4 + sub; row[u] = idx / NH; hh[u] = idx % NH;
            const float* op = odn + (size_t)row[u] * 768 + hh[u] * 128 + l16 * 8; o0[u] = *(const f32x4*)op; o1[u] = *(const f32x4*)(op + 4);
            graw[u] = *(const u32x4*)(proj + (size_t)row[u] * NPROJ + C_BG + hh[u] * 128 + l16 * 8); }
#pragma unroll
        for (int u = 0; u < UN; ++u) {
            float ss = (o0[u][0] * o0[u][0] + o0[u][1] * o0[u][1]) + (o0[u][2] * o0[u][2] + o0[u][3] * o0[u][3]) + (o1[u][0] * o1[u][0] + o1[u][1] * o1[u][1]) + (o1[u][2] * o1[u][2] + o1[u][3] * o1[u][3]);
            ss = sum16(ss);
            const float rs = __builtin_amdgcn_rsqf(ss * (1.0f / 128.0f) + EPS);
            float gt[8]; unpack8(graw[u], gt);
            float y[8];
#pragma unroll
            for (int e = 0; e < 4; ++e) { y[e] = o0[u][e] * rs * gv[e] * silu_f(gt[e]); y[4 + e] = o1[u][e] * rs * gv[4 + e] * silu_f(gt[4 + e]); }
            if (it0 + u * ngw < NIT) *(u32x4*)(mix + (size_t)row[u] * DM + 512 + hh[u] * 128 + l16 * 8) = pack8(y);
        }
    }
}

struct Args { const float* in[16]; float* out; unsigned char* ws; };
#ifndef MK_SKIP_MIX
#define MK_SKIP_MIX 0
#endif
#ifndef REP_M1
#define REP_M1 1
#endif
#ifndef REP_M2
#define REP_M2 1
#endif
#ifndef REP_G13
#define REP_G13 1
#endif
__global__ void __launch_bounds__(NTHR, 2) hybrid_fwd(Args a) {
    extern __shared__ __attribute__((aligned(16))) unsigned char lds_raw[];
    LAS unsigned char* lds = (LAS unsigned char*)lds_raw;
    cg::grid_group grid = cg::this_grid();
    volatile LAS unsigned* bst = (volatile LAS unsigned*)(lds + LDS_BYTES - 64);
    if (threadIdx.x < 2) bst[threadIdx.x] = 0u;
    __syncthreads();
    const XcdBarrier xbar = xcd_barrier_post((unsigned*)(a.ws + WS_CTL), bst);
    const int tid = threadIdx.x, lane = tid & 63, wave = __builtin_amdgcn_readfirstlane(tid >> 6);
    const int G = gridDim.x, bx = blockIdx.x, gw = bx * 8 + wave, ngw = G * 8;
    unsigned char* ws = a.ws;
    bf16* Hb = (bf16*)(ws + WS_H); bf16* PROJ = (bf16*)(ws + WS_PROJ); float* BD = (float*)(ws + WS_BD); unsigned char* DN = ws + WS_DN; float* GL = (float*)(ws + WS_GL);
    float* ODN = (float*)(ws + WS_ODN); bf16* OBR = (bf16*)(ws + WS_OBR); float* LSE = (float*)(ws + WS_LSE);
    bf16* MIX = Hb; bf16* ACT = PROJ; bf16* XB = (bf16*)DN; float* SS = (float*)(ws + WS_SS);

#ifdef EXTRA_SYNCS
    for (int es = 0; es < EXTRA_SYNCS; ++es) xcd_barrier(xbar);
#endif
    weight_prep(a.in, ws, lds, gw, ngw, wave, lane);
#ifdef REP_P0
    __syncthreads(); weight_prep(a.in, ws, lds, gw, ngw, wave, lane);
#endif
    __syncthreads();
    norm_phase(a.in[I_X], a.in[I_N1G], Hb, a.in[I_WIN], BD, lds, gw, ngw, tid, lane);
    grid.sync();
#ifndef REP_MASK
#define REP_MASK 0
#endif
    bool rep_done = false;
#pragma unroll 1
    for (int s = 1; s < DEPTH * 9; ++s) {
        const int l = s / 9, ph = s - 9 * l;
        const unsigned char* wl = ws + WS_W + (size_t)l * SZ_WL;
        if (ph == 0) {
            norm_phase(a.out, a.in[I_N1G] + (size_t)l * DM, Hb, a.in[I_WIN] + (size_t)l * DM * IN_TOTAL, BD, lds, gw, ngw, tid, lane);
        } else if (ph == 1) {
            pg8::Gemm g{Hb, (const bf16*)wl, M, NPROJ, DM}; pg8::StaticOrder S; S.init(M, NPROJ, G, bx);
            pg8::EpiBf16<0> E{PROJ, NPROJ, nullptr, 0, 0, 1.f};
            pg8::gemm_phase<pg8::EpiBf16<0>, pg8::StaticOrder, true, true>(lds, g, S, E);
        } else if (ph == 2) {
#ifndef M1_REP_TYPE
#define M1_REP_TYPE -1
#endif
            for (int it = bx; it < 2304 + 1536 + 512; it += G)
            for (int rr = 0; rr < (((it < 2304) ? 0 : (it < 3840) ? 1 : 2) == M1_REP_TYPE ? 2 : 1); ++rr) {
                if (it < 2304) attn_item(it, PROJ, a.in[I_QNG] + l * HD, a.in[I_KNG] + l * HD, OBR, LSE, lds, tid);
                else if (it < 2304 + 1536) dn_prep_item(it - 2304, PROJ, BD, a.in[I_CONVW] + (size_t)l * 4 * 2304, a.in[I_ALOG] + l * NH, a.in[I_DTB] + l * NH, DN, GL, lds, tid);
                else sgu_item(it - 3840, PROJ, a.in[I_SGUG] + l * 512, a.in[I_WS] + (size_t)l * 4 * 128 * 128, a.in[I_BS] + l * 512, MIX, lds, tid);
            }
        } else if (ph == 3) {
            if (G > NSCAN) {
                if (bx < NSCAN) { const int xcd = bx & 7, slot = bx >> 3;
#ifndef M2_REP_SCAN
#define M2_REP_SCAN 1
#endif
#ifndef M2_REP_COMB
#define M2_REP_COMB 1
#endif
                    dn_scan_item(((xcd * 6 + (slot >> 2)) << 2) | (slot & 3), DN, GL, ODN, lds, tid); }
                else for (int rr = 0; rr < M2_REP_COMB; ++rr) attn_combine(OBR, LSE, MIX, (bx - NSCAN) * NTHR + tid, (G - NSCAN) * NTHR);
            } else {
                for (int it = bx; it < NSCAN; it += G) { dn_scan_item(it, DN, GL, ODN, lds, tid); __syncthreads(); }
                attn_combine(OBR, LSE, MIX, bx * NTHR + tid, G * NTHR);
            }
        } else if (ph == 4) {
            dn_gate_phase(ODN, PROJ, a.in[I_ONG] + l * HD, MIX, gw, ngw, lane);
        } else if (ph == 5) {
            pg8::Gemm g{MIX, (const bf16*)(wl + SZ_WIN), M, DM, DM}; pg8::StaticOrder S; S.init(M, DM, G, bx);
            pg8::EpiResF32 E{(l == 0) ? a.in[I_X] : a.out, a.out, DM};
            pg8::gemm_phase<pg8::EpiResF32, pg8::StaticOrder, true, true>(lds, g, S, E);
        } else if (ph == 6) {
            norm_phase(a.out, a.in[I_N2G] + (size_t)l * DM, Hb, nullptr, nullptr, lds, gw, ngw, tid, lane);
        } else if (ph == 7) {
            pg8::Gemm g{Hb, (const bf16*)(wl + SZ_WIN + SZ_WOUT), M, 2 * FF, DM}; pg8::StaticOrder S; S.init(M, 2 * FF, G, bx);
            pg8::EpiSwiGLU E{ACT, FF};
            pg8::gemm_phase<pg8::EpiSwiGLU, pg8::StaticOrder, true, true>(lds, g, S, E);
        } else {
            pg8::Gemm g{ACT, (const bf16*)(wl + SZ_WIN + SZ_WOUT + SZ_WGU), M, DM, FF}; pg8::StaticOrder S; S.init(M, DM, G, bx);
            pg8::EpiResF32 E{a.out, a.out, DM};
            pg8::gemm_phase<pg8::EpiResF32, pg8::StaticOrder, true, true>(lds, g, S, E);
        }
        if (s + 1 < DEPTH * 9) xcd_barrier(xbar);
        if (REP_MASK) { if (((REP_MASK >> ph) & 1) && !rep_done) { --s; rep_done = true; } else rep_done = false; }
    }
}

extern "C" void kernel_launch(void* const* d_in, const int* in_sizes, int n_in, void* d_out, int out_size, void* d_ws, size_t ws_size, hipStream_t stream) {
    static int grid = 0;
    if (grid == 0) {
        if (n_in != 16 || in_sizes[0] != M * DM || out_size != M * DM || ws_size < WS_END) { fprintf(stderr, "kernel_launch: unexpected shapes / workspace (n_in %d, ws %zu, need %zu); nothing launched\n", n_in, ws_size, (size_t)WS_END); grid = -1; return; }
        int dev = 0, cus = 0, per_cu = 0;
        if (hipGetDevice(&dev) != hipSuccess || hipDeviceGetAttribute(&cus, hipDeviceAttributeMultiprocessorCount, dev) != hipSuccess) { grid = -1; return; }
        if (hipFuncSetAttribute((const void*)hybrid_fwd, hipFuncAttributeMaxDynamicSharedMemorySize, LDS_BYTES) != hipSuccess) { fprintf(stderr, "kernel_launch: hipFuncSetAttribute failed\n"); grid = -1; return; }
        if (hipOccupancyMaxActiveBlocksPerMultiprocessor(&per_cu, (const void*)hybrid_fwd, NTHR, LDS_BYTES) != hipSuccess || per_cu < 1) { fprintf(stderr, "kernel_launch: occupancy query says %d blocks per CU\n", per_cu); per_cu = 1; }
        (void)hipGetLastError();
        grid = cus;
    }
    if (grid < 0) return;
    if (hipMemsetAsync((char*)d_ws + WS_CTL, 0, CTL_BYTES, stream) != hipSuccess) { fprintf(stderr, "kernel_launch: memset of the barrier words failed\n"); return; }
    Args a{};
    for (int i = 0; i < 16; ++i) a.in[i] = (const float*)d_in[i];
    a.out = (float*)d_out; a.ws = (unsigned char*)d_ws;
    void* args[] = {&a};
    hipError_t e = hipLaunchCooperativeKernel((const void*)hybrid_fwd, dim3(grid), dim3(NTHR), args, LDS_BYTES, stream);
    if (e != hipSuccess) fprintf(stderr, "kernel_launch: cooperative launch failed: %s (grid %d)\n", hipGetErrorString(e), grid);
}
```
